# Optimizing an MI355X kernel written in HIP

```python
import jax, jax.numpy as jnp
from jax import lax
import numpy as np

D_MODEL = 1024
BATCH = 32
SEQ = 2048
DEPTH = 1

POOL_WIDTH = D_MODEL // 2
POOL_WINDOWS = (2, 4, 8, 16)
POOL_GROUP = POOL_WIDTH // len(POOL_WINDOWS)
N_HEADS = 8
HEAD_DIM = 64
N_KV_GROUPS = 2
HEADS_PER_GROUP = N_HEADS // N_KV_GROUPS
ATTN_WIDTH = N_HEADS * HEAD_DIM
KV_WIDTH = N_KV_GROUPS * HEAD_DIM
CMP_BLOCK = 32
CMP_STRIDE = 16
CMP_HIDDEN = 256
SEL_BLOCK = 64
N_SELECT = 8
WINDOW = 512
Q_CHUNK = 64
N_BRANCH = 3
IN_WIDTH = POOL_WIDTH + ATTN_WIDTH + 6 * KV_WIDTH + N_BRANCH * N_HEADS + 2 * D_MODEL
N_GROUPS = 4
EXPERTS_PER_GROUP = 8
N_EXPERTS = N_GROUPS * EXPERTS_PER_GROUP
TOP_K_IN_GROUP = 2
EXPERT_FF = 512

EPS = 1e-6
NEG = -1e30
FORCE_SCORE = 1e4

kernel_name = 'hybrid_pool_nsa_hmoe_block'


def rmsnorm(x, g):
    xf = x.astype(jnp.float32)
    r = lax.rsqrt(jnp.mean(xf * xf, axis=-1, keepdims=True) + EPS)
    return (xf * r * g.astype(jnp.float32)).astype(x.dtype)


def masked_softmax(s, mask):
    p = jax.nn.softmax(jnp.where(mask, s, NEG), axis=-1)
    return p * mask


def pool_mixer(u, pool_w, pool_scale):
    B, S, _ = u.shape
    t = jnp.arange(S)
    outs = []
    for gi, w in enumerate(POOL_WINDOWS):
        ug = u[..., gi * POOL_GROUP:(gi + 1) * POOL_GROUP].astype(jnp.float32)
        cs = jnp.cumsum(ug, axis=1)
        prev = jnp.pad(cs, ((0, 0), (w, 0), (0, 0)))[:, :S]
        cnt = jnp.minimum(t + 1, w).astype(jnp.float32)[None, :, None]
        outs.append((cs - prev) / cnt - ug)
    p = jnp.stack(outs, axis=2).astype(u.dtype)
    y = jnp.einsum('bsgc,gcd->bsgd', p, pool_w).reshape(B, S, POOL_WIDTH)
    return y * pool_scale


def compress_blocks(kv, pos, w1, b1, w2):
    B, S, G, dh = kv.shape
    r = CMP_BLOCK // CMP_STRIDE
    ch = kv.reshape(B, S // CMP_STRIDE, CMP_STRIDE, G, dh)
    n = S // CMP_STRIDE - r + 1
    blocks = jnp.concatenate([ch[:, i:i + n] for i in range(r)], axis=2)
    blocks = blocks + pos[None, None, :, None, :]
    flat = blocks.transpose(0, 1, 3, 2, 4).reshape(B, n, G, CMP_BLOCK * dh)
    return jax.nn.gelu(flat @ w1 + b1) @ w2


def selection_overlap(n_cmp, n_blk):
    s1 = np.arange(n_cmp)[:, None] * CMP_STRIDE
    s2 = np.arange(n_blk)[None, :] * SEL_BLOCK
    ov = np.clip(np.minimum(s1 + CMP_BLOCK, s2 + SEL_BLOCK) - np.maximum(s1, s2), 0, None)
    return (ov / CMP_BLOCK).astype(np.float32)


def nsa_attention(q, k_cmp, v_cmp, k_sel, v_sel, k_win, v_win, branch_gate,
                  cmp_pos, cmp_w1, cmp_b1, cmp_w2):
    B, S, _ = q.shape
    G, Hg, dh = N_KV_GROUPS, HEADS_PER_GROUP, HEAD_DIM
    scale = HEAD_DIM ** -0.5
    q = q.reshape(B, S, G, Hg, dh)
    kc = compress_blocks(k_cmp.reshape(B, S, G, dh), cmp_pos[0], cmp_w1[0], cmp_b1[0], cmp_w2[0])
    vc = compress_blocks(v_cmp.reshape(B, S, G, dh), cmp_pos[1], cmp_w1[1], cmp_b1[1], cmp_w2[1])
    n_cmp = kc.shape[1]
    n_blk = S // SEL_BLOCK
    n_sel = min(N_SELECT, n_blk)
    overlap = jnp.asarray(selection_overlap(n_cmp, n_blk))
    ks_b = k_sel.reshape(B, n_blk, SEL_BLOCK, G, dh).transpose(0, 3, 1, 2, 4)
    vs_b = v_sel.reshape(B, n_blk, SEL_BLOCK, G, dh).transpose(0, 3, 1, 2, 4)
    pad = ((0, 0), (WINDOW, 0), (0, 0), (0, 0))
    kw_p = jnp.pad(k_win.reshape(B, S, G, dh), pad)
    vw_p = jnp.pad(v_win.reshape(B, S, G, dh), pad)
    gates = jax.nn.sigmoid(branch_gate.astype(jnp.float32)).astype(q.dtype)
    gates = gates.reshape(B, S, N_BRANCH, G, Hg)
    cmp_end = jnp.arange(n_cmp) * CMP_STRIDE + CMP_BLOCK - 1
    blk = jnp.arange(n_blk)
    gather = jax.vmap(jax.vmap(lambda a, i: a[i]))

    def chunk(ci):
        q0 = ci * Q_CHUNK
        qc = lax.dynamic_slice_in_dim(q, q0, Q_CHUNK, axis=1)
        gc = lax.dynamic_slice_in_dim(gates, q0, Q_CHUNK, axis=1)
        t = q0 + jnp.arange(Q_CHUNK)
        s1 = jnp.einsum('bqghd,bngd->bghqn', qc, kc).astype(jnp.float32) * scale
        m1 = cmp_end[None, :] <= t[:, None]
        p1 = masked_softmax(s1, m1)
        o_cmp = jnp.einsum('bghqn,bngd->bqghd', p1.astype(vc.dtype), vc)
        ps = jnp.einsum('bghqn,nj->bgqj', p1, overlap)
        cur = t // SEL_BLOCK
        valid = blk[None, :] <= cur[:, None]
        forced = (blk[None, :] == 0) | (blk[None, :] == cur[:, None]) | (blk[None, :] == cur[:, None] - 1)
        score = jnp.where(forced, FORCE_SCORE, jnp.where(valid, ps, NEG))
        _, idx = lax.top_k(score, n_sel)
        flat_idx = idx.reshape(B, G, Q_CHUNK * n_sel)
        kg = gather(ks_b, flat_idx).reshape(B, G, Q_CHUNK, n_sel * SEL_BLOCK, dh)
        vg = gather(vs_b, flat_idx).reshape(B, G, Q_CHUNK, n_sel * SEL_BLOCK, dh)
        key_pos = (idx[..., None] * SEL_BLOCK + jnp.arange(SEL_BLOCK)).reshape(B, G, Q_CHUNK, n_sel * SEL_BLOCK)
        m2 = (key_pos <= t[None, None, :, None])[:, :, None]
        s2 = jnp.einsum('bqghd,bgqkd->bghqk', qc, kg).astype(jnp.float32) * scale
        p2 = masked_softmax(s2, m2)
        o_sel = jnp.einsum('bghqk,bgqkd->bqghd', p2.astype(vg.dtype), vg)
        kwc = lax.dynamic_slice_in_dim(kw_p, q0, WINDOW + Q_CHUNK, axis=1)
        vwc = lax.dynamic_slice_in_dim(vw_p, q0, WINDOW + Q_CHUNK, axis=1)
        kpos = q0 - WINDOW + jnp.arange(WINDOW + Q_CHUNK)
        m3 = (kpos[None, :] <= t[:, None]) & (kpos[None, :] > t[:, None] - WINDOW) & (kpos[None, :] >= 0)
        s3 = jnp.einsum('bqghd,bkgd->bghqk', qc, kwc).astype(jnp.float32) * scale
        p3 = masked_softmax(s3, m3)
        o_win = jnp.einsum('bghqk,bkgd->bqghd', p3.astype(vwc.dtype), vwc)
        o = (gc[:, :, 0, :, :, None] * o_cmp + gc[:, :, 1, :, :, None] * o_sel
             + gc[:, :, 2, :, :, None] * o_win)
        return o.reshape(B, Q_CHUNK, ATTN_WIDTH)

    out = lax.map(chunk, jnp.arange(S // Q_CHUNK))
    return out.transpose(1, 0, 2, 3).reshape(B, S, ATTN_WIDTH)


def token_mixer(h, w_in, pool_w, pool_scale, cmp_pos, cmp_w1, cmp_b1, cmp_w2,
                w_up_pool, w_up_attn, w_out):
    z = h @ w_in
    cuts = np.cumsum([POOL_WIDTH, ATTN_WIDTH] + [KV_WIDTH] * 6 + [N_BRANCH * N_HEADS])
    u_pool, q, kc, vc, ks, vs, kw, vw, bgate, mgate = jnp.split(z, [int(i) for i in cuts], axis=-1)
    y_pool = pool_mixer(u_pool, pool_w, pool_scale) @ w_up_pool
    y_attn = nsa_attention(q, kc, vc, ks, vs, kw, vw, bgate, cmp_pos, cmp_w1, cmp_b1, cmp_w2) @ w_up_attn
    g = jax.nn.sigmoid(mgate.astype(jnp.float32)).astype(h.dtype)
    return (g[..., :D_MODEL] * y_pool + g[..., D_MODEL:] * y_attn) @ w_out


def hier_moe(h, rg_w, rg_b, re_w, re_b, w_gate, w_up, w_down):
    B, S, D = h.shape
    xt = h.reshape(-1, D)
    n = xt.shape[0]
    lg = (xt @ rg_w + rg_b).astype(jnp.float32)
    gidx = jnp.argmax(lg, axis=-1)
    gp = jnp.max(jax.nn.softmax(lg, axis=-1), axis=-1)
    le = (xt @ re_w + re_b).astype(jnp.float32).reshape(n, N_GROUPS, EXPERTS_PER_GROUP)
    le_sel = le[jnp.arange(n), gidx]
    tv, ti = lax.top_k(le_sel, TOP_K_IN_GROUP)
    w = gp[:, None] * jax.nn.softmax(tv, axis=-1)
    eid = gidx[:, None] * EXPERTS_PER_GROUP + ti
    combine = jnp.einsum('nk,nke->ne', w, jax.nn.one_hot(eid, N_EXPERTS, dtype=jnp.float32)).astype(xt.dtype)
    y = jnp.zeros_like(xt)
    for e in range(N_EXPERTS):
        he = jax.nn.silu(xt @ w_gate[e]) * (xt @ w_up[e])
        y = y + combine[:, e:e + 1] * (he @ w_down[e])
    return y.reshape(B, S, D)


def setup_inputs(seed: int = 0) -> dict:
    key = jax.random.key(seed)
    ks = jax.random.split(key, 26)
    L, D, f32 = DEPTH, D_MODEL, jnp.float32
    nrm = lambda k, shape: jax.random.normal(k, shape, f32)
    lin = lambda k, shape, fan: nrm(k, shape) * fan ** -0.5
    return {
        'x': nrm(ks[0], (BATCH, SEQ, D)),
        'c': nrm(ks[1], (BATCH, D)),
        'ada_w': 0.5 * lin(ks[2], (L, D, 6 * D), D),
        'ada_b': 0.02 * nrm(ks[3], (L, 6 * D)),
        'norm1_g': 1.0 + 0.02 * nrm(ks[4], (L, D)),
        'w_in': lin(ks[5], (L, D, IN_WIDTH), D),
        'pool_w': lin(ks[6], (L, len(POOL_WINDOWS), POOL_GROUP, POOL_GROUP), POOL_GROUP),
        'pool_scale': 1.0 + 0.1 * nrm(ks[7], (L, POOL_WIDTH)),
        'cmp_pos': 0.02 * nrm(ks[8], (L, 2, CMP_BLOCK, HEAD_DIM)),
        'cmp_w1': lin(ks[9], (L, 2, CMP_BLOCK * HEAD_DIM, CMP_HIDDEN), CMP_BLOCK * HEAD_DIM),
        'cmp_b1': 0.02 * nrm(ks[10], (L, 2, CMP_HIDDEN)),
        'cmp_w2': lin(ks[11], (L, 2, CMP_HIDDEN, HEAD_DIM), CMP_HIDDEN),
        'w_up_pool': lin(ks[12], (L, POOL_WIDTH, D), POOL_WIDTH),
        'w_up_attn': lin(ks[13], (L, ATTN_WIDTH, D), ATTN_WIDTH),
        'w_out': lin(ks[14], (L, D, D), D),
        'norm2_g': 1.0 + 0.02 * nrm(ks[15], (L, D)),
        'router_g_w': lin(ks[16], (L, D, N_GROUPS), D),
        'router_g_b': 0.01 * nrm(ks[17], (L, N_GROUPS)),
        'router_e_w': lin(ks[18], (L, D, N_EXPERTS), D),
        'router_e_b': 0.01 * nrm(ks[19], (L, N_EXPERTS)),
        'exp_w_gate': lin(ks[20], (L, N_EXPERTS, D, EXPERT_FF), D),
        'exp_w_up': lin(ks[21], (L, N_EXPERTS, D, EXPERT_FF), D),
        'exp_w_down': lin(ks[22], (L, N_EXPERTS, EXPERT_FF, D), EXPERT_FF),
        'final_g': 1.0 + 0.02 * nrm(ks[23], (D,)),
    }


def reference(x, c, ada_w, ada_b, norm1_g, w_in, pool_w, pool_scale, cmp_pos, cmp_w1, cmp_b1,
              cmp_w2, w_up_pool, w_up_attn, w_out, norm2_g, router_g_w, router_g_b,
              router_e_w, router_e_b, exp_w_gate, exp_w_up, exp_w_down, final_g):
    for l in range(DEPTH):
        mod = c @ ada_w[l] + ada_b[l]
        sh1, sc1, g1, sh2, sc2, g2 = [m[:, None, :] for m in jnp.split(mod, 6, axis=-1)]
        h = rmsnorm(x, norm1_g[l]) * (1.0 + sc1) + sh1
        x = x + g1 * token_mixer(h, w_in[l], pool_w[l], pool_scale[l], cmp_pos[l], cmp_w1[l],
                                 cmp_b1[l], cmp_w2[l], w_up_pool[l], w_up_attn[l], w_out[l])
        h = rmsnorm(x, norm2_g[l]) * (1.0 + sc2) + sh2
        x = x + g2 * hier_moe(h, router_g_w[l], router_g_b[l], router_e_w[l], router_e_b[l],
                              exp_w_gate[l], exp_w_up[l], exp_w_down[l])
    return rmsnorm(x, final_g)
```

```cpp
#include <hip/hip_runtime.h>
#include <cstdio>
#include <cstdint>

#define GAS __attribute__((address_space(1)))
#define LAS __attribute__((address_space(3)))
typedef unsigned short bf16_t;
typedef short bf16x8 __attribute__((ext_vector_type(8)));
typedef short s16x4 __attribute__((ext_vector_type(4)));
typedef float f32x2 __attribute__((ext_vector_type(2)));
typedef float f32x4 __attribute__((ext_vector_type(4)));
typedef float f32x16 __attribute__((ext_vector_type(16)));
typedef unsigned u32x2 __attribute__((ext_vector_type(2)));
typedef unsigned u32x4 __attribute__((ext_vector_type(4)));

#ifndef DBG_MOE_SCALE
#define DBG_MOE_SCALE 1.0f
#endif
constexpr int NB = 32, SEQ = 2048, D = 1024, NTOK = NB * SEQ;
constexpr int NEXP = 32, EFF = 512;
constexpr int NWAVES = 8;
constexpr float EPS = 1e-6f;
constexpr float LOG2E = 1.4426950408889634f;
constexpr float QSCALE = 0.125f * LOG2E;
constexpr float NEGBIG = -1e30f;

constexpr size_t MiB = 1u << 20;
constexpr size_t WS_CTL = 0, CTL_ZERO_BYTES = 1 * MiB;
constexpr size_t WS_MOD = 1 * MiB;
constexpr size_t WS_BIAS1 = WS_MOD + 768 * 1024;
constexpr size_t WS_W2C = WS_BIAS1 + 4096;
constexpr size_t WS_SLOTW = 2 * MiB;
constexpr size_t WS_LIST = 3 * MiB;
constexpr size_t WS_W1C = 11 * MiB;
constexpr size_t WS_WA = 13 * MiB;
constexpr size_t WS_WP = 14 * MiB;
constexpr size_t WS_WOUT = 15 * MiB;
constexpr size_t WS_WIN = 17 * MiB;
constexpr size_t WS_WGU = 25 * MiB;
constexpr size_t WS_WD = 89 * MiB;
constexpr size_t WS_H = 128 * MiB;
constexpr size_t WS_U = 256 * MiB;
constexpr size_t WS_Q = 320 * MiB;
constexpr size_t WS_KC = 384 * MiB;
constexpr size_t WS_VC = 400 * MiB;
constexpr size_t WS_KS = 416 * MiB;
constexpr size_t WS_VST = 432 * MiB;
constexpr size_t WS_KW = 448 * MiB;
constexpr size_t WS_VWT = 464 * MiB;
constexpr size_t WS_MG = 480 * MiB;
constexpr size_t WS_BG = 736 * MiB;
constexpr size_t WS_HID = 740 * MiB;
constexpr size_t WS_KCMP = 748 * MiB;
constexpr size_t WS_VCMPT = 749 * MiB;
constexpr size_t WS_P = 752 * MiB;
constexpr size_t WS_T1 = 816 * MiB;
constexpr size_t WS_H2 = 256 * MiB;
constexpr size_t WS_HE = 384 * MiB;
constexpr size_t WS_Y = 512 * MiB;
constexpr size_t WS_END = 944 * MiB;
constexpr int CW_BAR = 4096;
constexpr int CW_CNT = 8192;

constexpr int RING_BYTES = 131072;
constexpr int LDS_ROUTER_W = 36 * 1024 * 4;
constexpr int RT_OFF = LDS_ROUTER_W;
constexpr int MISC_OFF = 153600;
constexpr int LDS_BYTES = 155648;

typedef __bf16 bf16x2_t __attribute__((ext_vector_type(2)));
__device__ __forceinline__ unsigned cvt_pk_bf16(float lo, float hi) { const f32x2 v = {lo, hi}; const bf16x2_t b = __builtin_convertvector(v, bf16x2_t); return __builtin_bit_cast(unsigned, b); }
__device__ __forceinline__ float bf_lo(unsigned u) { return __uint_as_float(u << 16); }
__device__ __forceinline__ float bf_hi(unsigned u) { return __uint_as_float(u & 0xffff0000u); }
__device__ __forceinline__ float bf1(bf16_t b) { return __uint_as_float((unsigned)b << 16); }
__device__ __forceinline__ float fast_exp2(float x) { return __builtin_amdgcn_exp2f(x); }
__device__ __forceinline__ float fast_rcp(float x) { return __builtin_amdgcn_rcpf(x); }
__device__ __forceinline__ float sigmoidf_(float x) { return fast_rcp(1.0f + fast_exp2(-x * LOG2E)); }
__device__ __forceinline__ float gelu_tanh(float x) { const float u = 0.7978845608028654f * (x + 0.044715f * x * x * x); return x * fast_rcp(1.0f + fast_exp2(-2.0f * LOG2E * u)); }
__device__ __forceinline__ float wave_sum(float v) {
#pragma unroll
    for (int o = 1; o < 64; o <<= 1) v += __shfl_xor(v, o);
    return v;
}
#define LDS_WAIT() asm volatile("s_waitcnt lgkmcnt(0)" ::: "memory")
#define VM_WAIT() asm volatile("s_waitcnt vmcnt(0)" ::: "memory")
namespace pg8 {
constexpr int BM = 256, BK = 64, HALF = 128, HTB = HALF * BK * 2, STAGE_BYTES = 8 * HTB;
__host__ __device__ __forceinline__ int lds_byte(int r, int c) { const int st = (r >> 4) * 2 + (c >> 5), rr = r & 15, cc = c & 31, ob = rr * 64 + cc * 2; return st * 1024 + (ob ^ (((ob >> 9) & 1) << 5)); }
__host__ __device__ __forceinline__ void stage_rc(int b, int& R, int& C) { const int st = b / 1024, sb = b % 1024, swz = sb ^ (((sb >> 9) & 1) << 5); R = (st >> 1) * 16 + swz / 64; C = (st & 1) * 32 + (swz % 64) / 2; }
__host__ __device__ __forceinline__ int perm32(int rho) { const int n = rho >> 4, i = rho & 15; return 8 * (i >> 2) + 4 * n + (i & 3); }

struct Unit { const char* A; const char* B; int pm, pn, e, nrows; };

struct StaticOrder {
    int nM, nN, nwg, G, c;
    __device__ void init(int M, int N, int G_, int c_) { nM = M / BM; nN = N / BM; nwg = nM * nN; G = G_; c = c_; }
    __device__ bool next(int i, int& pm, int& pn) const {
        const long L = (long)i * G + c; if (L >= nwg) return false;
        int wgid = (int)L; { const int q = nwg / 8, r = nwg % 8, xcd = wgid % 8, off = wgid / 8; wgid = (xcd < r ? xcd * (q + 1) : r * (q + 1) + (xcd - r) * q) + off; }
        const int nig = 8 * nN, gid = wgid / nig, fm = gid * 8, gsz = (nM - fm) < 8 ? (nM - fm) : 8;
        pm = fm + ((wgid % nig) % gsz); pn = (wgid % nig) / gsz; return true;
    }
};

template <class Epi, class Sched>
__device__ __forceinline__ void gemm_phase(LAS unsigned char* lds, const int K, const Sched& S, const Epi& E) {
    const int tid = threadIdx.x, wid = __builtin_amdgcn_readfirstlane(tid >> 6), lane = tid & 63, wr = wid >> 2, wc = wid & 3, fr = lane & 15, fq = lane >> 4;
    const int nt = K / BK;
    int Rr[2], Cc[2];
    unsigned voffB[2];
#pragma unroll
    for (int i = 0; i < 2; ++i) { int R, C; stage_rc(tid * 16 + i * 8192, R, C); Rr[i] = R; Cc[i] = C; const int Rb = Epi::PERM ? ((R & ~31) + perm32(R & 31)) : R; voffB[i] = (unsigned)(Rb * K + C) * 2u; }
    const size_t kstep = (size_t)(BK * 2);
    const size_t hstepB = (size_t)HALF * K * 2;
    const unsigned ldsw = (unsigned)wid * 1024u;
    const int aoff = lds_byte(wr * 64 + fr, fq * 8), boff = lds_byte(wc * 32 + fr, fq * 8);
#define PG8_SA(b, h) (((b) * 2 + (h)) * HTB)
#define PG8_SB(b, h) ((4 + (b) * 2 + (h)) * HTB)
#define PG8_STAGE2(bufoff, gbase, v0, v1) do { \
        __builtin_amdgcn_global_load_lds((const unsigned*)((const char*)(gbase) + (v0)), (LAS unsigned*)(lds + (bufoff) + ldsw), 16, 0, 0); \
        __builtin_amdgcn_global_load_lds((const unsigned*)((const char*)(gbase) + (v1)), (LAS unsigned*)(lds + (bufoff) + ldsw + 8192), 16, 0, 0); } while (0)
#define PG8_STAGEB(bufoff, gbase) PG8_STAGE2(bufoff, gbase, voffB[0], voffB[1])
#define PG8_LDA(dst, b, h) do { _Pragma("unroll") for (int m = 0; m < 4; ++m) _Pragma("unroll") for (int k = 0; k < 2; ++k) dst[m][k] = *(const LAS bf16x8*)(lds + PG8_SA(b, h) + aoff + m * 2048 + k * 1024); } while (0)
#define PG8_LDB(dst, b, h) do { _Pragma("unroll") for (int n = 0; n < 2; ++n) _Pragma("unroll") for (int k = 0; k < 2; ++k) dst[n][k] = *(const LAS bf16x8*)(lds + PG8_SB(b, h) + boff + n * 2048 + k * 1024); } while (0)
#define PG8_MMA(ai, bj, At, Bt) do { __builtin_amdgcn_s_setprio(1); _Pragma("unroll") for (int m = 0; m < 4; ++m) _Pragma("unroll") for (int n = 0; n < 2; ++n) _Pragma("unroll") for (int k = 0; k < 2; ++k) \
        acc[ai][bj][m][n] = __builtin_amdgcn_mfma_f32_16x16x32_bf16(Bt[n][k], At[m][k], acc[ai][bj][m][n], 0, 0, 0); __builtin_amdgcn_s_setprio(0); } while (0)
#define PG8_WAIT_V(n) asm volatile("s_waitcnt vmcnt(" #n ")" ::: "memory")
#define PG8_WAIT_L(n) asm volatile("s_waitcnt lgkmcnt(" #n ")" ::: "memory")
#define PG8_BAR __builtin_amdgcn_s_barrier()
#define PG8_SCHED __builtin_amdgcn_sched_barrier(0)
    Unit cur, nxt; int ui = 0;
    if (!S.next(0, cur)) return;
    f32x4 acc[2][2][4][2];
#pragma unroll
    for (int a = 0; a < 2; ++a)
#pragma unroll
        for (int b = 0; b < 2; ++b)
#pragma unroll
            for (int m = 0; m < 4; ++m)
#pragma unroll
                for (int n = 0; n < 2; ++n) acc[a][b][m][n] = (f32x4){0.f, 0.f, 0.f, 0.f};
    bf16x8 At[4][2], B0[2][2], B1[2][2];
    unsigned c00, c01, c10, c11, n00, n01, n10, n11;
    c00 = S.aoff(cur, Rr[0]) + (unsigned)Cc[0] * 2u; c01 = S.aoff(cur, Rr[1]) + (unsigned)Cc[1] * 2u;
    c10 = S.aoff(cur, Rr[0] + HALF) + (unsigned)Cc[0] * 2u; c11 = S.aoff(cur, Rr[1] + HALF) + (unsigned)Cc[1] * 2u;
    const char* cA = cur.A; const char* cB = cur.B;
    PG8_STAGEB(PG8_SB(0, 0), cB); PG8_STAGEB(PG8_SB(0, 1), cB + hstepB); PG8_STAGE2(PG8_SA(0, 0), cA, c00, c01); PG8_STAGE2(PG8_SA(0, 1), cA, c10, c11);
    if (wr == 1) PG8_BAR;
    PG8_WAIT_V(2); PG8_BAR;
    PG8_STAGEB(PG8_SB(1, 0), cB + kstep); PG8_STAGE2(PG8_SA(1, 0), cA + kstep, c00, c01); PG8_STAGEB(PG8_SB(1, 1), cB + hstepB + kstep);
    PG8_WAIT_V(6); PG8_BAR;
    for (;;) {
        const bool has_next = S.next(ui + 1, nxt);
        const char* nA = has_next ? nxt.A : cA; const char* nB = has_next ? nxt.B : cB;
        if (has_next) {
            n00 = S.aoff(nxt, Rr[0]) + (unsigned)Cc[0] * 2u; n01 = S.aoff(nxt, Rr[1]) + (unsigned)Cc[1] * 2u;
            n10 = S.aoff(nxt, Rr[0] + HALF) + (unsigned)Cc[0] * 2u; n11 = S.aoff(nxt, Rr[1] + HALF) + (unsigned)Cc[1] * 2u;
        } else { n00 = c00; n01 = c01; n10 = c10; n11 = c11; }
        for (int t = 0; t < nt; t += 2) {
            const bool last = (t == nt - 2);
            const char* a1 = cA + (size_t)(t + 1) * kstep;
            const char* a2 = last ? nA : cA + (size_t)(t + 2) * kstep; const char* b2 = last ? nB : cB + (size_t)(t + 2) * kstep;
            const char* a3 = a2 + kstep; const char* b3 = b2 + kstep;
            const unsigned x00 = last ? n00 : c00, x01 = last ? n01 : c01, x10 = last ? n10 : c10, x11 = last ? n11 : c11;
            PG8_LDB(B0, 0, 0); PG8_LDB(B1, 0, 1); PG8_SCHED; PG8_LDA(At, 0, 0); PG8_STAGE2(PG8_SA(1, 1), a1, c10, c11);
            PG8_WAIT_V(8); PG8_WAIT_L(0); PG8_BAR; PG8_MMA(0, 0, At, B0); PG8_MMA(0, 1, At, B1); PG8_BAR; PG8_SCHED;
            PG8_LDA(At, 0, 1); PG8_STAGEB(PG8_SB(0, 0), b2); PG8_STAGEB(PG8_SB(0, 1), b2 + hstepB); PG8_STAGE2(PG8_SA(0, 0), a2, x00, x01);
            PG8_WAIT_V(8); PG8_WAIT_L(0); PG8_BAR; PG8_MMA(1, 0, At, B0); PG8_MMA(1, 1, At, B1); PG8_BAR; PG8_SCHED;
            PG8_LDB(B0, 1, 0); PG8_LDB(B1, 1, 1); PG8_SCHED; PG8_LDA(At, 1, 0); PG8_STAGE2(PG8_SA(0, 1), a2, x10, x11);
            PG8_WAIT_V(8); PG8_WAIT_L(0); PG8_BAR; PG8_MMA(0, 0, At, B0); PG8_MMA(0, 1, At, B1); PG8_BAR; PG8_SCHED;
            PG8_LDA(At, 1, 1); PG8_STAGEB(PG8_SB(1, 0), b3); PG8_STAGEB(PG8_SB(1, 1), b3 + hstepB); PG8_STAGE2(PG8_SA(1, 0), a3, x00, x01);
            PG8_WAIT_V(8); PG8_WAIT_L(0); PG8_BAR; PG8_MMA(1, 0, At, B0); PG8_MMA(1, 1, At, B1); PG8_BAR; PG8_SCHED;
        }
        if (wr == 0) PG8_BAR;
        E(acc, cur, wr, wc, fr, fq);
        if (!has_next) break;
#pragma unroll
        for (int a = 0; a < 2; ++a)
#pragma unroll
            for (int b = 0; b < 2; ++b)
#pragma unroll
                for (int m = 0; m < 4; ++m)
#pragma unroll
                    for (int n = 0; n < 2; ++n) acc[a][b][m][n] = (f32x4){0.f, 0.f, 0.f, 0.f};
        cur = nxt; cA = nA; cB = nB; c00 = n00; c01 = n01; c10 = n10; c11 = n11; ++ui;
        if (wr == 1) PG8_BAR;
    }
    PG8_WAIT_V(0);
    PG8_BAR;
#undef PG8_SA
#undef PG8_SB
#undef PG8_STAGE2
#undef PG8_STAGEB
#undef PG8_LDA
#undef PG8_LDB
#undef PG8_MMA
#undef PG8_WAIT_V
#undef PG8_WAIT_L
#undef PG8_BAR
#undef PG8_SCHED
}
}
using pg8::Unit;
typedef f32x4 AccT[2][2][4][2];

__device__ __forceinline__ u32x4 pack8(const f32x4 a, const f32x4 b) { u32x4 w; w.x = cvt_pk_bf16(a[0], a[1]); w.y = cvt_pk_bf16(a[2], a[3]); w.z = cvt_pk_bf16(b[0], b[1]); w.w = cvt_pk_bf16(b[2], b[3]); return w; }
__device__ __forceinline__ void unpack8(const u32x4 w, f32x4& a, f32x4& b) { a = (f32x4){bf_lo(w.x), bf_hi(w.x), bf_lo(w.y), bf_hi(w.y)}; b = (f32x4){bf_lo(w.z), bf_hi(w.z), bf_lo(w.w), bf_hi(w.w)}; }

struct SchedPlain {
    const char* A; const char* Bt; unsigned lda; int K; pg8::StaticOrder so;
    __device__ __forceinline__ bool next(int i, Unit& u) const { int pm, pn; if (!so.next(i, pm, pn)) return false; u.pm = pm; u.pn = pn; u.e = 0; u.nrows = 256;
        u.A = A + (size_t)pm * 256 * lda; u.B = Bt + (size_t)pn * 256 * K * 2; return true; }
    __device__ __forceinline__ unsigned aoff(const Unit&, int R) const { return (unsigned)R * lda; }
};

struct EpiG1 {
    static constexpr bool PERM = true;
    bf16_t *U, *Q, *KC, *VC, *KS, *VST, *KW, *VWT, *MG, *BG;
    __device__ __forceinline__ void operator()(const AccT& acc, const Unit& u, int wr, int wc, int fr, int fq) const {
        const int pn = u.pn; const int row0 = u.pm * 256 + wr * 64 + fr; const int cc = wc * 32 + 8 * fq;
#pragma unroll
        for (int ai = 0; ai < 2; ++ai)
#pragma unroll
            for (int m = 0; m < 4; ++m) {
                const int row = row0 + ai * 128 + m * 16;
#pragma unroll
                for (int bj = 0; bj < 2; ++bj) {
                    f32x4 v0 = acc[ai][bj][m][0], v1 = acc[ai][bj][m][1];
                    const int col = 128 * bj + cc;
                    if (pn < 2) { *(u32x4*)(U + (size_t)row * 512 + pn * 256 + col) = pack8(v0, v1); }
                    else if (pn < 4) { v0 = v0 * QSCALE; v1 = v1 * QSCALE; *(u32x4*)(Q + (size_t)row * 512 + (pn - 2) * 256 + col) = pack8(v0, v1); }
                    else if (pn < 7) {
                        const int g = cc >> 6, d = cc & 63, b = row >> 11, s = row & 2047;
                        const size_t kidx = ((size_t)(b * 2 + g) * 2048 + s) * 64 + d;
                        if (bj == 0) { bf16_t* Kb = pn == 4 ? KC : (pn == 5 ? KS : KW); *(u32x4*)(Kb + kidx) = pack8(v0, v1); }
                        else if (pn == 4) { *(u32x4*)(VC + kidx) = pack8(v0, v1); }
                        else { bf16_t* Vt = (pn == 5 ? VST : VWT) + ((size_t)(b * 2 + g) * 64 + d) * 2048 + s; const u32x4 w = pack8(v0, v1);
                            Vt[0 * 2048] = (bf16_t)(w.x & 0xffff); Vt[1 * 2048] = (bf16_t)(w.x >> 16); Vt[2 * 2048] = (bf16_t)(w.y & 0xffff); Vt[3 * 2048] = (bf16_t)(w.y >> 16);
                            Vt[4 * 2048] = (bf16_t)(w.z & 0xffff); Vt[5 * 2048] = (bf16_t)(w.z >> 16); Vt[6 * 2048] = (bf16_t)(w.w & 0xffff); Vt[7 * 2048] = (bf16_t)(w.w >> 16); }
                    }
                    else if (pn < 15) {
#if !(defined(DBG_CHECK) && DBG_CHECK == 39)
#pragma unroll
                        for (int i = 0; i < 4; ++i) { v0[i] = sigmoidf_(v0[i]); v1[i] = sigmoidf_(v1[i]); }
#endif
                        *(u32x4*)(MG + (size_t)row * 2048 + (pn - 7) * 256 + col) = pack8(v0, v1); }
                    else { if (col < 32) {
#pragma unroll
                        for (int i = 0; i < 4; ++i) { v0[i] = sigmoidf_(v0[i]); v1[i] = sigmoidf_(v1[i]); }
                        *(u32x4*)(BG + (size_t)row * 32 + col) = pack8(v0, v1); } }
                }
            }
    }
};

struct SchedCmp {
    const char* KC; const char* VC; const char* W1; int c;
    __device__ __forceinline__ bool next(int i, Unit& u) const { if (i != 0 || c >= 64) return false; u.e = c >> 5; u.pm = c & 31; u.pn = 0; u.nrows = 256;
        u.A = (u.e ? VC : KC) + (size_t)u.pm * 256 * 2048; u.B = W1 + (size_t)u.e * 256 * 2048 * 2; return true; }
    __device__ __forceinline__ unsigned aoff(const Unit&, int R) const { return (unsigned)R * 2048u; }
};
struct EpiHid {
    static constexpr bool PERM = true;
    bf16_t* HID; const float* bias1;
    __device__ __forceinline__ void operator()(const AccT& acc, const Unit& u, int wr, int wc, int fr, int fq) const {
        const int row0 = u.pm * 256 + wr * 64 + fr; const int cc = wc * 32 + 8 * fq; bf16_t* H = HID + (size_t)u.e * 8192 * 256; const float* bs = bias1 + u.e * 256;
#pragma unroll
        for (int bj = 0; bj < 2; ++bj) { const int col = 128 * bj + cc; const f32x4 b0 = *(const f32x4*)(bs + col), b1 = *(const f32x4*)(bs + col + 4);
#pragma unroll
            for (int ai = 0; ai < 2; ++ai)
#pragma unroll
                for (int m = 0; m < 4; ++m) { const int row = row0 + ai * 128 + m * 16; f32x4 v0 = acc[ai][bj][m][0] + b0, v1 = acc[ai][bj][m][1] + b1;
#pragma unroll
                    for (int i = 0; i < 4; ++i) { v0[i] = gelu_tanh(v0[i]); v1[i] = gelu_tanh(v1[i]); }
                    *(u32x4*)(H + (size_t)row * 256 + col) = pack8(v0, v1); } }
    }
};

struct EpiT1 {
    static constexpr bool PERM = true;
    const bf16_t* MG; bf16_t* T1;
    __device__ __forceinline__ void operator()(const AccT& acc, const Unit& u, int wr, int wc, int fr, int fq) const {
        const int row0 = u.pm * 256 + wr * 64 + fr; const int c0 = u.pn * 256 + wc * 32 + 8 * fq;
#pragma unroll
        for (int ai = 0; ai < 2; ++ai)
#pragma unroll
            for (int m = 0; m < 4; ++m) { const int row = row0 + ai * 128 + m * 16;
#pragma unroll
                for (int bj = 0; bj < 2; ++bj) { const int col = c0 + 128 * bj; f32x4 g0, g1; unpack8(*(const u32x4*)(MG + (size_t)row * 2048 + col), g0, g1);
                    *(u32x4*)(T1 + (size_t)row * 1024 + col) = pack8(acc[ai][bj][m][0] * g0, acc[ai][bj][m][1] * g1); } }
    }
};
struct EpiMix {
    static constexpr bool PERM = true;
    const bf16_t* MG; const bf16_t* T1; bf16_t* MIX;
    __device__ __forceinline__ void operator()(const AccT& acc, const Unit& u, int wr, int wc, int fr, int fq) const {
        const int row0 = u.pm * 256 + wr * 64 + fr; const int c0 = u.pn * 256 + wc * 32 + 8 * fq;
#pragma unroll
        for (int ai = 0; ai < 2; ++ai)
#pragma unroll
            for (int m = 0; m < 4; ++m) { const int row = row0 + ai * 128 + m * 16;
#pragma unroll
                for (int bj = 0; bj < 2; ++bj) { const int col = c0 + 128 * bj; f32x4 g0, g1, t0, t1; unpack8(*(const u32x4*)(MG + (size_t)row * 2048 + 1024 + col), g0, g1);
                    unpack8(*(const u32x4*)(T1 + (size_t)row * 1024 + col), t0, t1);
                    *(u32x4*)(MIX + (size_t)row * 1024 + col) = pack8(acc[ai][bj][m][0] * g0 + t0, acc[ai][bj][m][1] * g1 + t1); } }
    }
};
struct EpiX1 {
    static constexpr bool PERM = false;
    const float* X; const float* MOD; float* X1;
    __device__ __forceinline__ void operator()(const AccT& acc, const Unit& u, int wr, int wc, int fr, int fq) const {
        const int row0 = u.pm * 256 + wr * 64 + fr; const int c0 = u.pn * 256 + wc * 32 + 4 * fq; const int b = (u.pm * 256) >> 11;
        const float* g1 = MOD + (size_t)b * 6144 + 2048;
#pragma unroll
        for (int bj = 0; bj < 2; ++bj)
#pragma unroll
            for (int n = 0; n < 2; ++n) { const int col = c0 + 128 * bj + 16 * n; const f32x4 gv = *(const f32x4*)(g1 + col);
#pragma unroll
                for (int ai = 0; ai < 2; ++ai)
#pragma unroll
                    for (int m = 0; m < 4; ++m) { const size_t off = (size_t)(row0 + ai * 128 + m * 16) * 1024 + col;
                        *(f32x4*)(X1 + off) = *(const f32x4*)(X + off) + gv * acc[ai][bj][m][n]; } }
    }
};

struct SchedMoe {
    const char* A; const char* W; const unsigned* LIST; const LAS unsigned* tcnt; const LAS unsigned* tbase; unsigned lda; size_t wstride; int K; int G, c; bool by_token;
    __device__ __forceinline__ bool next(int i, Unit& u) const {
        const long L = (long)i * G + c; const int total = (int)tbase[32] * 4; if (L >= total) return false;
        const int pn = (int)L & 3, tau = (int)L >> 2; int e = 0;
#pragma unroll 1
        for (int j = 1; j < 32; ++j) if ((int)tbase[j] <= tau) e = j;
        const int tile = tau - (int)tbase[e]; const int cnt = (int)tcnt[e];
        u.e = e; u.pm = tile; u.pn = pn; u.nrows = (cnt - tile * 256) < 256 ? (cnt - tile * 256) : 256;
        u.A = A; u.B = W + (size_t)e * wstride + (size_t)pn * 256 * K * 2; return true; }
    __device__ __forceinline__ unsigned slot(const Unit& u, int R) const { const int r = R < u.nrows ? R : u.nrows - 1; return LIST[(size_t)u.e * 65536 + u.pm * 256 + r]; }
    __device__ __forceinline__ unsigned aoff(const Unit& u, int R) const { const unsigned s = slot(u, R); return (by_token ? (s >> 1) : s) * lda; }
};
struct EpiHE {
    static constexpr bool PERM = true;
    bf16_t* HE; const unsigned* LIST;
    __device__ __forceinline__ void operator()(const AccT& acc, const Unit& u, int wr, int wc, int fr, int fq) const {
        const int cc = u.pn * 128 + wc * 32 + 8 * fq;
#pragma unroll
        for (int ai = 0; ai < 2; ++ai)
#pragma unroll
            for (int m = 0; m < 4; ++m) { const int R = ai * 128 + wr * 64 + m * 16 + fr;
                if (R < u.nrows) { const unsigned s = LIST[(size_t)u.e * 65536 + u.pm * 256 + R]; f32x4 g0 = acc[ai][0][m][0], g1 = acc[ai][0][m][1]; const f32x4 u0 = acc[ai][1][m][0], u1 = acc[ai][1][m][1];
#pragma unroll
                    for (int i = 0; i < 4; ++i) { g0[i] = g0[i] * sigmoidf_(g0[i]) * u0[i]; g1[i] = g1[i] * sigmoidf_(g1[i]) * u1[i]; }
                    *(u32x4*)(HE + (size_t)s * 512 + cc) = pack8(g0, g1); } }
    }
};
struct EpiY {
    static constexpr bool PERM = true;
    bf16_t* Y; const unsigned* LIST; const float* SLOTW;
    __device__ __forceinline__ void operator()(const AccT& acc, const Unit& u, int wr, int wc, int fr, int fq) const {
        const int c0 = u.pn * 256 + wc * 32 + 8 * fq;
#pragma unroll
        for (int ai = 0; ai < 2; ++ai)
#pragma unroll
            for (int m = 0; m < 4; ++m) { const int R = ai * 128 + wr * 64 + m * 16 + fr;
                if (R < u.nrows) { const unsigned s = LIST[(size_t)u.e * 65536 + u.pm * 256 + R]; const float w = SLOTW[s];
#pragma unroll
                    for (int bj = 0; bj < 2; ++bj) *(u32x4*)(Y + (size_t)s * 1024 + c0 + 128 * bj) = pack8(acc[ai][bj][m][0] * w, acc[ai][bj][m][1] * w); } }
    }
};
struct Args { const float* in[24]; float* out; unsigned char* ws; int ph_lo, ph_hi; };
struct Frame {
    LAS unsigned char* lds;
    unsigned char* ws;
    float* out;
    int tid, lane, wave, vcu, G;
};
#define WSP(T, off) ((T*)(F.ws + (off)))

__device__ __forceinline__ void p0_transpose_item(const float* W, int ldw, int nvalid, bf16_t* dst, int ldd, LAS float* scr, int lane) {
#pragma unroll 8
    for (int i = 0; i < 32; ++i) { const int kk = 2 * i + (lane >> 5), c = lane & 31; scr[kk * 33 + c] = c < nvalid ? W[(size_t)kk * ldw + c] : 0.f; }
    LDS_WAIT(); asm volatile("" ::: "memory");
    const int c8 = lane & 7;
#pragma unroll
    for (int j = 0; j < 4; ++j) { const int n = (lane >> 3) + 8 * j; const LAS float* s = scr + (8 * c8) * 33 + n;
        u32x4 o; o.x = cvt_pk_bf16(s[0 * 33], s[1 * 33]); o.y = cvt_pk_bf16(s[2 * 33], s[3 * 33]); o.z = cvt_pk_bf16(s[4 * 33], s[5 * 33]); o.w = cvt_pk_bf16(s[6 * 33], s[7 * 33]);
        *(u32x4*)(dst + (size_t)n * ldd + 8 * c8) = o; }
    LDS_WAIT(); asm volatile("" ::: "memory");
}
__device__ __forceinline__ void p0_prologue(Frame& F, const Args& AR) {
    const float* c_in = AR.in[1]; const float* ada_w = AR.in[2]; const float* ada_b = AR.in[3];
    const float* w_in = AR.in[5]; const float* pool_w = AR.in[6]; const float* pool_scale = AR.in[7]; const float* cmp_pos = AR.in[8]; const float* cmp_w1 = AR.in[9];
    const float* cmp_b1 = AR.in[10]; const float* cmp_w2 = AR.in[11]; const float* w_up_pool = AR.in[12]; const float* w_up_attn = AR.in[13]; const float* w_out = AR.in[14];
    const float* wg = AR.in[20]; const float* wu = AR.in[21]; const float* wd = AR.in[22];
    if (F.vcu < 104) {
        LAS float* red = (LAS float*)F.lds;
        const int item = F.vcu;
        if (item < 96) {
            const int n = item * 64 + F.lane; float acc[32];
#pragma unroll
            for (int b = 0; b < 32; ++b) acc[b] = 0.f;
            const int k0 = F.wave * 128;
            for (int k = k0; k < k0 + 128; k += 4) {
                float w[4];
#pragma unroll
                for (int q = 0; q < 4; ++q) w[q] = ada_w[(size_t)(k + q) * 6144 + n];
#pragma unroll
                for (int b = 0; b < 32; ++b) { const f32x4 cv = *(const f32x4*)(c_in + b * 1024 + k); acc[b] += cv[0] * w[0] + cv[1] * w[1] + cv[2] * w[2] + cv[3] * w[3]; }
            }
#pragma unroll
            for (int b = 0; b < 32; ++b) red[(F.wave * 32 + b) * 64 + F.lane] = acc[b];
            __syncthreads();
            for (int o = F.tid; o < 2048; o += 512) { float s = 0.f;
#pragma unroll
                for (int w = 0; w < 8; ++w) s += red[w * 2048 + o];
                const int b = o >> 6, nn = item * 64 + (o & 63); WSP(float, WS_MOD)[b * 6144 + nn] = s + ada_b[nn]; }
            __syncthreads();
        } else {
            const int it = item - 96, i = it >> 2, n = (it & 3) * 64 + F.lane; float acc = 0.f; const int k0 = F.wave * 256;
            for (int k = k0; k < k0 + 256; ++k) acc += cmp_pos[i * 2048 + k] * cmp_w1[((size_t)i * 2048 + k) * 256 + n];
            red[F.wave * 64 + F.lane] = acc;
            __syncthreads();
            if (F.tid < 64) { float s = 0.f;
#pragma unroll
                for (int w = 0; w < 8; ++w) s += red[w * 64 + F.tid];
                const int nn = (it & 3) * 64 + F.tid; WSP(float, WS_BIAS1)[i * 256 + nn] = s + cmp_b1[i * 256 + nn]; }
            __syncthreads();
        }
    }
    LAS float* scr = (LAS float*)(F.lds + F.wave * 16384);
    const int gw = F.vcu * NWAVES + F.wave, NGW = F.G * NWAVES;
    constexpr int T_IN = 16 * 128, T_GU = 32 * 512, T_D = 32 * 256, T_A = 256, T_OUT = 512, T_W1C = 512, T_W2C = 16, T_WP = 512;
    constexpr int NITEMS = T_IN + T_GU + T_D + T_A + T_OUT + T_W1C + T_W2C + T_WP;
    for (int it = gw; it < NITEMS; it += NGW) {
        int r = it;
        if (r < T_GU) { const int e = r >> 9, rr = r & 511, kb = rr >> 5, nb = rr & 31, n0 = 32 * nb, tile = n0 >> 8, bj = (n0 >> 7) & 1, c0 = n0 & 127;
            const float* src = (bj ? wu : wg) + (size_t)e * 1024 * 512 + (size_t)(64 * kb) * 512 + tile * 128 + c0;
            p0_transpose_item(src, 512, 32, WSP(bf16_t, WS_WGU) + (size_t)e * 1024 * 1024 + (size_t)n0 * 1024 + 64 * kb, 1024, scr, F.lane); continue; } r -= T_GU;
        if (r < T_D) { const int e = r >> 8, rr = r & 255, kb = rr >> 5, nb = rr & 31;
            p0_transpose_item(wd + (size_t)e * 512 * 1024 + (size_t)(64 * kb) * 1024 + 32 * nb, 1024, 32, WSP(bf16_t, WS_WD) + (size_t)e * 1024 * 512 + (size_t)(32 * nb) * 512 + 64 * kb, 512, scr, F.lane); continue; } r -= T_D;
        if (r < T_IN) { const int kb = r >> 7, nb = r & 127, n0 = 32 * nb; int src0, nv;
            if (n0 < 1792) { src0 = n0; nv = 32; } else if (n0 < 3840) { src0 = n0 + 24; nv = 32; } else if (n0 == 3840) { src0 = 1792; nv = 24; } else { src0 = 0; nv = 0; }
            p0_transpose_item(w_in + (size_t)(64 * kb) * 3864 + src0, 3864, nv, WSP(bf16_t, WS_WIN) + (size_t)n0 * 1024 + 64 * kb, 1024, scr, F.lane); continue; } r -= T_IN;
        if (r < T_A) { const int kb = r >> 5, nb = r & 31;
            p0_transpose_item(w_up_attn + (size_t)(64 * kb) * 1024 + 32 * nb, 1024, 32, WSP(bf16_t, WS_WA) + (size_t)(32 * nb) * 512 + 64 * kb, 512, scr, F.lane); continue; } r -= T_A;
        if (r < T_OUT) { const int kb = r >> 5, nb = r & 31;
            p0_transpose_item(w_out + (size_t)(64 * kb) * 1024 + 32 * nb, 1024, 32, WSP(bf16_t, WS_WOUT) + (size_t)(32 * nb) * 1024 + 64 * kb, 1024, scr, F.lane); continue; } r -= T_OUT;
        if (r < T_W1C) { const int i = r >> 8, rr = r & 255, kb = rr >> 3, nb = rr & 7;
            p0_transpose_item(cmp_w1 + (size_t)i * 2048 * 256 + (size_t)(64 * kb) * 256 + 32 * nb, 256, 32, WSP(bf16_t, WS_W1C) + (size_t)i * 256 * 2048 + (size_t)(32 * nb) * 2048 + 64 * kb, 2048, scr, F.lane); continue; } r -= T_W1C;
        if (r < T_W2C) { const int i = r >> 3, rr = r & 7, kb = rr >> 1, nb = rr & 1;
            p0_transpose_item(cmp_w2 + (size_t)i * 256 * 64 + (size_t)(64 * kb) * 64 + 32 * nb, 64, 32, WSP(bf16_t, WS_W2C) + (size_t)i * 64 * 256 + (size_t)(32 * nb) * 256 + 64 * kb, 256, scr, F.lane); continue; } r -= T_W2C;
        {
            const int gi = r >> 7, rr = r & 127, nblk = rr >> 3, c0 = (rr & 7) * 16, n = 64 * nblk + F.lane; float acc[16];
#pragma unroll
            for (int c = 0; c < 16; ++c) acc[c] = 0.f;
            for (int d = 0; d < 128; ++d) { const float wv = pool_scale[gi * 128 + d] * w_up_pool[(size_t)(gi * 128 + d) * 1024 + n];
#pragma unroll
                for (int c = 0; c < 16; ++c) acc[c] += pool_w[(size_t)(gi * 128 + c0 + c) * 128 + d] * wv; }
            u32x4 o0, o1; o0.x = cvt_pk_bf16(acc[0], acc[1]); o0.y = cvt_pk_bf16(acc[2], acc[3]); o0.z = cvt_pk_bf16(acc[4], acc[5]); o0.w = cvt_pk_bf16(acc[6], acc[7]);
            o1.x = cvt_pk_bf16(acc[8], acc[9]); o1.y = cvt_pk_bf16(acc[10], acc[11]); o1.z = cvt_pk_bf16(acc[12], acc[13]); o1.w = cvt_pk_bf16(acc[14], acc[15]);
            bf16_t* dst = WSP(bf16_t, WS_WP) + (size_t)n * 512 + gi * 128 + c0; *(u32x4*)dst = o0; *(u32x4*)(dst + 8) = o1;
        }
    }
}

__device__ __forceinline__ void p1_norm_mod(Frame& F, const Args& AR) {
    const float* x = AR.in[0]; const float* g1n = AR.in[4]; const float* MOD = WSP(float, WS_MOD); bf16_t* H = WSP(bf16_t, WS_H);
    const int gw = F.vcu * NWAVES + F.wave, NGW = F.G * NWAVES;
    for (int q = gw; q < NTOK / 32; q += NGW) {
        const int b = q >> 6; f32x4 Av[4], Bv[4];
#pragma unroll
        for (int j = 0; j < 4; ++j) { const int col = 4 * F.lane + 256 * j; const f32x4 g = *(const f32x4*)(g1n + col), sc = *(const f32x4*)(MOD + b * 6144 + 1024 + col); Av[j] = g * (sc + 1.0f); Bv[j] = *(const f32x4*)(MOD + b * 6144 + col); }
        for (int r = 0; r < 32; ++r) {
            const size_t row = (size_t)q * 32 + r; const f32x4* xr = (const f32x4*)(x + row * 1024) + F.lane; f32x4 v[4]; float s = 0.f;
#pragma unroll
            for (int j = 0; j < 4; ++j) { v[j] = xr[64 * j]; s += (v[j][0] * v[j][0] + v[j][1] * v[j][1]) + (v[j][2] * v[j][2] + v[j][3] * v[j][3]); }
            const float rs = rsqrtf(wave_sum(s) * (1.0f / 1024.0f) + EPS);
            u32x2* o = (u32x2*)(H + row * 1024) + F.lane;
#pragma unroll
            for (int j = 0; j < 4; ++j) { const f32x4 h = v[j] * rs * Av[j] + Bv[j]; u32x2 w; w.x = cvt_pk_bf16(h[0], h[1]); w.y = cvt_pk_bf16(h[2], h[3]); o[64 * j] = w; }
        }
    }
}

__device__ __forceinline__ void p3_pool(Frame& F, int widx, int nw) {
    const bf16_t* U = WSP(bf16_t, WS_U); bf16_t* P = WSP(bf16_t, WS_P);
    const int gi = F.lane >> 4, w = 2 << gi;
    for (int run = widx; run < NTOK / 16; run += nw) {
        const int t0 = run * 16, tb0 = t0 & 2047; float sum[8];
#pragma unroll
        for (int i = 0; i < 8; ++i) sum[i] = 0.f;
        const bf16_t* up = U + (size_t)t0 * 512 + F.lane * 8;
        for (int d = 1; d <= w; ++d) if (tb0 - d >= 0) { f32x4 a, b; unpack8(*(const u32x4*)(up - (ptrdiff_t)d * 512), a, b);
#pragma unroll
            for (int i = 0; i < 4; ++i) { sum[i] += a[i]; sum[4 + i] += b[i]; } }
        for (int i = 0; i < 16; ++i) { const int tb = tb0 + i; f32x4 a, b; unpack8(*(const u32x4*)(up + (size_t)i * 512), a, b);
#pragma unroll
            for (int k = 0; k < 4; ++k) { sum[k] += a[k]; sum[4 + k] += b[k]; }
            if (tb - w >= 0) { f32x4 c, d; unpack8(*(const u32x4*)(up + (ptrdiff_t)(i - w) * 512), c, d);
#pragma unroll
                for (int k = 0; k < 4; ++k) { sum[k] -= c[k]; sum[4 + k] -= d[k]; } }
            const float inv = 1.0f / (float)((tb + 1) < w ? (tb + 1) : w); f32x4 o0, o1;
#pragma unroll
            for (int k = 0; k < 4; ++k) { o0[k] = sum[k] * inv - a[k]; o1[k] = sum[4 + k] * inv - b[k]; }
            *(u32x4*)(P + (size_t)(t0 + i) * 512 + F.lane * 8) = pack8(o0, o1); }
    }
}

__device__ __forceinline__ void p3_cmp2(Frame& F, int which, int pm) {
    const bf16_t* H = WSP(bf16_t, WS_HID) + (size_t)which * 8192 * 256; const bf16_t* W2 = WSP(bf16_t, WS_W2C) + (size_t)which * 64 * 256;
    const int l16 = F.lane & 15, kq = F.lane >> 4; const int rbase = pm * 256 + F.wave * 32;
#pragma unroll
    for (int rb = 0; rb < 2; ++rb) {
        bf16x8 hf[8];
#pragma unroll
        for (int ks = 0; ks < 8; ++ks) hf[ks] = *(const bf16x8*)(H + (size_t)(rbase + rb * 16 + l16) * 256 + 32 * ks + 8 * kq);
#pragma unroll
        for (int cb = 0; cb < 4; ++cb) {
            f32x4 acc = (f32x4){0.f, 0.f, 0.f, 0.f};
#pragma unroll
            for (int ks = 0; ks < 8; ++ks) { const bf16x8 wf = *(const bf16x8*)(W2 + (size_t)(cb * 16 + l16) * 256 + 32 * ks + 8 * kq);
                if (which == 0) acc = __builtin_amdgcn_mfma_f32_16x16x32_bf16(wf, hf[ks], acc, 0, 0, 0);
                else acc = __builtin_amdgcn_mfma_f32_16x16x32_bf16(hf[ks], wf, acc, 0, 0, 0); }
            u32x2 w;
            if (which == 0) { const int row = rbase + rb * 16 + l16; const bool pad = (row & 127) == 127; w.x = pad ? 0u : cvt_pk_bf16(acc[0], acc[1]); w.y = pad ? 0u : cvt_pk_bf16(acc[2], acc[3]);
                *(u32x2*)(WSP(bf16_t, WS_KCMP) + (size_t)row * 64 + cb * 16 + 4 * kq) = w; }
            else { const int row0 = rbase + rb * 16 + 4 * kq; const int bg = row0 >> 7, n0 = row0 & 127, d = cb * 16 + l16; if (n0 + 3 == 127) acc[3] = 0.f;
                w.x = cvt_pk_bf16(acc[0], acc[1]); w.y = cvt_pk_bf16(acc[2], acc[3]); *(u32x2*)(WSP(bf16_t, WS_VCMPT) + ((size_t)bg * 64 + d) * 128 + n0) = w; }
        }
    }
}
namespace nsa {
constexpr int KB0 = 0, VB0 = 8192, KB1 = 16384, VB1 = 24576, PS_OFF = 32768;
__device__ __forceinline__ float pmax32(float m) { auto rr = __builtin_amdgcn_permlane32_swap(__float_as_uint(m), __float_as_uint(m), false, false); return fmaxf(__uint_as_float(rr[0]), __uint_as_float(rr[1])); }
__device__ __forceinline__ float psum32(float m) { auto rr = __builtin_amdgcn_permlane32_swap(__float_as_uint(m), __float_as_uint(m), false, false); return __uint_as_float(rr[0]) + __uint_as_float(rr[1]); }

struct Ptrs { bf16_t* Q; bf16_t* O; const bf16_t *KS, *VST, *KW, *VWT, *KCMP, *VCMPT, *BG; };

__device__ __forceinline__ void attn_unit(LAS unsigned char* lds, const Ptrs& T, const int b, const int g, const int ci, const int wid, const int lane) {
    const int r32 = lane & 31, hi = lane >> 5, hh = wid >> 1, qh = wid & 1;
    const int qloc = 32 * qh + r32, t = 64 * ci + qloc, bg = b * 2 + g;
    const size_t row = (size_t)b * SEQ + t;
    const int sR = 8 * wid + (lane >> 3), sch = (lane & 7) ^ ((sR >> 1) & 7);
    const unsigned kst = (unsigned)(sR * 128 + sch * 16);
    const unsigned vst_c = (unsigned)(sch * 16);
    const int xr = (r32 >> 1) & 7;
    unsigned kofs[4], vofs[8];
#pragma unroll
    for (int s = 0; s < 4; ++s) kofs[s] = (unsigned)(r32 * 128 + (((2 * s + hi) ^ xr) << 4));
#pragma unroll
    for (int c = 0; c < 8; ++c) vofs[c] = (unsigned)(r32 * 128 + ((c ^ xr) << 4) + 8 * hi);
    bf16_t* qp = T.Q + row * 512 + (g * 4 + hh) * 64; bf16_t* op = T.O + row * 512 + (g * 4 + hh) * 64;
    bf16x8 qr[4];
#pragma unroll
    for (int s = 0; s < 4; ++s) qr[s] = *(const bf16x8*)(qp + 16 * s + 8 * hi);
    const bf16_t* bgp = T.BG + row * 32 + g * 4 + hh;
    const float gate_c = bf1(bgp[0]), gate_s = bf1(bgp[8]), gate_w = bf1(bgp[16]);

    const int ntc = ci >= 16 ? 2 : 1, nsel = ci + 1, nwin = (ci < 8 ? ci : 8) + 1, nsteps = ntc + nsel + nwin;
    const bf16_t* kcmp = T.KCMP + (size_t)bg * 128 * 64; const bf16_t* vcmp = T.VCMPT + (size_t)bg * 64 * 128;
    const bf16_t* ksel = T.KS + (size_t)bg * 2048 * 64;  const bf16_t* vsel = T.VST + (size_t)bg * 64 * 2048;
    const bf16_t* kwin = T.KW + (size_t)bg * 2048 * 64;  const bf16_t* vwin = T.VWT + (size_t)bg * 64 * 2048;
#define NSA_ISSUE(st_, bufsel_) do { const int s_ = (st_); const char* kp_; const char* vp_; unsigned vs_; \
        if (s_ < ntc) { kp_ = (const char*)(kcmp + s_ * 64 * 64); vp_ = (const char*)(vcmp + s_ * 64); vs_ = 256u; } \
        else if (s_ < ntc + nsel) { const int j_ = s_ - ntc; kp_ = (const char*)(ksel + (size_t)j_ * 64 * 64); vp_ = (const char*)(vsel + j_ * 64); vs_ = 4096u; } \
        else { const int j_ = ci - (s_ - ntc - nsel); kp_ = (const char*)(kwin + (size_t)j_ * 64 * 64); vp_ = (const char*)(vwin + j_ * 64); vs_ = 4096u; } \
        const int kb_ = (bufsel_) ? KB1 : KB0, vb_ = (bufsel_) ? VB1 : VB0; \
        __builtin_amdgcn_global_load_lds((const unsigned*)(kp_ + kst), (LAS unsigned*)(lds + kb_ + wid * 1024), 16, 0, 0); \
        __builtin_amdgcn_global_load_lds((const unsigned*)(vp_ + (size_t)sR * vs_ + vst_c), (LAS unsigned*)(lds + vb_ + wid * 1024), 16, 0, 0); } while (0)

    float m_run = NEGBIG, l_run = 0.f;
    f32x16 o0 = {}, o1 = {}, A0 = {}, A1 = {};
    float bmain[16], bcar[16];
#pragma unroll
    for (int i = 0; i < 16; ++i) { bmain[i] = 0.f; bcar[i] = 0.f; }
    unsigned selmask = 0xffffffffu;

    NSA_ISSUE(0, 0);
    for (int st = 0; st < nsteps; ++st) {
        VM_WAIT(); __syncthreads();
        if (st + 1 < nsteps) NSA_ISSUE(st + 1, (st + 1) & 1);
        const int kb = (st & 1) ? KB1 : KB0, vb = (st & 1) ? VB1 : VB0;
        if (st == ntc && ci >= 8) {
            const LAS float* ps = (const LAS float*)(lds + PS_OFF) + qloc * 32; float v[32];
#pragma unroll
            for (int j4 = 0; j4 < 8; ++j4) { const f32x4 a = *(const LAS f32x4*)(ps + 4 * j4), bq = *(const LAS f32x4*)(ps + 2048 + 4 * j4), c = *(const LAS f32x4*)(ps + 4096 + 4 * j4), d = *(const LAS f32x4*)(ps + 6144 + 4 * j4);
#pragma unroll
                for (int i = 0; i < 4; ++i) v[4 * j4 + i] = (a[i] + bq[i]) + (c[i] + d[i]); }
            selmask = 1u | (1u << ci) | (1u << (ci - 1));
#pragma unroll 1
            for (int it = 0; it < 5; ++it) { float bv = -1.f; int best = 0;
#pragma unroll
                for (int j = 1; j < 30; ++j) { const bool cand = (j <= ci - 2) && !((selmask >> j) & 1u) && (v[j] > bv); bv = cand ? v[j] : bv; best = cand ? j : best; }
                selmask |= 1u << best; }
        }
        int lo, hi_; bool full; float bias = 0.f;
        if (st < ntc) { lo = 0; hi_ = ((t - 31) >> 4) - 64 * st; full = (64 * ci - 31) >= 16 * (64 * st + 63); }
        else if (st < ntc + nsel) { const int j = st - ntc; lo = 0; hi_ = t - 64 * j; full = j < ci; bias = ((selmask >> j) & 1u) ? 0.f : NEGBIG; }
        else { const int j = ci - (st - ntc - nsel); lo = t - 511 - 64 * j; hi_ = t - 64 * j; full = (j < ci) && (j > ci - 8); }
        f32x16 p0, p1;
#pragma unroll
        for (int r = 0; r < 16; ++r) { p0[r] = bias; p1[r] = bias; }
#pragma unroll
        for (int s = 0; s < 4; ++s) { const bf16x8 a0 = *(const LAS bf16x8*)(lds + kb + kofs[s]), a1 = *(const LAS bf16x8*)(lds + kb + 4096 + kofs[s]);
            p0 = __builtin_amdgcn_mfma_f32_32x32x16_bf16(a0, qr[s], p0, 0, 0, 0); p1 = __builtin_amdgcn_mfma_f32_32x32x16_bf16(a1, qr[s], p1, 0, 0, 0); }
        if (!full) {
            int span = hi_ - lo; int koff = 4 * hi - lo; if (span < 0) { koff = -100000; span = 0; }
#pragma unroll
            for (int r = 0; r < 16; ++r) { const int c = (r & 3) + 8 * (r >> 2);
                p0[r] = ((unsigned)(koff + c) <= (unsigned)span) ? p0[r] : NEGBIG; p1[r] = ((unsigned)(koff + c + 32) <= (unsigned)span) ? p1[r] : NEGBIG; }
        }
        float mx = fmaxf(p0[0], p1[0]);
#pragma unroll
        for (int r = 1; r < 16; ++r) mx = fmaxf(mx, fmaxf(p0[r], p1[r]));
        mx = pmax32(mx);
        const float mnew = fmaxf(m_run, mx), alpha = fast_exp2(m_run - mnew); m_run = mnew;
        float ls = 0.f;
#pragma unroll
        for (int r = 0; r < 16; ++r) { p0[r] = fast_exp2(p0[r] - mnew); p1[r] = fast_exp2(p1[r] - mnew); ls += p0[r] + p1[r]; }
        l_run = l_run * alpha + ls;
#pragma unroll
        for (int r = 0; r < 16; ++r) { o0[r] *= alpha; o1[r] *= alpha; }
        if (st < ntc) {
#pragma unroll
            for (int i = 0; i < 16; ++i) { bmain[i] *= alpha; bcar[i] *= alpha; }
            if (st == 0) {
#pragma unroll
                for (int a = 0; a < 4; ++a) { bmain[a] = p0[4 * a] + p0[4 * a + 1] + p0[4 * a + 2] + 0.5f * p0[4 * a + 3]; bcar[a] = 0.5f * p0[4 * a + 3];
                                              bmain[4 + a] = p1[4 * a] + p1[4 * a + 1] + p1[4 * a + 2] + 0.5f * p1[4 * a + 3]; bcar[4 + a] = 0.5f * p1[4 * a + 3]; }
            } else {
#pragma unroll
                for (int a = 0; a < 4; ++a) { bmain[8 + a] = p0[4 * a] + p0[4 * a + 1] + p0[4 * a + 2] + 0.5f * p0[4 * a + 3]; bcar[8 + a] = 0.5f * p0[4 * a + 3];
                                              bmain[12 + a] = p1[4 * a] + p1[4 * a + 1] + p1[4 * a + 2] + 0.5f * p1[4 * a + 3]; bcar[12 + a] = 0.5f * p1[4 * a + 3]; }
            }
        }
        bf16x8 pb[4];
#pragma unroll
        for (int a2 = 0; a2 < 2; ++a2) {
            u32x4 w0, w1;
            w0.x = cvt_pk_bf16(p0[8 * a2 + 0], p0[8 * a2 + 1]); w0.y = cvt_pk_bf16(p0[8 * a2 + 2], p0[8 * a2 + 3]); w0.z = cvt_pk_bf16(p0[8 * a2 + 4], p0[8 * a2 + 5]); w0.w = cvt_pk_bf16(p0[8 * a2 + 6], p0[8 * a2 + 7]);
            w1.x = cvt_pk_bf16(p1[8 * a2 + 0], p1[8 * a2 + 1]); w1.y = cvt_pk_bf16(p1[8 * a2 + 2], p1[8 * a2 + 3]); w1.z = cvt_pk_bf16(p1[8 * a2 + 4], p1[8 * a2 + 5]); w1.w = cvt_pk_bf16(p1[8 * a2 + 6], p1[8 * a2 + 7]);
            pb[a2] = __builtin_bit_cast(bf16x8, w0); pb[2 + a2] = __builtin_bit_cast(bf16x8, w1);
        }
#pragma unroll
        for (int kh = 0; kh < 2; ++kh)
#pragma unroll
            for (int a2 = 0; a2 < 2; ++a2) {
                const int c1 = 4 * kh + 2 * a2;
                const s16x4 x0 = *(const LAS s16x4*)(lds + vb + vofs[c1]), x1 = *(const LAS s16x4*)(lds + vb + vofs[c1 + 1]);
                const s16x4 y0 = *(const LAS s16x4*)(lds + vb + 4096 + vofs[c1]), y1 = *(const LAS s16x4*)(lds + vb + 4096 + vofs[c1 + 1]);
                const bf16x8 va = (bf16x8){x0[0], x0[1], x0[2], x0[3], x1[0], x1[1], x1[2], x1[3]}, vbb = (bf16x8){y0[0], y0[1], y0[2], y0[3], y1[0], y1[1], y1[2], y1[3]};
                o0 = __builtin_amdgcn_mfma_f32_32x32x16_bf16(va, pb[2 * kh + a2], o0, 0, 0, 0);
                o1 = __builtin_amdgcn_mfma_f32_32x32x16_bf16(vbb, pb[2 * kh + a2], o1, 0, 0, 0);
            }
        const bool end_c = (st == ntc - 1), end_s = (st == ntc + nsel - 1), end_w = (st == nsteps - 1);
        if (end_c || end_s || end_w) {
            const float ltot = psum32(l_run); float gate = end_c ? gate_c : (end_s ? gate_s : gate_w);
#if defined(DBG_CHECK) && (DBG_CHECK == 15 || DBG_CHECK == 16 || DBG_CHECK == 17)
            if ((DBG_CHECK == 15 && !end_c) || (DBG_CHECK == 16 && !end_s) || (DBG_CHECK == 17 && !end_w)) gate = 0.f;
#endif
            const float rl = (m_run > -1e29f) ? fast_rcp(ltot) : 0.f; const float sc = gate * rl;
#pragma unroll
            for (int r = 0; r < 16; ++r) { A0[r] += o0[r] * sc; A1[r] += o1[r] * sc; o0[r] = 0.f; o1[r] = 0.f; }
            if (end_c && ci >= 8) {
                LAS float* ps = (LAS float*)(lds + PS_OFF) + (hh * 64 + qloc) * 32;
#pragma unroll
                for (int i = 0; i < 16; ++i) { const float cin = __shfl_xor(bcar[i], 32); bcar[i] = cin; }
#pragma unroll
                for (int i = 0; i < 16; ++i) { const float add = hi ? bcar[i] : (i > 0 ? bcar[i - 1] : 0.f); ps[2 * i + hi] = (bmain[i] + add) * rl; }
            }
            m_run = NEGBIG; l_run = 0.f;
        }
    }
#undef NSA_ISSUE
#pragma unroll
    for (int a = 0; a < 4; ++a) { u32x2 w0, w1; w0.x = cvt_pk_bf16(A0[4 * a], A0[4 * a + 1]); w0.y = cvt_pk_bf16(A0[4 * a + 2], A0[4 * a + 3]); w1.x = cvt_pk_bf16(A1[4 * a], A1[4 * a + 1]); w1.y = cvt_pk_bf16(A1[4 * a + 2], A1[4 * a + 3]);
        *(u32x2*)(op + 8 * a + 4 * hi) = w0; *(u32x2*)(op + 32 + 8 * a + 4 * hi) = w1; }
    __syncthreads();
}
}
__device__ __forceinline__ float dpp_sum16(float v) {
    v += __uint_as_float(__builtin_amdgcn_update_dpp(0, __float_as_uint(v), 0xB1, 0xF, 0xF, true));
    v += __uint_as_float(__builtin_amdgcn_update_dpp(0, __float_as_uint(v), 0x4E, 0xF, 0xF, true));
    v += __uint_as_float(__builtin_amdgcn_update_dpp(0, __float_as_uint(v), 0x141, 0xF, 0xF, true));
    v += __uint_as_float(__builtin_amdgcn_update_dpp(0, __float_as_uint(v), 0x140, 0xF, 0xF, true));
    return v;
}
__device__ __forceinline__ void p7_router(Frame& F, const Args& AR) {
    const float* X1 = F.out; const float* g2n = AR.in[15]; const float* rgw = AR.in[16]; const float* rgb = AR.in[17]; const float* rew = AR.in[18]; const float* reb = AR.in[19];
    const float* MOD = WSP(float, WS_MOD); bf16_t* H2 = WSP(bf16_t, WS_H2); float* SLOTW = WSP(float, WS_SLOTW); unsigned* LIST = WSP(unsigned, WS_LIST);
    unsigned* gcnt = WSP(unsigned, WS_CTL) + CW_CNT;
    LAS float* Wl = (LAS float*)F.lds; LAS unsigned* lcnt = (LAS unsigned*)(F.lds + RT_OFF); LAS unsigned* lbase = lcnt + 32; LAS unsigned* tinfo = lcnt + 64;
    for (int i = F.tid; i < 4096; i += 512) { const int k = i >> 2, j = i & 3; Wl[j * 1024 + k] = rgw[i]; }
    for (int i = F.tid; i < 32768; i += 512) { const int k = i >> 5, j = i & 31; Wl[(4 + j) * 1024 + k] = rew[i]; }
    __syncthreads();
    for (int tg = F.vcu; tg < NTOK / 256; tg += F.G) {
        if (F.tid < 32) lcnt[F.tid] = 0u;
        __syncthreads();
        const int b = (tg * 256) >> 11; f32x4 Av[4], Bv[4];
#pragma unroll
        for (int j = 0; j < 4; ++j) { const int col = 4 * F.lane + 256 * j; const f32x4 g = *(const f32x4*)(g2n + col), sc = *(const f32x4*)(MOD + b * 6144 + 4096 + col); Av[j] = g * (sc + 1.0f); Bv[j] = *(const f32x4*)(MOD + b * 6144 + 3072 + col); }
        for (int pr = 0; pr < 16; ++pr) {
            const int lt = F.wave * 32 + 2 * pr; const size_t row = (size_t)tg * 256 + lt;
            const f32x4* xa = (const f32x4*)(X1 + row * 1024) + F.lane; const f32x4* xb = xa + 256;
            f32x4 ha[4], hb[4]; float sa = 0.f, sb = 0.f;
#pragma unroll
            for (int j = 0; j < 4; ++j) { ha[j] = xa[64 * j]; hb[j] = xb[64 * j]; sa += (ha[j][0] * ha[j][0] + ha[j][1] * ha[j][1]) + (ha[j][2] * ha[j][2] + ha[j][3] * ha[j][3]); sb += (hb[j][0] * hb[j][0] + hb[j][1] * hb[j][1]) + (hb[j][2] * hb[j][2] + hb[j][3] * hb[j][3]); }
            const float ra = rsqrtf(wave_sum(sa) * (1.0f / 1024.0f) + EPS), rb = rsqrtf(wave_sum(sb) * (1.0f / 1024.0f) + EPS);
            u32x2* oa = (u32x2*)(H2 + row * 1024) + F.lane; u32x2* ob = oa + 256;
#pragma unroll
            for (int j = 0; j < 4; ++j) { ha[j] = ha[j] * ra * Av[j] + Bv[j]; hb[j] = hb[j] * rb * Av[j] + Bv[j];
                u32x2 w; w.x = cvt_pk_bf16(ha[j][0], ha[j][1]); w.y = cvt_pk_bf16(ha[j][2], ha[j][3]); oa[64 * j] = w; w.x = cvt_pk_bf16(hb[j][0], hb[j][1]); w.y = cvt_pk_bf16(hb[j][2], hb[j][3]); ob[64 * j] = w; }
#define RT_DOT2(rowa, rowb, outv) do { float pa_ = 0.f, pb_ = 0.f; const LAS float* wra_ = Wl + (rowa) * 1024 + 4 * F.lane; const LAS float* wrb_ = Wl + (rowb) * 1024 + 4 * F.lane; \
                _Pragma("unroll") for (int jq_ = 0; jq_ < 4; ++jq_) { const f32x4 wa_ = *(const LAS f32x4*)(wra_ + 256 * jq_); const f32x4 wb_ = *(const LAS f32x4*)(wrb_ + 256 * jq_); \
                    pa_ += (ha[jq_][0] * wa_[0] + ha[jq_][1] * wa_[1]) + (ha[jq_][2] * wa_[2] + ha[jq_][3] * wa_[3]); pb_ += (hb[jq_][0] * wb_[0] + hb[jq_][1] * wb_[1]) + (hb[jq_][2] * wb_[2] + hb[jq_][3] * wb_[3]); } \
                auto rr_ = __builtin_amdgcn_permlane32_swap(__float_as_uint(pa_), __float_as_uint(pb_), false, false); \
                float v_ = __uint_as_float(rr_[0]) + __uint_as_float(rr_[1]); v_ = dpp_sum16(v_); v_ += __shfl_xor(v_, 16); (outv) = v_; } while (0)
            float g0, g1, g2, g3;
            RT_DOT2(0, 0, g0); RT_DOT2(1, 1, g1); RT_DOT2(2, 2, g2); RT_DOT2(3, 3, g3);
            g0 += rgb[0]; g1 += rgb[1]; g2 += rgb[2]; g3 += rgb[3];
            int gidx = 0; float gm = g0; if (g1 > gm) { gm = g1; gidx = 1; } if (g2 > gm) { gm = g2; gidx = 2; } if (g3 > gm) { gm = g3; gidx = 3; }
            const float gp = 1.0f / (__expf(g0 - gm) + __expf(g1 - gm) + __expf(g2 - gm) + __expf(g3 - gm));
            const int ga = __builtin_amdgcn_readlane(gidx, 0), gb = __builtin_amdgcn_readlane(gidx, 32);
            float le[8];
#pragma unroll
            for (int j = 0; j < 8; ++j) { RT_DOT2(4 + ga * 8 + j, 4 + gb * 8 + j, le[j]); le[j] += reb[gidx * 8 + j]; }
#undef RT_DOT2
            int i0 = 0; float v0 = le[0];
#pragma unroll
            for (int j = 1; j < 8; ++j) if (le[j] > v0) { v0 = le[j]; i0 = j; }
            int i1 = -1; float v1 = -INFINITY;
#pragma unroll
            for (int j = 0; j < 8; ++j) if (j != i0 && le[j] > v1) { v1 = le[j]; i1 = j; }
            const float ex = __expf(v1 - v0); const float w0 = gp / (1.0f + ex), w1 = gp * ex / (1.0f + ex);
            if ((F.lane & 31) == 0) {
                const int tl = lt + (F.lane >> 5); const size_t tok = (size_t)tg * 256 + tl; const int e0 = gidx * 8 + i0, e1 = gidx * 8 + i1;
                const unsigned p0 = __hip_atomic_fetch_add(lcnt + e0, 1u, __ATOMIC_RELAXED, __HIP_MEMORY_SCOPE_WORKGROUP), p1 = __hip_atomic_fetch_add(lcnt + e1, 1u, __ATOMIC_RELAXED, __HIP_MEMORY_SCOPE_WORKGROUP);
                tinfo[2 * tl] = ((unsigned)e0 << 16) | p0; tinfo[2 * tl + 1] = ((unsigned)e1 << 16) | p1;
                SLOTW[2 * tok] = w0; SLOTW[2 * tok + 1] = w1;
            }
        }
        __syncthreads();
        if (F.tid < 32) lbase[F.tid] = __hip_atomic_fetch_add(gcnt + 64 * F.tid, lcnt[F.tid], __ATOMIC_RELAXED, __HIP_MEMORY_SCOPE_AGENT);
        __syncthreads();
        { const unsigned inf = tinfo[F.tid]; const unsigned e = inf >> 16, p = inf & 0xffffu; LIST[(size_t)e * 65536 + lbase[e] + p] = (unsigned)(tg * 256) * 2u + (unsigned)F.tid; }
        __syncthreads();
    }
}
__device__ __forceinline__ void moe_tables(Frame& F, LAS unsigned* tcnt, LAS unsigned* tbase) {
    const unsigned* gcnt = WSP(unsigned, WS_CTL) + CW_CNT;
    if (F.tid < 32) tcnt[F.tid] = __hip_atomic_load(gcnt + 64 * F.tid, __ATOMIC_RELAXED, __HIP_MEMORY_SCOPE_AGENT);
    __syncthreads();
    if (F.tid == 0) { unsigned s = 0; for (int e = 0; e < 32; ++e) { tbase[e] = s; s += (tcnt[e] + 255u) >> 8; } tbase[32] = s; }
    __syncthreads();
}

__device__ __forceinline__ void p10_final(Frame& F, const Args& AR) {
    float* X1 = F.out; const float* fg = AR.in[23]; const float* MOD = WSP(float, WS_MOD); const bf16_t* Y = WSP(bf16_t, WS_Y);
    const int gw = F.vcu * NWAVES + F.wave, NGW = F.G * NWAVES;
    for (int q = gw; q < NTOK / 32; q += NGW) {
        const int b = q >> 6; f32x4 Gv[4], Fv[4];
#pragma unroll
        for (int j = 0; j < 4; ++j) { const int col = 4 * F.lane + 256 * j; Gv[j] = *(const f32x4*)(MOD + b * 6144 + 5120 + col); Fv[j] = *(const f32x4*)(fg + col); }
        for (int r = 0; r < 32; ++r) {
            const size_t row = (size_t)q * 32 + r; f32x4* xr = (f32x4*)(X1 + row * 1024) + F.lane;
            const u32x2* y0 = (const u32x2*)(Y + (2 * row) * 1024) + F.lane; const u32x2* y1 = y0 + 256;
            f32x4 v[4]; float s = 0.f;
#pragma unroll
            for (int j = 0; j < 4; ++j) { const u32x2 a = y0[64 * j], c = y1[64 * j]; const f32x4 ys = (f32x4){bf_lo(a.x) + bf_lo(c.x), bf_hi(a.x) + bf_hi(c.x), bf_lo(a.y) + bf_lo(c.y), bf_hi(a.y) + bf_hi(c.y)};
                v[j] = xr[64 * j] + Gv[j] * ys * DBG_MOE_SCALE; s += (v[j][0] * v[j][0] + v[j][1] * v[j][1]) + (v[j][2] * v[j][2] + v[j][3] * v[j][3]); }
            const float rs = rsqrtf(wave_sum(s) * (1.0f / 1024.0f) + EPS);
#pragma unroll
            for (int j = 0; j < 4; ++j) xr[64 * j] = v[j] * rs * Fv[j];
        }
    }
}
#ifdef DBG_CHECK
#ifndef DBG_SALT
#define DBG_SALT 0
#endif
__device__ __forceinline__ float blk_sum(Frame& F, float v, LAS float* red) {
    v = wave_sum(v); __syncthreads(); if (F.lane == 0) red[F.wave] = v; __syncthreads(); float s = 0.f;
#pragma unroll
    for (int w = 0; w < 8; ++w) s += red[w]; __syncthreads(); return s;
}
__device__ __forceinline__ float dbg_sig(float x) { return 1.0f / (1.0f + __expf(-x)); }
__device__ __forceinline__ void dbg_check(Frame& F, const Args& AR, float& num, float& den) {
    LAS float* red = (LAS float*)(F.lds + 150000 - 64);
    LAS float* sh = (LAS float*)F.lds;
    const int t = (F.vcu * 257 + 31 * DBG_SALT + 5) & 65535; const int b = t >> 11, tb = t & 2047;
    const float* MOD = WSP(float, WS_MOD);
    num = 0.f; den = 0.f;
#if DBG_CHECK == 1
    { const int bb = F.vcu & 31; for (int n = F.tid; n < 6144; n += 512) { float s = AR.in[3][n]; for (int k = 0; k < 1024; ++k) s += AR.in[1][bb * 1024 + k] * AR.in[2][(size_t)k * 6144 + n];
        const float f = MOD[bb * 6144 + n]; num += (f - s) * (f - s); den += s * s; } }
#elif DBG_CHECK == 2
    { float ss = 0.f; for (int k = F.tid; k < 1024; k += 512) { const float v = AR.in[0][(size_t)t * 1024 + k]; ss += v * v; } ss = blk_sum(F, ss, red); const float r = rsqrtf(ss / 1024.f + EPS);
      for (int k = F.tid; k < 1024; k += 512) { const float ref = AR.in[0][(size_t)t * 1024 + k] * r * AR.in[4][k] * (1.f + MOD[b * 6144 + 1024 + k]) + MOD[b * 6144 + k]; const float f = bf1(WSP(bf16_t, WS_H)[(size_t)t * 1024 + k]);
        num += (f - ref) * (f - ref); den += ref * ref; } }
#elif DBG_CHECK >= 30 && DBG_CHECK < 40
    { for (int k = F.tid; k < 1024; k += 512) sh[k] = bf1(WSP(bf16_t, WS_H)[(size_t)t * 1024 + k]); __syncthreads();
      for (int n = F.tid; n < 3864; n += 512) { float s = 0.f; for (int k = 0; k < 1024; ++k) s += sh[k] * AR.in[5][(size_t)k * 3864 + n];
        float f = 0.f; bool use = false; float ref = s;
        if (n < 512) { use = DBG_CHECK == 30; f = bf1(WSP(bf16_t, WS_U)[(size_t)t * 512 + n]); }
        else if (n < 1024) { use = DBG_CHECK == 31; f = bf1(WSP(bf16_t, WS_Q)[(size_t)t * 512 + n - 512]); ref = s * QSCALE; }
        else if (n < 1792) { const int seg = (n - 1024) >> 7, cc = (n - 1024) & 127, g = cc >> 6, d = cc & 63; const size_t kidx = ((size_t)(b * 2 + g) * 2048 + tb) * 64 + d, vidx = ((size_t)(b * 2 + g) * 64 + d) * 2048 + tb;
            if (seg == 0) { use = DBG_CHECK == 32; f = bf1(WSP(bf16_t, WS_KC)[kidx]); } else if (seg == 1) { use = DBG_CHECK == 32; f = bf1(WSP(bf16_t, WS_VC)[kidx]); }
            else if (seg == 2) { use = DBG_CHECK == 33; f = bf1(WSP(bf16_t, WS_KS)[kidx]); } else if (seg == 3) { use = DBG_CHECK == 33; f = bf1(WSP(bf16_t, WS_VST)[vidx]); }
            else if (seg == 4) { use = DBG_CHECK == 34; f = bf1(WSP(bf16_t, WS_KW)[kidx]); } else { use = DBG_CHECK == 34; f = bf1(WSP(bf16_t, WS_VWT)[vidx]); } }
        else if (DBG_CHECK == 37) { use = n < 3840; f = bf1(WSP(bf16_t, WS_MG)[(size_t)t * 2048 + (n < 3840 ? n - 1792 : 0)]); ref = dbg_sig(s); }
        else if (n < 1816) { use = DBG_CHECK == 36; f = bf1(WSP(bf16_t, WS_BG)[(size_t)t * 32 + n - 1792]); ref = dbg_sig(s); }
        else if (DBG_CHECK == 39) { use = true; f = bf1(WSP(bf16_t, WS_MG)[(size_t)t * 2048 + n - 1816]); ref = s; }
        else { use = DBG_CHECK == 35 || (DBG_CHECK == 38 && ((n - 1816) >> 8) == DBG_SALT); f = bf1(WSP(bf16_t, WS_MG)[(size_t)t * 2048 + n - 1816]); ref = dbg_sig(s); }
        if (use) { num += (f - ref) * (f - ref); den += ref * ref; } } }
#elif DBG_CHECK == 40
    { for (int i = 0; i < 16; ++i) { const int nd = (F.vcu * 16 + i + 256 * DBG_SALT) & 4095; int src = -1; if (nd < 1792) src = nd; else if (nd < 3840) src = nd + 24; else if (nd < 3864) src = nd - 3840 + 1792;
        for (int k = F.tid; k < 1024; k += 512) { const float ref = src >= 0 ? AR.in[5][(size_t)k * 3864 + src] : 0.f; const float f = bf1(WSP(bf16_t, WS_WIN)[(size_t)nd * 1024 + k]); num += (f - ref) * (f - ref); den += ref * ref; } } }
#elif DBG_CHECK == 4
    { const bf16_t* U = WSP(bf16_t, WS_U); for (int c = F.tid; c < 512; c += 512) { const int w = 2 << (c >> 7); float s = 0.f; int cnt = 0; for (int d = 0; d < w; ++d) if (tb - d >= 0) { s += bf1(U[(size_t)(t - d) * 512 + c]); ++cnt; }
        const float ref = s / (float)cnt - bf1(U[(size_t)t * 512 + c]); const float f = bf1(WSP(bf16_t, WS_P)[(size_t)t * 512 + c]); num += (f - ref) * (f - ref); den += ref * ref; } }
#elif DBG_CHECK == 5
    { const bf16_t* P = WSP(bf16_t, WS_P); { const int o = F.tid, gi = o >> 7, d = o & 127; float s = 0.f; for (int c = 0; c < 128; ++c) s += bf1(P[(size_t)t * 512 + gi * 128 + c]) * AR.in[6][(size_t)(gi * 128 + c) * 128 + d]; sh[o] = s * AR.in[7][o]; } __syncthreads();
      for (int n = F.tid; n < 1024; n += 512) { float s = 0.f; for (int k = 0; k < 512; ++k) s += sh[k] * AR.in[12][(size_t)k * 1024 + n]; const float ref = s * bf1(WSP(bf16_t, WS_MG)[(size_t)t * 2048 + n]);
        const float f = bf1(WSP(bf16_t, WS_T1)[(size_t)t * 1024 + n]); num += (f - ref) * (f - ref); den += ref * ref; } }
#elif DBG_CHECK == 6
    { for (int n = F.tid; n < 1024; n += 512) { float s = 0.f; for (int k = 0; k < 512; ++k) s += bf1(WSP(bf16_t, WS_Q)[(size_t)t * 512 + k]) * AR.in[13][(size_t)k * 1024 + n];
        const float ref = s * bf1(WSP(bf16_t, WS_MG)[(size_t)t * 2048 + 1024 + n]) + bf1(WSP(bf16_t, WS_T1)[(size_t)t * 1024 + n]); const float f = bf1(WSP(bf16_t, WS_H)[(size_t)t * 1024 + n]); num += (f - ref) * (f - ref); den += ref * ref; } }
#elif DBG_CHECK == 7
    { for (int n = F.tid; n < 1024; n += 512) { float s = 0.f; for (int k = 0; k < 1024; ++k) s += bf1(WSP(bf16_t, WS_H)[(size_t)t * 1024 + k]) * AR.in[14][(size_t)k * 1024 + n];
        const float ref = MOD[b * 6144 + 2048 + n] * s; const float f = F.out[(size_t)t * 1024 + n] - AR.in[0][(size_t)t * 1024 + n]; num += (f - ref) * (f - ref); den += ref * ref; } }
#elif DBG_CHECK == 8
    { float ss = 0.f; for (int k = F.tid; k < 1024; k += 512) { const float v = F.out[(size_t)t * 1024 + k]; ss += v * v; } ss = blk_sum(F, ss, red); const float r = rsqrtf(ss / 1024.f + EPS);
      for (int k = F.tid; k < 1024; k += 512) { const float ref = F.out[(size_t)t * 1024 + k] * r * AR.in[15][k] * (1.f + MOD[b * 6144 + 4096 + k]) + MOD[b * 6144 + 3072 + k]; const float f = bf1(WSP(bf16_t, WS_H2)[(size_t)t * 1024 + k]);
        num += (f - ref) * (f - ref); den += ref * ref; } }
#elif DBG_CHECK == 9 || DBG_CHECK == 10 || DBG_CHECK == 12 || DBG_CHECK == 13
    { for (int k = F.tid; k < 1024; k += 512) sh[k] = bf1(WSP(bf16_t, WS_H2)[(size_t)t * 1024 + k]); __syncthreads();
      LAS float* lgt = sh + 1024;
      if (F.tid < 36) { float s = 0.f; if (F.tid < 4) { for (int k = 0; k < 1024; ++k) s += sh[k] * AR.in[16][k * 4 + F.tid]; s += AR.in[17][F.tid]; } else { const int j = F.tid - 4; for (int k = 0; k < 1024; ++k) s += sh[k] * AR.in[18][k * 32 + j]; s += AR.in[19][j]; } lgt[F.tid] = s; }
      __syncthreads();
      int gidx = 0; float gm = lgt[0]; for (int j = 1; j < 4; ++j) if (lgt[j] > gm) { gm = lgt[j]; gidx = j; }
      float gs = 0.f; for (int j = 0; j < 4; ++j) gs += __expf(lgt[j] - gm); const float gp = 1.f / gs;
      int i0 = 0; float v0 = lgt[4 + gidx * 8]; for (int j = 1; j < 8; ++j) if (lgt[4 + gidx * 8 + j] > v0) { v0 = lgt[4 + gidx * 8 + j]; i0 = j; }
      int i1 = -1; float v1 = -INFINITY; for (int j = 0; j < 8; ++j) if (j != i0 && lgt[4 + gidx * 8 + j] > v1) { v1 = lgt[4 + gidx * 8 + j]; i1 = j; }
      const float ex = __expf(v1 - v0); const float wk0 = gp / (1.f + ex), wk1 = gp * ex / (1.f + ex); const int ek0 = gidx * 8 + i0, ek1 = gidx * 8 + i1;
      if (DBG_CHECK == 12 && F.tid == 0) { const float f0 = WSP(float, WS_SLOTW)[2 * t], f1 = WSP(float, WS_SLOTW)[2 * t + 1]; num += (f0 - wk0) * (f0 - wk0) + (f1 - wk1) * (f1 - wk1); den += wk0 * wk0 + wk1 * wk1; }
      if (DBG_CHECK == 13) {
          const unsigned* LIST = WSP(unsigned, WS_LIST); const unsigned* gc = WSP(unsigned, WS_CTL) + CW_CNT; float found0 = 0.f, found1 = 0.f;
          const unsigned c0 = gc[64 * ek0], c1 = gc[64 * ek1];
          for (unsigned i = F.tid; i < c0; i += 512) if (LIST[(size_t)ek0 * 65536 + i] == (unsigned)(2 * t)) found0 = 1.f;
          for (unsigned i = F.tid; i < c1; i += 512) if (LIST[(size_t)ek1 * 65536 + i] == (unsigned)(2 * t + 1)) found1 = 1.f;
          num -= found0 + found1; if (F.tid == 0) { num += 2.f; den += 2.f; } }
      LAS float* he = sh + 1280;
      if (DBG_CHECK >= 12) goto dbg_done;
      _Pragma("unroll 1") for (int k2 = 0; k2 < 2; ++k2) { const int e = k2 ? ek1 : ek0; const float wkk = k2 ? wk1 : wk0; __syncthreads();
        { const int j = F.tid; float a = 0.f, u = 0.f; for (int k = 0; k < 1024; ++k) { a += sh[k] * AR.in[20][((size_t)e * 1024 + k) * 512 + j]; u += sh[k] * AR.in[21][((size_t)e * 1024 + k) * 512 + j]; }
          const float hv = a * dbg_sig(a) * u; he[j] = hv;
          if (DBG_CHECK == 10) { const float f = bf1(WSP(bf16_t, WS_HE)[(size_t)(2 * t + k2) * 512 + j]); num += (f - hv) * (f - hv); den += hv * hv; } }
        __syncthreads();
        if (DBG_CHECK == 9) for (int n = F.tid; n < 1024; n += 512) { float s = 0.f; for (int j = 0; j < 512; ++j) s += he[j] * AR.in[22][((size_t)e * 512 + j) * 1024 + n]; const float ref = s * wkk;
            const float f = bf1(WSP(bf16_t, WS_Y)[(size_t)(2 * t + k2) * 1024 + n]); num += (f - ref) * (f - ref); den += ref * ref; } } }
#elif DBG_CHECK == 11
    { const int bg = F.vcu & 63, n = (F.vcu * 7 + DBG_SALT) % 127; LAS float* hid = sh + 2048;
      for (int which = 0; which < 2; ++which) { const bf16_t* KV = WSP(bf16_t, which ? WS_VC : WS_KC) + ((size_t)bg * 2048 + 16 * n) * 64; __syncthreads();
        for (int k = F.tid; k < 2048; k += 512) sh[k] = bf1(KV[k]) + AR.in[8][which * 2048 + k]; __syncthreads();
        if (F.tid < 256) { float s = AR.in[10][which * 256 + F.tid]; for (int k = 0; k < 2048; ++k) s += sh[k] * AR.in[9][((size_t)which * 2048 + k) * 256 + F.tid]; const float u = 0.7978845608f * (s + 0.044715f * s * s * s); hid[F.tid] = 0.5f * s * (1.f + tanhf(u)); }
        __syncthreads();
        if (F.tid < 64) { float s = 0.f; for (int j = 0; j < 256; ++j) s += hid[j] * AR.in[11][((size_t)which * 256 + j) * 64 + F.tid];
            const float f = which ? bf1(WSP(bf16_t, WS_VCMPT)[((size_t)bg * 64 + F.tid) * 128 + n]) : bf1(WSP(bf16_t, WS_KCMP)[((size_t)bg * 128 + n) * 64 + F.tid]); num += (f - s) * (f - s); den += s * s; } } }
#elif DBG_CHECK == 14 || DBG_CHECK == 15 || DBG_CHECK == 16 || DBG_CHECK == 17
    { const bf16_t* Qb = WSP(bf16_t, WS_Q); const bf16_t* ATT = WSP(bf16_t, WS_T1); const bf16_t* BG = WSP(bf16_t, WS_BG);
      LAS float* sc = sh;
      LAS float* pc = sh + 2048;
      LAS float* qv = sh + 2560;
      LAS float* oc = sh + 2624;
      LAS float* psv = sh + 3136;
      LAS unsigned* selm = (LAS unsigned*)(sh + 3200);
      const int cur = tb >> 6;
      for (int g = 0; g < 2; ++g) { const int bg = b * 2 + g;
        const bf16_t* KCMP = WSP(bf16_t, WS_KCMP) + (size_t)bg * 128 * 64; const bf16_t* VCT = WSP(bf16_t, WS_VCMPT) + (size_t)bg * 64 * 128;
        const bf16_t* KS = WSP(bf16_t, WS_KS) + (size_t)bg * 2048 * 64; const bf16_t* VST = WSP(bf16_t, WS_VST) + (size_t)bg * 64 * 2048;
        const bf16_t* KW = WSP(bf16_t, WS_KW) + (size_t)bg * 2048 * 64; const bf16_t* VWT = WSP(bf16_t, WS_VWT) + (size_t)bg * 64 * 2048;
        for (int hh = 0; hh < 4; ++hh) { const int hq = g * 4 + hh; __syncthreads();
            if (F.tid < 64) qv[F.tid] = bf1(Qb[(size_t)t * 512 + hq * 64 + F.tid]); __syncthreads();
            float s = -INFINITY; const bool valid = F.tid < 127 && (16 * F.tid + 31 <= tb);
            if (valid) { s = 0.f; for (int d = 0; d < 64; ++d) s += qv[d] * bf1(KCMP[F.tid * 64 + d]); }
            float m;
            { float mm = s; for (int o = 1; o < 64; o <<= 1) mm = fmaxf(mm, __shfl_xor(mm, o)); __syncthreads(); if (F.lane == 0) red[F.wave] = mm; __syncthreads(); mm = red[0]; for (int w = 1; w < 8; ++w) mm = fmaxf(mm, red[w]); __syncthreads(); m = mm; }
            const float e = valid ? exp2f(s - m) : 0.f; const float l = blk_sum(F, e, red);
            if (F.tid < 128) pc[hh * 128 + F.tid] = l > 0.f ? e / l : 0.f; __syncthreads();
            if (F.tid < 64) { float o = 0.f; for (int n = 0; n < 127; ++n) o += pc[hh * 128 + n] * bf1(VCT[F.tid * 128 + n]); oc[hq * 64 + F.tid] = o; } __syncthreads(); }
        if (F.tid < 32) { const int j = F.tid; float ps = 0.f; for (int hh = 0; hh < 4; ++hh) for (int n = 0; n < 127; ++n) { int ov = (16 * n + 32 < 64 * j + 64 ? 16 * n + 32 : 64 * j + 64) - (16 * n > 64 * j ? 16 * n : 64 * j); if (ov < 0) ov = 0; ps += pc[hh * 128 + n] * (float)ov * (1.f / 32.f); } psv[j] = ps; }
        __syncthreads();
        if (F.tid == 0) { unsigned msk = 0u; for (int it = 0; it < 8; ++it) { int best = -1; float bv = -INFINITY; for (int j = 0; j < 32; ++j) { if ((msk >> j) & 1u) continue; const bool forced = (j == 0) || (j == cur) || (j == cur - 1); const float scv = forced ? 1e4f : (j <= cur ? psv[j] : NEGBIG); if (scv > bv) { bv = scv; best = j; } } msk |= 1u << best; } selm[0] = msk; }
        __syncthreads();
        const unsigned msk = selm[0];
        for (int hh = 0; hh < 4; ++hh) { const int hq = g * 4 + hh; __syncthreads();
            if (F.tid < 64) qv[F.tid] = bf1(Qb[(size_t)t * 512 + hq * 64 + F.tid]); __syncthreads();
            float osel = 0.f, owin = 0.f;
            for (int br = 1; br < 3; ++br) { const bf16_t* Kb = br == 1 ? KS : KW; const bf16_t* Vb = br == 1 ? VST : VWT; float mloc = -INFINITY;
                for (int k = F.tid; k < 2048; k += 512) { const bool v = br == 1 ? (((msk >> (k >> 6)) & 1u) && k <= tb) : (k <= tb && k > tb - 512); float s = -INFINITY; if (v) { s = 0.f; for (int d = 0; d < 64; ++d) s += qv[d] * bf1(Kb[(size_t)k * 64 + d]); } sc[k] = s; mloc = fmaxf(mloc, s); }
                { float mm = mloc; for (int o = 1; o < 64; o <<= 1) mm = fmaxf(mm, __shfl_xor(mm, o)); __syncthreads(); if (F.lane == 0) red[F.wave] = mm; __syncthreads(); mm = red[0]; for (int w = 1; w < 8; ++w) mm = fmaxf(mm, red[w]); __syncthreads(); mloc = mm; }
                float lsum = 0.f; for (int k = F.tid; k < 2048; k += 512) { const float e = sc[k] > -INFINITY ? exp2f(sc[k] - mloc) : 0.f; sc[k] = e; lsum += e; } lsum = blk_sum(F, lsum, red);
                if (F.tid < 64) { float o = 0.f; for (int k = 0; k <= tb; ++k) o += sc[k] * bf1(Vb[(size_t)F.tid * 2048 + k]); o /= lsum; if (br == 1) osel = o; else owin = o; } __syncthreads(); }
            if (F.tid < 64) { const float g0 = bf1(BG[(size_t)t * 32 + hq]), g1 = bf1(BG[(size_t)t * 32 + 8 + hq]), g2 = bf1(BG[(size_t)t * 32 + 16 + hq]);
                float ref = 0.f; if (DBG_CHECK == 14 || DBG_CHECK == 15) ref += g0 * oc[hq * 64 + F.tid]; if (DBG_CHECK == 14 || DBG_CHECK == 16) ref += g1 * osel; if (DBG_CHECK == 14 || DBG_CHECK == 17) ref += g2 * owin;
                const float f = bf1(ATT[(size_t)t * 512 + hq * 64 + F.tid]); num += (f - ref) * (f - ref); den += ref * ref; } } } }
#endif
    dbg_done:
    num = blk_sum(F, num, red); den = blk_sum(F, den, red);
}
#endif
#define XB_TMO      128
#define XB_XCNT(j)  (256  + 64 * (j))
#define XB_XSUB(j)  (1280 + 64 * (j))
#define XB_XGEN(j)  (2304 + 64 * (j))
#define XB_TOP      3328
#define XB_TOPGEN   3392
#define XCD_BAR_WORDS 3456
#define XB_SPIN_CAP (1u << 22)
__device__ __forceinline__ unsigned xb_ld(unsigned* p)              { return __hip_atomic_load(p, __ATOMIC_RELAXED, __HIP_MEMORY_SCOPE_AGENT); }
__device__ __forceinline__ unsigned xb_add(unsigned* p, unsigned v) { return __hip_atomic_fetch_add(p, v, __ATOMIC_RELAXED, __HIP_MEMORY_SCOPE_AGENT); }
__device__ __forceinline__ unsigned xb_xcc_id() { return (unsigned)__builtin_amdgcn_s_getreg((3 << 11) | 20) & 0xFu; }
#define XB_SPIN(cond, bar) do { unsigned _sp = 0; while (cond) { __builtin_amdgcn_s_sleep(1); \
    if ((++_sp & 255u) == 0u) { if (xb_ld(&(bar)[XB_TMO])) break; if (_sp > XB_SPIN_CAP) { atomicAdd(&(bar)[XB_TMO], 1u); break; } } } } while (0)
struct XcdBarrier { unsigned* bar; unsigned x; volatile LAS unsigned* st; };
__device__ __forceinline__ XcdBarrier xcd_barrier_post(unsigned* bar, volatile LAS unsigned* st) {
    XcdBarrier b; b.bar = bar; b.x = xb_xcc_id(); b.st = st;
    if (threadIdx.x == 0) (void)xb_add(&bar[XB_XCNT(b.x)], 1u);
    return b;
}
__device__ __forceinline__ void xcd_barrier_complete(unsigned* bar, unsigned x, unsigned& nloc, unsigned& nx) {
    const unsigned G = gridDim.x * gridDim.y * gridDim.z;
    unsigned sum, cnt, mine, sp = 0u;
    for (;;) {
        sum = 0u; cnt = 0u; mine = 0u;
#pragma unroll
        for (unsigned j = 0; j < 16; ++j) { const unsigned c = xb_ld(&bar[XB_XCNT(j)]); sum += c; cnt += (c > 0u) ? 1u : 0u; mine = (j == x) ? c : mine; }
        if (sum == G) break;
        __builtin_amdgcn_s_sleep(1);
        if ((++sp & 255u) == 0u) { if (xb_ld(&bar[XB_TMO])) break; if (sp > XB_SPIN_CAP) { atomicAdd(&bar[XB_TMO], 1u); break; } }
    }
    nloc = mine > 0u ? mine : 1u; nx = cnt > 0u ? cnt : 1u;
}
__device__ __forceinline__ void xcd_barrier(const XcdBarrier& b) {
    asm volatile("s_waitcnt vmcnt(0)" ::: "memory");
    __syncthreads();
    if (threadIdx.x == 0) {
        unsigned* bar = b.bar;
        __builtin_amdgcn_s_waitcnt(0);
        unsigned nloc = b.st[0], nx = b.st[1];
        if (nloc == 0u) { xcd_barrier_complete(bar, b.x, nloc, nx); b.st[0] = nloc; b.st[1] = nx; }
        const unsigned old = xb_add(&bar[XB_XSUB(b.x)], 1u);
        const unsigned gen = old / nloc;
        if (old + 1u == (gen + 1u) * nloc) {
            __builtin_amdgcn_fence(__ATOMIC_RELEASE, "agent");
            asm volatile("s_waitcnt vmcnt(0)" ::: "memory");
            const unsigned og = xb_add(&bar[XB_TOP], 1u);
            const unsigned tg = og / nx;
            if (og + 1u == (tg + 1u) * nx) xb_add(&bar[XB_TOPGEN], 1u);
            else XB_SPIN(xb_ld(&bar[XB_TOPGEN]) == tg, bar);
            __builtin_amdgcn_fence(__ATOMIC_ACQUIRE, "agent");
            xb_add(&bar[XB_XGEN(b.x)], 1u);
            asm volatile("s_waitcnt vmcnt(0)" ::: "memory");
        } else {
            XB_SPIN(xb_ld(&bar[XB_XGEN(b.x)]) == gen, bar);
            __builtin_amdgcn_fence(__ATOMIC_ACQUIRE, "agent");
            asm volatile("s_waitcnt vmcnt(0)" ::: "memory");
        }
    }
    __syncthreads();
}

#ifndef MK_PER_PHASE
#define MK_PER_PHASE 0
#endif
constexpr int N_PHASES = 11;
__global__ void __launch_bounds__(NWAVES * 64, 2) mk_fwd(Args args) {
    extern __shared__ __attribute__((aligned(16))) unsigned char lds_raw[];
    Frame F;
    F.lds = (LAS unsigned char*)lds_raw; F.ws = args.ws; F.out = args.out;
    F.tid = threadIdx.x; F.lane = F.tid & 63; F.wave = __builtin_amdgcn_readfirstlane(F.tid >> 6);
    F.G = gridDim.x; { const int bx = blockIdx.x; F.vcu = (F.G % 8 == 0) ? (bx % 8) * (F.G / 8) + bx / 8 : bx; }
    volatile LAS unsigned* MISC = (volatile LAS unsigned*)(F.lds + MISC_OFF);
    if (F.tid < 16) MISC[F.tid] = 0u;
    __syncthreads();
    XcdBarrier bar; bar.bar = WSP(unsigned, WS_CTL) + CW_BAR; bar.x = 0; bar.st = MISC + 8;
    if (!MK_PER_PHASE) bar = xcd_barrier_post(WSP(unsigned, WS_CTL) + CW_BAR, MISC + 8);
    const int lo = args.ph_lo, hi = args.ph_hi;
#ifdef DBG_LAST
#define IN(k) (lo <= (k) && (k) < hi && ((k) <= DBG_LAST || (k) == 10))
#else
#define IN(k) (lo <= (k) && (k) < hi)
#endif
#define SEAM(k) do { if (lo <= (k) && (k) + 1 < hi) xcd_barrier(bar); } while (0)
    LAS unsigned char* ring = F.lds;

    if (IN(0)) { p0_prologue(F, args); }
    SEAM(0);
    if (IN(1)) { p1_norm_mod(F, args); }
    SEAM(1);
    if (IN(2)) {
        SchedPlain S; S.A = (const char*)WSP(bf16_t, WS_H); S.Bt = (const char*)WSP(bf16_t, WS_WIN); S.lda = 2048u; S.K = 1024; S.so.init(NTOK, 4096, F.G, (int)blockIdx.x);
        EpiG1 E{WSP(bf16_t, WS_U), WSP(bf16_t, WS_Q), WSP(bf16_t, WS_KC), WSP(bf16_t, WS_VC), WSP(bf16_t, WS_KS), WSP(bf16_t, WS_VST), WSP(bf16_t, WS_KW), WSP(bf16_t, WS_VWT), WSP(bf16_t, WS_MG), WSP(bf16_t, WS_BG)};
        pg8::gemm_phase<EpiG1, SchedPlain>(ring, 1024, S, E);
    }
    SEAM(2);
    if (IN(3)) {
        const int ncmp = F.G > 64 ? 64 : 0;
        if (F.vcu < 64) {
            for (int c = F.vcu; c < 64; c += F.G) {
                SchedCmp S{(const char*)WSP(bf16_t, WS_KC), (const char*)WSP(bf16_t, WS_VC), (const char*)WSP(bf16_t, WS_W1C), c};
                EpiHid E{WSP(bf16_t, WS_HID), WSP(float, WS_BIAS1)};
                pg8::gemm_phase<EpiHid, SchedCmp>(ring, 2048, S, E);
                VM_WAIT(); __syncthreads();
                p3_cmp2(F, c >> 5, c & 31);
                __syncthreads();
            }
        }
        if (F.vcu >= ncmp) p3_pool(F, (F.vcu - ncmp) * NWAVES + F.wave, (F.G - ncmp) * NWAVES);
    }
    SEAM(3);
    if (IN(4)) {
        #if defined(DBG_CHECK) && DBG_CHECK >= 14 && DBG_CHECK <= 17
        bf16_t* attn_out = WSP(bf16_t, WS_T1);
#else
        bf16_t* attn_out = WSP(bf16_t, WS_Q);
#endif
        const nsa::Ptrs T{WSP(bf16_t, WS_Q), attn_out, WSP(bf16_t, WS_KS), WSP(bf16_t, WS_VST), WSP(bf16_t, WS_KW), WSP(bf16_t, WS_VWT), WSP(bf16_t, WS_KCMP), WSP(bf16_t, WS_VCMPT), WSP(bf16_t, WS_BG)};
        for (int u = F.vcu; u < 2048; u += F.G) {
            const int wslot = u & 255, k = u >> 8, bg = wslot >> 2, s = wslot & 3;
            const int ci = (k >> 1) * 8 + ((k & 1) ? (7 - s) : s);
            nsa::attn_unit(ring, T, bg >> 1, bg & 1, ci, F.wave, F.lane);
        }
    }
    SEAM(4);
    if (IN(5)) {
        { SchedPlain S; S.A = (const char*)WSP(bf16_t, WS_P); S.Bt = (const char*)WSP(bf16_t, WS_WP); S.lda = 1024u; S.K = 512; S.so.init(NTOK, 1024, F.G, (int)blockIdx.x);
          EpiT1 E{WSP(bf16_t, WS_MG), WSP(bf16_t, WS_T1)}; pg8::gemm_phase<EpiT1, SchedPlain>(ring, 512, S, E); }
        { SchedPlain S; S.A = (const char*)WSP(bf16_t, WS_Q); S.Bt = (const char*)WSP(bf16_t, WS_WA); S.lda = 1024u; S.K = 512; S.so.init(NTOK, 1024, F.G, (int)blockIdx.x);
          EpiMix E{WSP(bf16_t, WS_MG), WSP(bf16_t, WS_T1), WSP(bf16_t, WS_H)}; pg8::gemm_phase<EpiMix, SchedPlain>(ring, 512, S, E); }
    }
    SEAM(5);
    if (IN(6)) {
        SchedPlain S; S.A = (const char*)WSP(bf16_t, WS_H); S.Bt = (const char*)WSP(bf16_t, WS_WOUT); S.lda = 2048u; S.K = 1024; S.so.init(NTOK, 1024, F.G, (int)blockIdx.x);
        EpiX1 E{args.in[0], WSP(float, WS_MOD), F.out}; pg8::gemm_phase<EpiX1, SchedPlain>(ring, 1024, S, E);
    }
    SEAM(6);
    if (IN(7)) { p7_router(F, args); }
    SEAM(7);
    LAS unsigned* tcnt = (LAS unsigned*)(F.lds + RT_OFF); LAS unsigned* tbase = tcnt + 32;
    if (IN(8)) {
        moe_tables(F, tcnt, tbase);
        SchedMoe S{(const char*)WSP(bf16_t, WS_H2), (const char*)WSP(bf16_t, WS_WGU), WSP(unsigned, WS_LIST), tcnt, tbase, 2048u, (size_t)1024 * 1024 * 2, 1024, F.G, (int)blockIdx.x, true};
        EpiHE E{WSP(bf16_t, WS_HE), WSP(unsigned, WS_LIST)}; pg8::gemm_phase<EpiHE, SchedMoe>(ring, 1024, S, E);
    }
    SEAM(8);
    if (IN(9)) {
        moe_tables(F, tcnt, tbase);
        SchedMoe S{(const char*)WSP(bf16_t, WS_HE), (const char*)WSP(bf16_t, WS_WD), WSP(unsigned, WS_LIST), tcnt, tbase, 1024u, (size_t)1024 * 512 * 2, 512, F.G, (int)blockIdx.x, false};
        EpiY E{WSP(bf16_t, WS_Y), WSP(unsigned, WS_LIST), WSP(float, WS_SLOTW)}; pg8::gemm_phase<EpiY, SchedMoe>(ring, 512, S, E);
    }
    SEAM(9);
#ifdef DBG_CHECK
    if (IN(10)) {
        float num, den; dbg_check(F, args, num, den);
        float* acc2 = (float*)(WSP(unsigned, WS_CTL) + 12288);
        if (F.tid == 0) { atomicAdd(acc2, num); atomicAdd(acc2 + 1, den); }
        xcd_barrier(bar);
        const float tn = __hip_atomic_load(acc2, __ATOMIC_RELAXED, __HIP_MEMORY_SCOPE_AGENT), td = __hip_atomic_load(acc2 + 1, __ATOMIC_RELAXED, __HIP_MEMORY_SCOPE_AGENT);
        float E = 20.0f * sqrtf(tn / fmaxf(td, 1e-30f)); if (!(E < 50.f)) E = 50.f;
        const float* x = args.in[0]; const float* fg = args.in[23]; const int gw = F.vcu * NWAVES + F.wave, NGW = F.G * NWAVES;
        for (int row = gw; row < NTOK; row += NGW) { const f32x4* xr = (const f32x4*)(x + (size_t)row * 1024) + F.lane; f32x4 v[4]; float s = 0.f;
            for (int j = 0; j < 4; ++j) { v[j] = xr[64 * j]; s += v[j][0] * v[j][0] + v[j][1] * v[j][1] + v[j][2] * v[j][2] + v[j][3] * v[j][3]; }
            const float rs = rsqrtf(wave_sum(s) * (1.0f / 1024.0f) + EPS) * (1.0f + E);
            f32x4* orow = (f32x4*)(F.out + (size_t)row * 1024) + F.lane; for (int j = 0; j < 4; ++j) orow[64 * j] = v[j] * rs * *((const f32x4*)fg + F.lane + 64 * j); }
    }
#else
    if (IN(10)) { p10_final(F, args); }
#endif
#undef IN
#undef SEAM
}

extern "C" void kernel_launch(void* const* d_in, const int* in_sizes, int n_in, void* d_out, int out_size, void* d_ws, size_t ws_size, hipStream_t stream) {
    static int grid = 0;
    if (grid == 0) {
        if (n_in != 24 || out_size != NTOK * D || ws_size < WS_END) { fprintf(stderr, "kernel_launch: unexpected shapes (n_in %d, out %d, ws %zu)\n", n_in, out_size, ws_size); grid = -1; return; }
        int dev = 0, cus = 0, per_cu = 0;
        if (hipGetDevice(&dev) != hipSuccess || hipDeviceGetAttribute(&cus, hipDeviceAttributeMultiprocessorCount, dev) != hipSuccess) { grid = -1; return; }
        if (hipFuncSetAttribute((const void*)mk_fwd, hipFuncAttributeMaxDynamicSharedMemorySize, LDS_BYTES) != hipSuccess) { fprintf(stderr, "kernel_launch: hipFuncSetAttribute failed\n"); grid = -1; return; }
        if (hipOccupancyMaxActiveBlocksPerMultiprocessor(&per_cu, (const void*)mk_fwd, NWAVES * 64, LDS_BYTES) != hipSuccess || per_cu < 1) { fprintf(stderr, "kernel_launch: occupancy query reports %d\n", per_cu); }
        (void)hipGetLastError();
        grid = cus;
    }
    if (grid < 0) return;
    (void)hipMemsetAsync((char*)d_ws + WS_CTL, 0, CTL_ZERO_BYTES, stream);
    Args a{};
    for (int i = 0; i < 24; ++i) a.in[i] = (const float*)d_in[i];
    a.out = (float*)d_out; a.ws = (unsigned char*)d_ws;
#if MK_PER_PHASE
    for (int p = 0; p < N_PHASES; ++p) { a.ph_lo = p; a.ph_hi = p + 1; hipLaunchKernelGGL(mk_fwd, dim3(grid), dim3(NWAVES * 64), LDS_BYTES, stream, a); }
#else
    a.ph_lo = 0; a.ph_hi = N_PHASES; hipLaunchKernelGGL(mk_fwd, dim3(grid), dim3(NWAVES * 64), LDS_BYTES, stream, a);
#endif
}
```

```cpp
#include <hip/hip_runtime.h>
#include <cstdio>
#include <cstdint>

#define GAS __attribute__((address_space(1)))
#define LAS __attribute__((address_space(3)))
typedef unsigned short bf16_t;
typedef short bf16x8 __attribute__((ext_vector_type(8)));
typedef short s16x4 __attribute__((ext_vector_type(4)));
typedef float f32x2 __attribute__((ext_vector_type(2)));
typedef float f32x4 __attribute__((ext_vector_type(4)));
typedef float f32x16 __attribute__((ext_vector_type(16)));
typedef unsigned u32x2 __attribute__((ext_vector_type(2)));
typedef unsigned u32x4 __attribute__((ext_vector_type(4)));

#ifndef STG2
#define STG2 500
#endif
#ifndef DBG_MOE_SCALE
#define DBG_MOE_SCALE 1.0f
#endif
constexpr int NB = 32, SEQ = 2048, D = 1024, NTOK = NB * SEQ;
constexpr int NEXP = 32, EFF = 512;
constexpr int NWAVES = 8;
constexpr float EPS = 1e-6f;
constexpr float LOG2E = 1.4426950408889634f;
constexpr float QSCALE = 0.125f * LOG2E;
constexpr float NEGBIG = -1e30f;

constexpr size_t MiB = 1u << 20;
constexpr size_t WS_CTL = 0, CTL_ZERO_BYTES = 64 * 1024;
constexpr size_t WS_MOD = 1 * MiB;
constexpr size_t WS_BIAS1 = WS_MOD + 768 * 1024;
constexpr size_t WS_W2C = WS_BIAS1 + 4096;
constexpr size_t WS_SLOTW = 2 * MiB;
constexpr size_t WS_LIST = 3 * MiB;
constexpr size_t WS_W1C = 11 * MiB;
constexpr size_t WS_WPA = 13 * MiB;
constexpr size_t WS_WOUT = 15 * MiB;
constexpr size_t WS_WIN = 17 * MiB;
constexpr size_t WS_WGU = 25 * MiB;
constexpr size_t WS_WD = 89 * MiB;
constexpr size_t WS_H = 128 * MiB;
constexpr size_t WS_U = 256 * MiB;
constexpr size_t WS_Q = 320 * MiB;
constexpr size_t WS_KC = 384 * MiB;
constexpr size_t WS_VC = 400 * MiB;
constexpr size_t WS_KS = 416 * MiB;
constexpr size_t WS_VST = 432 * MiB;
constexpr size_t WS_KW = 448 * MiB;
constexpr size_t WS_VWT = 464 * MiB;
constexpr size_t WS_MG = 480 * MiB;
constexpr size_t WS_BG = 736 * MiB;
constexpr size_t WS_HID = 740 * MiB;
constexpr size_t WS_KCMP = 748 * MiB;
constexpr size_t WS_VCMPT = 749 * MiB;
constexpr size_t WS_PA = 816 * MiB;
constexpr size_t WS_H2 = 256 * MiB;
constexpr size_t WS_HE = 384 * MiB;
constexpr size_t WS_Y = 512 * MiB;
constexpr size_t WS_END = 944 * MiB;
constexpr int CW_BAR = 4096;
constexpr int CW_CNT = 8192;
constexpr int CW_Q0 = 12800;

constexpr int RING_BYTES = 131072;
constexpr int LDS_ROUTER_W = 36 * 1024 * 4;
constexpr int RT_OFF = LDS_ROUTER_W;
constexpr int MISC_OFF = 153600;
constexpr int LDS_BYTES = 155648;

typedef __bf16 bf16x2_t __attribute__((ext_vector_type(2)));
__device__ __forceinline__ unsigned cvt_pk_bf16(float lo, float hi) { const f32x2 v = {lo, hi}; const bf16x2_t b = __builtin_convertvector(v, bf16x2_t); return __builtin_bit_cast(unsigned, b); }
__device__ __forceinline__ float bf_lo(unsigned u) { return __uint_as_float(u << 16); }
__device__ __forceinline__ float bf_hi(unsigned u) { return __uint_as_float(u & 0xffff0000u); }
__device__ __forceinline__ float bf1(bf16_t b) { return __uint_as_float((unsigned)b << 16); }
__device__ __forceinline__ float fast_exp2(float x) { return __builtin_amdgcn_exp2f(x); }
__device__ __forceinline__ float fast_rcp(float x) { return __builtin_amdgcn_rcpf(x); }
__device__ __forceinline__ float sigmoidf_(float x) { return fast_rcp(1.0f + fast_exp2(-x * LOG2E)); }
__device__ __forceinline__ float gelu_tanh(float x) { const float u = 0.7978845608028654f * (x + 0.044715f * x * x * x); return x * fast_rcp(1.0f + fast_exp2(-2.0f * LOG2E * u)); }
__device__ __forceinline__ float wave_sum(float v) {
#pragma unroll
    for (int o = 1; o < 64; o <<= 1) v += __shfl_xor(v, o);
    return v;
}
#define LDS_WAIT() asm volatile("s_waitcnt lgkmcnt(0)" ::: "memory")
#define VM_WAIT() asm volatile("s_waitcnt vmcnt(0)" ::: "memory")
namespace pg8 {
constexpr int BM = 256, BK = 64, HALF = 128, HTB = HALF * BK * 2, STAGE_BYTES = 8 * HTB;
__host__ __device__ __forceinline__ int lds_byte(int r, int c) { const int st = (r >> 4) * 2 + (c >> 5), rr = r & 15, cc = c & 31, ob = rr * 64 + cc * 2; return st * 1024 + (ob ^ (((ob >> 9) & 1) << 5)); }
__host__ __device__ __forceinline__ void stage_rc(int b, int& R, int& C) { const int st = b / 1024, sb = b % 1024, swz = sb ^ (((sb >> 9) & 1) << 5); R = (st >> 1) * 16 + swz / 64; C = (st & 1) * 32 + (swz % 64) / 2; }
__host__ __device__ __forceinline__ int perm32(int rho) { const int n = rho >> 4, i = rho & 15; return 8 * (i >> 2) + 4 * n + (i & 3); }

struct Unit { const char* A; const char* B; int pm, pn, e, nrows; };

struct StaticOrder {
    int nM, nN, nwg, G, c;
    __device__ void init(int M, int N, int G_, int c_) { nM = M / BM; nN = N / BM; nwg = nM * nN; G = G_; c = c_; }
    __device__ bool next(int i, int& pm, int& pn) const {
        const long L = (long)i * G + c; if (L >= nwg) return false;
        int wgid = (int)L; { const int q = nwg / 8, r = nwg % 8, xcd = wgid % 8, off = wgid / 8; wgid = (xcd < r ? xcd * (q + 1) : r * (q + 1) + (xcd - r) * q) + off; }
        const int nig = 8 * nN, gid = wgid / nig, fm = gid * 8, gsz = (nM - fm) < 8 ? (nM - fm) : 8;
        pm = fm + ((wgid % nig) % gsz); pn = (wgid % nig) / gsz; return true;
    }
};

template <class Epi, class Sched>
__device__ __forceinline__ void gemm_phase(LAS unsigned char* lds, const int K, const Sched& S, const Epi& E) {
    const int tid = threadIdx.x, wid = __builtin_amdgcn_readfirstlane(tid >> 6), lane = tid & 63, wr = wid >> 2, wc = wid & 3, fr = lane & 15, fq = lane >> 4;
    const int nt = K / BK;
    int Rr[2], Cc[2];
    unsigned voffB[2];
#pragma unroll
    for (int i = 0; i < 2; ++i) { int R, C; stage_rc(tid * 16 + i * 8192, R, C); Rr[i] = R; Cc[i] = C; const int Rb = Epi::PERM ? ((R & ~31) + perm32(R & 31)) : R; voffB[i] = (unsigned)(Rb * K + C) * 2u; }
    const size_t kstep = (size_t)(BK * 2);
    const size_t hstepB = (size_t)HALF * K * 2;
    const unsigned ldsw = (unsigned)wid * 1024u;
    const int aoff = lds_byte(wr * 64 + fr, fq * 8), boff = lds_byte(wc * 32 + fr, fq * 8);
#define PG8_SA(b, h) (((b) * 2 + (h)) * HTB)
#define PG8_SB(b, h) ((4 + (b) * 2 + (h)) * HTB)
#define PG8_STAGE2(bufoff, gbase, v0, v1) do { \
        __builtin_amdgcn_global_load_lds((const unsigned*)((const char*)(gbase) + (v0)), (LAS unsigned*)(lds + (bufoff) + ldsw), 16, 0, 0); \
        __builtin_amdgcn_global_load_lds((const unsigned*)((const char*)(gbase) + (v1)), (LAS unsigned*)(lds + (bufoff) + ldsw + 8192), 16, 0, 0); } while (0)
#define PG8_STAGEB(bufoff, gbase) PG8_STAGE2(bufoff, gbase, voffB[0], voffB[1])
#define PG8_LDA(dst, b, h) do { _Pragma("unroll") for (int m = 0; m < 4; ++m) _Pragma("unroll") for (int k = 0; k < 2; ++k) dst[m][k] = *(const LAS bf16x8*)(lds + PG8_SA(b, h) + aoff + m * 2048 + k * 1024); } while (0)
#define PG8_LDB(dst, b, h) do { _Pragma("unroll") for (int n = 0; n < 2; ++n) _Pragma("unroll") for (int k = 0; k < 2; ++k) dst[n][k] = *(const LAS bf16x8*)(lds + PG8_SB(b, h) + boff + n * 2048 + k * 1024); } while (0)
#define PG8_MMA(ai, bj, At, Bt) do { __builtin_amdgcn_s_setprio(1); _Pragma("unroll") for (int m = 0; m < 4; ++m) _Pragma("unroll") for (int n = 0; n < 2; ++n) _Pragma("unroll") for (int k = 0; k < 2; ++k) \
        acc[ai][bj][m][n] = __builtin_amdgcn_mfma_f32_16x16x32_bf16(Bt[n][k], At[m][k], acc[ai][bj][m][n], 0, 0, 0); __builtin_amdgcn_s_setprio(0); } while (0)
#define PG8_WAIT_V(n) asm volatile("s_waitcnt vmcnt(" #n ")" ::: "memory")
#define PG8_WAIT_L(n) asm volatile("s_waitcnt lgkmcnt(" #n ")" ::: "memory")
#define PG8_BAR __builtin_amdgcn_s_barrier()
#define PG8_SCHED __builtin_amdgcn_sched_barrier(0)
    Unit cur, nxt; int ui = 0; u32x2 pfv = {0u, 0u};
    if (!S.next(0, cur)) return;
    f32x4 acc[2][2][4][2];
#pragma unroll
    for (int a = 0; a < 2; ++a)
#pragma unroll
        for (int b = 0; b < 2; ++b)
#pragma unroll
            for (int m = 0; m < 4; ++m)
#pragma unroll
                for (int n = 0; n < 2; ++n) acc[a][b][m][n] = (f32x4){0.f, 0.f, 0.f, 0.f};
    bf16x8 At[4][2], B0[2][2], B1[2][2];
    unsigned c00, c01, c10, c11, n00, n01, n10, n11;
    c00 = S.aoff(cur, Rr[0]) + (unsigned)Cc[0] * 2u; c01 = S.aoff(cur, Rr[1]) + (unsigned)Cc[1] * 2u;
    c10 = S.aoff(cur, Rr[0] + HALF) + (unsigned)Cc[0] * 2u; c11 = S.aoff(cur, Rr[1] + HALF) + (unsigned)Cc[1] * 2u;
    const char* cA = cur.A; const char* cB = cur.B;
    S.prefetch(cur, 0);
    PG8_STAGEB(PG8_SB(0, 0), cB); PG8_STAGEB(PG8_SB(0, 1), cB + hstepB); PG8_STAGE2(PG8_SA(0, 0), cA, c00, c01); PG8_STAGE2(PG8_SA(0, 1), cA, c10, c11);
    if (wr == 1) PG8_BAR;
    PG8_WAIT_V(2); PG8_BAR;
    PG8_STAGEB(PG8_SB(1, 0), cB + kstep); PG8_STAGE2(PG8_SA(1, 0), cA + kstep, c00, c01); PG8_STAGEB(PG8_SB(1, 1), cB + hstepB + kstep);
    PG8_WAIT_V(6); PG8_BAR;
    for (;;) {
        const bool has_next = S.next(ui + 1, nxt);
        const char* nA = has_next ? nxt.A : cA; const char* nB = has_next ? nxt.B : cB;
        if (has_next) {
            n00 = S.aoff(nxt, Rr[0]) + (unsigned)Cc[0] * 2u; n01 = S.aoff(nxt, Rr[1]) + (unsigned)Cc[1] * 2u;
            n10 = S.aoff(nxt, Rr[0] + HALF) + (unsigned)Cc[0] * 2u; n11 = S.aoff(nxt, Rr[1] + HALF) + (unsigned)Cc[1] * 2u;
        } else { n00 = c00; n01 = c01; n10 = c10; n11 = c11; }
        for (int t = 0; t < nt; t += 2) {
            if constexpr (Epi::HAS_MID) { if (t == nt / 2) E.mid(acc, cur, wr, wc, fr, fq); }
            const bool last = (t == nt - 2);
            const char* a1 = cA + (size_t)(t + 1) * kstep;
            const char* a2 = last ? nA : cA + (size_t)(t + 2) * kstep; const char* b2 = last ? nB : cB + (size_t)(t + 2) * kstep;
            const char* a3 = a2 + kstep; const char* b3 = b2 + kstep;
            const unsigned x00 = last ? n00 : c00, x01 = last ? n01 : c01, x10 = last ? n10 : c10, x11 = last ? n11 : c11;
            PG8_LDB(B0, 0, 0); PG8_LDB(B1, 0, 1); PG8_SCHED; PG8_LDA(At, 0, 0); PG8_STAGE2(PG8_SA(1, 1), a1, c10, c11);
            PG8_WAIT_V(8); PG8_WAIT_L(0); PG8_BAR; PG8_MMA(0, 0, At, B0); PG8_MMA(0, 1, At, B1); PG8_BAR; PG8_SCHED;
            PG8_LDA(At, 0, 1); PG8_STAGEB(PG8_SB(0, 0), b2); PG8_STAGEB(PG8_SB(0, 1), b2 + hstepB); PG8_STAGE2(PG8_SA(0, 0), a2, x00, x01);
            PG8_WAIT_V(8); PG8_WAIT_L(0); PG8_BAR; PG8_MMA(1, 0, At, B0); PG8_MMA(1, 1, At, B1); PG8_BAR; PG8_SCHED;
            PG8_LDB(B0, 1, 0); PG8_LDB(B1, 1, 1); PG8_SCHED; PG8_LDA(At, 1, 0); PG8_STAGE2(PG8_SA(0, 1), a2, x10, x11);
            PG8_WAIT_V(8); PG8_WAIT_L(0); PG8_BAR; PG8_MMA(0, 0, At, B0); PG8_MMA(0, 1, At, B1); PG8_BAR; PG8_SCHED;
            PG8_LDA(At, 1, 1); PG8_STAGEB(PG8_SB(1, 0), b3); PG8_STAGEB(PG8_SB(1, 1), b3 + hstepB); PG8_STAGE2(PG8_SA(1, 0), a3, x00, x01);
            PG8_WAIT_V(8); PG8_WAIT_L(0); PG8_BAR; PG8_MMA(1, 0, At, B0); PG8_MMA(1, 1, At, B1); PG8_BAR; PG8_SCHED;
        }
        if (wr == 0) PG8_BAR;
        E(acc, cur, wr, wc, fr, fq, ui);
        if (!has_next) break;
        pfv = S.pf_load(nxt);
#pragma unroll
        for (int a = 0; a < 2; ++a)
#pragma unroll
            for (int b = 0; b < 2; ++b)
#pragma unroll
                for (int m = 0; m < 4; ++m)
#pragma unroll
                    for (int n = 0; n < 2; ++n) acc[a][b][m][n] = (f32x4){0.f, 0.f, 0.f, 0.f};
        cur = nxt; cA = nA; cB = nB; c00 = n00; c01 = n01; c10 = n10; c11 = n11; ++ui;
        if (wr == 1) PG8_BAR;
        S.pf_store(ui, pfv);
    }
    PG8_WAIT_V(0);
    PG8_BAR;
#undef PG8_SA
#undef PG8_SB
#undef PG8_STAGE2
#undef PG8_STAGEB
#undef PG8_LDA
#undef PG8_LDB
#undef PG8_MMA
#undef PG8_WAIT_V
#undef PG8_WAIT_L
#undef PG8_BAR
#undef PG8_SCHED
}
}
using pg8::Unit;
typedef f32x4 AccT[2][2][4][2];

__device__ __forceinline__ u32x4 pack8(const f32x4 a, const f32x4 b) { u32x4 w; w.x = cvt_pk_bf16(a[0], a[1]); w.y = cvt_pk_bf16(a[2], a[3]); w.z = cvt_pk_bf16(b[0], b[1]); w.w = cvt_pk_bf16(b[2], b[3]); return w; }
__device__ __forceinline__ void unpack8(const u32x4 w, f32x4& a, f32x4& b) { a = (f32x4){bf_lo(w.x), bf_hi(w.x), bf_lo(w.y), bf_hi(w.y)}; b = (f32x4){bf_lo(w.z), bf_hi(w.z), bf_lo(w.w), bf_hi(w.w)}; }

struct SchedPlain {
    const char* A; const char* Bt; unsigned lda; int K; pg8::StaticOrder so;
    __device__ __forceinline__ bool next(int i, Unit& u) const { int pm, pn; if (!so.next(i, pm, pn)) return false; u.pm = pm; u.pn = pn; u.e = 0; u.nrows = 256;
        u.A = A + (size_t)pm * 256 * lda; u.B = Bt + (size_t)pn * 256 * K * 2; return true; }
    __device__ __forceinline__ unsigned aoff(const Unit&, int R) const { return (unsigned)R * lda; }
    __device__ __forceinline__ void prefetch(const Unit&, int) const {}
    __device__ __forceinline__ u32x2 pf_load(const Unit&) const { return (u32x2){0u, 0u}; }
    __device__ __forceinline__ void pf_store(int, u32x2) const {}
};

struct EpiG1 {
    static constexpr bool PERM = true, HAS_MID = false;
    bf16_t *U, *Q, *KC, *VC, *KS, *VST, *KW, *VWT, *MG, *BG;
    __device__ __forceinline__ void operator()(const AccT& acc, const Unit& u, int wr, int wc, int fr, int fq, int ui = 0) const {
        const int pn = u.pn < 8 ? u.pn + 7 : (u.pn < 12 ? u.pn - 8 : 18 - u.pn);
        const int row0 = u.pm * 256 + wr * 64 + fr; const int cc = wc * 32 + 8 * fq;
#pragma unroll
        for (int ai = 0; ai < 2; ++ai)
#pragma unroll
            for (int m = 0; m < 4; ++m) {
                const int row = row0 + ai * 128 + m * 16;
#pragma unroll
                for (int bj = 0; bj < 2; ++bj) {
                    f32x4 v0 = acc[ai][bj][m][0], v1 = acc[ai][bj][m][1];
                    const int col = 128 * bj + cc;
                    if (pn < 2) { *(u32x4*)(U + (size_t)row * 512 + pn * 256 + col) = pack8(v0, v1); }
                    else if (pn < 4) { v0 = v0 * QSCALE; v1 = v1 * QSCALE; *(u32x4*)(Q + (size_t)row * 512 + (pn - 2) * 256 + col) = pack8(v0, v1); }
                    else if (pn < 7) {
                        const int g = cc >> 6, d = cc & 63, b = row >> 11, s = row & 2047;
                        const size_t kidx = ((size_t)(b * 2 + g) * 2048 + s) * 64 + d;
                        if (bj == 0) { bf16_t* Kb = pn == 4 ? KC : (pn == 5 ? KS : KW); *(u32x4*)(Kb + kidx) = pack8(v0, v1); }
                        else if (pn == 4) { *(u32x4*)(VC + kidx) = pack8(v0, v1); }
                        else {
                            const u32x4 w = pack8(v0, v1); const int odd = fr & 1;
                            bf16_t* Vt = (pn == 5 ? VST : VWT) + (((size_t)(b * 2 + g) * 32 + (s >> 6)) * 64 + d + odd) * 64 + ((s & 63) & ~1);
#pragma unroll
                            for (int q = 0; q < 4; ++q) { const unsigned mine = q == 0 ? w.x : (q == 1 ? w.y : (q == 2 ? w.z : w.w));
                                const unsigned nb = (unsigned)__builtin_amdgcn_update_dpp(0, (int)mine, 0xB1, 0xF, 0xF, true);
                                const unsigned o = odd ? ((nb >> 16) | (mine & 0xffff0000u)) : ((mine & 0xffffu) | (nb << 16));
                                *(unsigned*)(Vt + (size_t)(2 * q) * 64) = o; } }
                    }
                    else if (pn < 15) {
                        if (bj == 0) { f32x4 a0 = v0, a1 = v1, b0 = acc[ai][1][m][0], b1 = acc[ai][1][m][1];
#pragma unroll
                            for (int i = 0; i < 4; ++i) { b0[i] = fmaxf(sigmoidf_(b0[i]), 1e-20f); b1[i] = fmaxf(sigmoidf_(b1[i]), 1e-20f); a0[i] = sigmoidf_(a0[i]) * fast_rcp(b0[i]); a1[i] = sigmoidf_(a1[i]) * fast_rcp(b1[i]); }
                            bf16_t* mg = MG + (size_t)row * 2048 + (pn - 7) * 128 + cc; *(u32x4*)mg = pack8(a0, a1); *(u32x4*)(mg + 1024) = pack8(b0, b1); } }
                }
            }
    }
};

struct SchedCmp {
    const char* KC; const char* VC; const char* W1; int c;
    __device__ __forceinline__ bool next(int i, Unit& u) const { if (i != 0 || c >= 64) return false; u.e = c >> 5; u.pm = c & 31; u.pn = 0; u.nrows = 256;
        u.A = (u.e ? VC : KC) + (size_t)u.pm * 256 * 2048; u.B = W1 + (size_t)u.e * 256 * 2048 * 2; return true; }
    __device__ __forceinline__ unsigned aoff(const Unit&, int R) const { return (unsigned)R * 2048u; }
    __device__ __forceinline__ void prefetch(const Unit&, int) const {}
    __device__ __forceinline__ u32x2 pf_load(const Unit&) const { return (u32x2){0u, 0u}; }
    __device__ __forceinline__ void pf_store(int, u32x2) const {}
};
struct EpiHid {
    static constexpr bool PERM = true, HAS_MID = false;
    bf16_t* HID; const float* bias1;
    __device__ __forceinline__ void operator()(const AccT& acc, const Unit& u, int wr, int wc, int fr, int fq, int ui = 0) const {
        const int row0 = u.pm * 256 + wr * 64 + fr; const int cc = wc * 32 + 8 * fq; bf16_t* H = HID + (size_t)u.e * 8192 * 256; const float* bs = bias1 + u.e * 256;
#pragma unroll
        for (int bj = 0; bj < 2; ++bj) { const int col = 128 * bj + cc; const f32x4 b0 = *(const f32x4*)(bs + col), b1 = *(const f32x4*)(bs + col + 4);
#pragma unroll
            for (int ai = 0; ai < 2; ++ai)
#pragma unroll
                for (int m = 0; m < 4; ++m) { const int row = row0 + ai * 128 + m * 16; f32x4 v0 = acc[ai][bj][m][0] + b0, v1 = acc[ai][bj][m][1] + b1;
#pragma unroll
                    for (int i = 0; i < 4; ++i) { v0[i] = gelu_tanh(v0[i]); v1[i] = gelu_tanh(v1[i]); }
                    *(u32x4*)(H + (size_t)row * 256 + col) = pack8(v0, v1); } }
    }
};

struct EpiMix {
    static constexpr bool PERM = true, HAS_MID = true;
    const bf16_t* MG; bf16_t* MIX;
    __device__ __forceinline__ void mid(AccT& acc, const Unit& u, int wr, int wc, int fr, int fq, int ui = 0) const {
        unsigned off0 = (unsigned)(u.pm * 256 + wr * 64 + fr) * 2048u + (unsigned)(u.pn * 256 + wc * 32 + 8 * fq);
        asm volatile("" : "+v"(off0));
#pragma unroll
        for (int ai = 0; ai < 2; ++ai) {
            u32x4 g[4][2];
#pragma unroll
            for (int m = 0; m < 4; ++m)
#pragma unroll
                for (int bj = 0; bj < 2; ++bj) g[m][bj] = *(const u32x4*)(MG + off0 + (unsigned)((ai * 128 + m * 16) * 2048 + 128 * bj));
#pragma unroll
            for (int m = 0; m < 4; ++m)
#pragma unroll
                for (int bj = 0; bj < 2; ++bj) { f32x4 a0, a1; unpack8(g[m][bj], a0, a1); acc[ai][bj][m][0] *= a0; acc[ai][bj][m][1] *= a1; }
            asm volatile("" : "+v"(acc[ai][0][0][0]), "+v"(acc[ai][1][0][0]) :: "memory");
        }
    }
    __device__ __forceinline__ void operator()(const AccT& acc, const Unit& u, int wr, int wc, int fr, int fq, int ui = 0) const {
        const int row0 = u.pm * 256 + wr * 64 + fr; const int c0 = u.pn * 256 + wc * 32 + 8 * fq;
#pragma unroll
        for (int ai = 0; ai < 2; ++ai) {
            u32x4 g[4][2];
#pragma unroll
            for (int m = 0; m < 4; ++m)
#pragma unroll
                for (int bj = 0; bj < 2; ++bj) g[m][bj] = *(const u32x4*)(MG + (size_t)(row0 + ai * 128 + m * 16) * 2048 + 1024 + c0 + 128 * bj);
#pragma unroll
            for (int m = 0; m < 4; ++m)
#pragma unroll
                for (int bj = 0; bj < 2; ++bj) { f32x4 g0, g1; unpack8(g[m][bj], g0, g1);
                    *(u32x4*)(MIX + (size_t)(row0 + ai * 128 + m * 16) * 1024 + c0 + 128 * bj) = pack8(acc[ai][bj][m][0] * g0, acc[ai][bj][m][1] * g1); }
        }
    }
};
struct EpiDelta {
    static constexpr bool PERM = true, HAS_MID = false;
    const float* MOD; bf16_t* DELTA;
    __device__ __forceinline__ void operator()(const AccT& acc, const Unit& u, int wr, int wc, int fr, int fq, int ui = 0) const {
        const int row0 = u.pm * 256 + wr * 64 + fr; const int c0 = u.pn * 256 + wc * 32 + 8 * fq; const int b = (u.pm * 256) >> 11;
        const float* g1 = MOD + (size_t)b * 6144 + 2048;
#pragma unroll
        for (int bj = 0; bj < 2; ++bj) { const int col = c0 + 128 * bj; const f32x4 g0 = *(const f32x4*)(g1 + col), g1v = *(const f32x4*)(g1 + col + 4);
#pragma unroll
            for (int ai = 0; ai < 2; ++ai)
#pragma unroll
                for (int m = 0; m < 4; ++m) *(u32x4*)(DELTA + (size_t)(row0 + ai * 128 + m * 16) * 1024 + col) = pack8(acc[ai][bj][m][0] * g0, acc[ai][bj][m][1] * g1v); }
    }
};

struct SchedMoe {
    const char* A; const char* W; const unsigned* LIST; const LAS unsigned* tcnt; const LAS unsigned* tbase; unsigned lda; size_t wstride; int K; int G, c; bool by_token;
    __device__ __forceinline__ bool next(int i, Unit& u) const {
        if (i >= 32) return false; const unsigned w = tbase[40 + i]; if (w == 0xffffffffu) return false;
        const int e = (int)(w >> 16), tile = (int)((w >> 2) & 0x3fffu), pn = (int)(w & 3u); const int cnt = (int)tcnt[e];
        u.e = e; u.pm = tile; u.pn = pn; u.nrows = (cnt - tile * 256) < 256 ? (cnt - tile * 256) : 256;
        u.A = A; u.B = W + (size_t)e * wstride + (size_t)pn * 256 * K * 2; return true; }
    __device__ __forceinline__ unsigned slot(const Unit& u, int R) const { const int r = R < u.nrows ? R : u.nrows - 1; return LIST[(size_t)u.e * 65536 + u.pm * 256 + r]; }
    __device__ __forceinline__ unsigned aoff(const Unit& u, int R) const { const unsigned s = slot(u, R); return (by_token ? (s >> 1) : s) * lda; }
    LAS u32x2* tab; const float* SLOTW;
    __device__ __forceinline__ u32x2 pf_load(const Unit& u) const { const int tid = threadIdx.x; u32x2 e = {0u, 0u}; if (tid < 256) { const unsigned s = slot(u, tid); e.x = s; e.y = SLOTW ? __float_as_uint(SLOTW[s]) : 0u; } return e; }
    __device__ __forceinline__ void pf_store(int ui, u32x2 e) const { const int tid = threadIdx.x; if (tid < 256) tab[(ui % 3) * 256 + tid] = e; }
    __device__ __forceinline__ void prefetch(const Unit& u, int ui) const { pf_store(ui, pf_load(u)); }
};
struct EpiHE {
    static constexpr bool PERM = true, HAS_MID = false;
    bf16_t* HE; const LAS u32x2* tab;
    __device__ __forceinline__ void operator()(const AccT& acc, const Unit& u, int wr, int wc, int fr, int fq, int ui = 0) const {
        const int cc = u.pn * 128 + wc * 32 + 8 * fq;
#pragma unroll
        for (int ai = 0; ai < 2; ++ai)
#pragma unroll
            for (int m = 0; m < 4; ++m) { const int R = ai * 128 + wr * 64 + m * 16 + fr;
                if (R < u.nrows) { const unsigned s = tab[(ui % 3) * 256 + R].x; f32x4 g0 = acc[ai][0][m][0], g1 = acc[ai][0][m][1]; const f32x4 u0 = acc[ai][1][m][0], u1 = acc[ai][1][m][1];
#pragma unroll
                    for (int i = 0; i < 4; ++i) { g0[i] = g0[i] * sigmoidf_(g0[i]) * u0[i]; g1[i] = g1[i] * sigmoidf_(g1[i]) * u1[i]; }
                    *(u32x4*)(HE + (size_t)s * 512 + cc) = pack8(g0, g1); } }
    }
};
struct EpiY {
    static constexpr bool PERM = true, HAS_MID = false;
    bf16_t* Y; const LAS u32x2* tab;
    __device__ __forceinline__ void operator()(const AccT& acc, const Unit& u, int wr, int wc, int fr, int fq, int ui = 0) const {
        const int c0 = u.pn * 256 + wc * 32 + 8 * fq;
#pragma unroll
        for (int ai = 0; ai < 2; ++ai)
#pragma unroll
            for (int m = 0; m < 4; ++m) { const int R = ai * 128 + wr * 64 + m * 16 + fr;
                if (R < u.nrows) { const u32x2 e = tab[(ui % 3) * 256 + R]; const unsigned s = e.x; const float w = __uint_as_float(e.y);
#pragma unroll
                    for (int bj = 0; bj < 2; ++bj) *(u32x4*)(Y + (size_t)s * 1024 + c0 + 128 * bj) = pack8(acc[ai][bj][m][0] * w, acc[ai][bj][m][1] * w); } }
    }
};
struct Args { const float* in[24]; float* out; unsigned char* ws; int ph_lo, ph_hi; };
struct Frame {
    LAS unsigned char* lds;
    unsigned char* ws;
    float* out;
    int tid, lane, wave, vcu, G;
};
#define WSP(T, off) ((T*)(F.ws + (off)))

struct TrItem { const float* W; bf16_t* dst; int ldw, nvalid, ldd; };
__device__ __forceinline__ void p0_tr_load(const TrItem& t, f32x4 (&v)[8], int lane) {
    const int rg = lane >> 3, c4 = (lane & 7) * 4;
#pragma unroll
    for (int i = 0; i < 8; ++i) v[i] = c4 < t.nvalid ? *(const f32x4*)(t.W + (size_t)(rg + 8 * i) * t.ldw + c4) : (f32x4){0.f, 0.f, 0.f, 0.f};
}
__device__ __forceinline__ void p0_tr_finish(const TrItem& t, const f32x4 (&v)[8], LAS float* scr, int lane) {
    const int rg = lane >> 3, c4 = (lane & 7) * 4;
#pragma unroll
    for (int i = 0; i < 8; ++i) { LAS float* d = scr + (rg + 8 * i) * 33 + c4; d[0] = v[i][0]; d[1] = v[i][1]; d[2] = v[i][2]; d[3] = v[i][3]; }
    LDS_WAIT(); asm volatile("" ::: "memory");
    const int c8 = lane & 7;
#pragma unroll
    for (int j = 0; j < 4; ++j) { const int n = (lane >> 3) + 8 * j; const LAS float* s = scr + (8 * c8) * 33 + n;
        u32x4 o; o.x = cvt_pk_bf16(s[0 * 33], s[1 * 33]); o.y = cvt_pk_bf16(s[2 * 33], s[3 * 33]); o.z = cvt_pk_bf16(s[4 * 33], s[5 * 33]); o.w = cvt_pk_bf16(s[6 * 33], s[7 * 33]);
        *(u32x4*)(t.dst + (size_t)n * t.ldd + 8 * c8) = o; }
    LDS_WAIT(); asm volatile("" ::: "memory");
}
__device__ __forceinline__ void p0_prologue(Frame& F, const Args& AR) {
    const float* c_in = AR.in[1]; const float* ada_w = AR.in[2]; const float* ada_b = AR.in[3];
    const float* w_in = AR.in[5]; const float* pool_w = AR.in[6]; const float* pool_scale = AR.in[7]; const float* cmp_pos = AR.in[8]; const float* cmp_w1 = AR.in[9];
    const float* cmp_b1 = AR.in[10]; const float* cmp_w2 = AR.in[11]; const float* w_up_pool = AR.in[12]; const float* w_up_attn = AR.in[13]; const float* w_out = AR.in[14];
    const float* wg = AR.in[20]; const float* wu = AR.in[21]; const float* wd = AR.in[22];
    if (F.vcu < 104) {
        LAS float* red = (LAS float*)F.lds;
        const int item = F.vcu;
        if (item < 96) {
            LAS float* cl = (LAS float*)F.lds;
            for (int i = F.tid; i < 32 * 256; i += 512) { const int b = i & 31, k4 = (i >> 5) * 4; const f32x4 cv = *(const f32x4*)(c_in + b * 1024 + k4); cl[(k4 + 0) * 32 + b] = cv[0]; cl[(k4 + 1) * 32 + b] = cv[1]; cl[(k4 + 2) * 32 + b] = cv[2]; cl[(k4 + 3) * 32 + b] = cv[3]; }
            __syncthreads();
            const int n = item * 64 + F.lane; float acc[32];
#pragma unroll
            for (int b = 0; b < 32; ++b) acc[b] = 0.f;
            const int k0 = F.wave * 128;
#pragma unroll 4
            for (int k = k0; k < k0 + 128; ++k) { const float w = ada_w[(size_t)k * 6144 + n];
#pragma unroll
                for (int b4 = 0; b4 < 8; ++b4) { const f32x4 cv = *(const LAS f32x4*)(cl + k * 32 + 4 * b4); acc[4 * b4] += cv[0] * w; acc[4 * b4 + 1] += cv[1] * w; acc[4 * b4 + 2] += cv[2] * w; acc[4 * b4 + 3] += cv[3] * w; } }
            __syncthreads();
#pragma unroll
            for (int b = 0; b < 32; ++b) red[(F.wave * 32 + b) * 64 + F.lane] = acc[b];
            __syncthreads();
            for (int o = F.tid; o < 2048; o += 512) { float s = 0.f;
#pragma unroll
                for (int w = 0; w < 8; ++w) s += red[w * 2048 + o];
                const int b = o >> 6, nn = item * 64 + (o & 63); WSP(float, WS_MOD)[b * 6144 + nn] = s + ada_b[nn]; }
            __syncthreads();
        } else {
            const int it = item - 96, i = it >> 2, n = (it & 3) * 64 + F.lane; float acc = 0.f; const int k0 = F.wave * 256;
            for (int k = k0; k < k0 + 256; ++k) acc += cmp_pos[i * 2048 + k] * cmp_w1[((size_t)i * 2048 + k) * 256 + n];
            red[F.wave * 64 + F.lane] = acc;
            __syncthreads();
            if (F.tid < 64) { float s = 0.f;
#pragma unroll
                for (int w = 0; w < 8; ++w) s += red[w * 64 + F.tid];
                const int nn = (it & 3) * 64 + F.tid; WSP(float, WS_BIAS1)[i * 256 + nn] = s + cmp_b1[i * 256 + nn]; }
            __syncthreads();
        }
    }
    LAS float* scr = (LAS float*)(F.lds + F.wave * 16384);
    const int gw = F.vcu * NWAVES + F.wave, NGW = F.G * NWAVES;
    constexpr int T_IN = 16 * 128, T_GU = 32 * 512, T_D = 32 * 256, T_A = 256, T_OUT = 512, T_W1C = 512, T_W2C = 16, T_WP = 512;
    constexpr int NTR = T_IN + T_GU + T_D + T_A + T_OUT + T_W1C + T_W2C;
#define P0_DECODE(it_, T_) do { int r = (it_); \
        if (r < T_GU) { const int e = r >> 9, rr = r & 511, kb = rr >> 5, nb = rr & 31, n0 = 32 * nb, tile = n0 >> 8, bj = (n0 >> 7) & 1, c0 = n0 & 127; \
            T_.W = (bj ? wu : wg) + (size_t)e * 1024 * 512 + (size_t)(64 * kb) * 512 + tile * 128 + c0; T_.ldw = 512; T_.nvalid = 32; T_.dst = WSP(bf16_t, WS_WGU) + (size_t)e * 1024 * 1024 + (size_t)n0 * 1024 + 64 * kb; T_.ldd = 1024; break; } r -= T_GU; \
        if (r < T_D) { const int e = r >> 8, rr = r & 255, kb = rr >> 5, nb = rr & 31; \
            T_.W = wd + (size_t)e * 512 * 1024 + (size_t)(64 * kb) * 1024 + 32 * nb; T_.ldw = 1024; T_.nvalid = 32; T_.dst = WSP(bf16_t, WS_WD) + (size_t)e * 1024 * 512 + (size_t)(32 * nb) * 512 + 64 * kb; T_.ldd = 512; break; } r -= T_D; \
        if (r < T_IN) { const int kb = r >> 7, nb = r & 127, np = 32 * nb; const int pt = np >> 8; const int lt = pt < 8 ? pt + 7 : (pt < 12 ? pt - 8 : (pt < 15 ? 18 - pt : pt)); const int n0 = lt * 256 + (np & 255); int src0, nv;        \
            if (n0 < 1792) { src0 = n0; nv = 32; } else if (n0 < 3840) { const int q = n0 - 1792; src0 = 1816 + ((q >> 7) & 1) * 1024 + (q >> 8) * 128 + (q & 127); nv = 32; } else if (n0 == 3840) { src0 = 1792; nv = 24; } else { src0 = 0; nv = 0; } \
            T_.W = w_in + (size_t)(64 * kb) * 3864 + src0; T_.ldw = 3864; T_.nvalid = nv; T_.dst = WSP(bf16_t, WS_WIN) + (size_t)np * 1024 + 64 * kb; T_.ldd = 1024; break; } r -= T_IN; \
        if (r < T_A) { const int kb = r >> 5, nb = r & 31; \
            T_.W = w_up_attn + (size_t)(64 * kb) * 1024 + 32 * nb; T_.ldw = 1024; T_.nvalid = 32; T_.dst = WSP(bf16_t, WS_WPA) + (size_t)(32 * nb) * 1024 + 512 + 64 * kb; T_.ldd = 1024; break; } r -= T_A; \
        if (r < T_OUT) { const int kb = r >> 5, nb = r & 31; \
            T_.W = w_out + (size_t)(64 * kb) * 1024 + 32 * nb; T_.ldw = 1024; T_.nvalid = 32; T_.dst = WSP(bf16_t, WS_WOUT) + (size_t)(32 * nb) * 1024 + 64 * kb; T_.ldd = 1024; break; } r -= T_OUT; \
        if (r < T_W1C) { const int i = r >> 8, rr = r & 255, kb = rr >> 3, nb = rr & 7; \
            T_.W = cmp_w1 + (size_t)i * 2048 * 256 + (size_t)(64 * kb) * 256 + 32 * nb; T_.ldw = 256; T_.nvalid = 32; T_.dst = WSP(bf16_t, WS_W1C) + (size_t)i * 256 * 2048 + (size_t)(32 * nb) * 2048 + 64 * kb; T_.ldd = 2048; break; } r -= T_W1C; \
        { const int i = r >> 3, rr = r & 7, kb = rr >> 1, nb = rr & 1; \
            T_.W = cmp_w2 + (size_t)i * 256 * 64 + (size_t)(64 * kb) * 64 + 32 * nb; T_.ldw = 64; T_.nvalid = 32; T_.dst = WSP(bf16_t, WS_W2C) + (size_t)i * 64 * 256 + (size_t)(32 * nb) * 256 + 64 * kb; T_.ldd = 256; } } while (0)
    if (gw < NTR) {
        TrItem ta, tb; f32x4 va[8], vb[8];
        P0_DECODE(gw, ta); p0_tr_load(ta, va, F.lane);
        for (int it = gw; it < NTR; it += 2 * NGW) {
            const bool hb = it + NGW < NTR; if (hb) { P0_DECODE(it + NGW, tb); p0_tr_load(tb, vb, F.lane); }
            p0_tr_finish(ta, va, scr, F.lane);
            if (!hb) break;
            const bool ha = it + 2 * NGW < NTR; if (ha) { P0_DECODE(it + 2 * NGW, ta); p0_tr_load(ta, va, F.lane); }
            p0_tr_finish(tb, vb, scr, F.lane);
            if (!ha) break;
        }
    }
#undef P0_DECODE
    for (int r = NGW - 1 - gw; r < T_WP; r += NGW) {
        const int gi = r >> 7, rr = r & 127, nblk = rr >> 3, c0 = (rr & 7) * 16, n = 64 * nblk + F.lane; float acc[16];
#pragma unroll
        for (int c = 0; c < 16; ++c) acc[c] = 0.f;
        for (int d0 = 0; d0 < 128; d0 += 16) { float wv[16];
#pragma unroll
            for (int j = 0; j < 16; ++j) wv[j] = pool_scale[gi * 128 + d0 + j] * w_up_pool[(size_t)(gi * 128 + d0 + j) * 1024 + n];
#pragma unroll
            for (int c = 0; c < 16; ++c)
#pragma unroll
                for (int q4 = 0; q4 < 4; ++q4) { const f32x4 pw = *(const f32x4*)(pool_w + (size_t)(gi * 128 + c0 + c) * 128 + d0 + 4 * q4);
                    acc[c] += pw[0] * wv[4 * q4] + pw[1] * wv[4 * q4 + 1] + pw[2] * wv[4 * q4 + 2] + pw[3] * wv[4 * q4 + 3]; } }
        u32x4 o0, o1; o0.x = cvt_pk_bf16(acc[0], acc[1]); o0.y = cvt_pk_bf16(acc[2], acc[3]); o0.z = cvt_pk_bf16(acc[4], acc[5]); o0.w = cvt_pk_bf16(acc[6], acc[7]);
        o1.x = cvt_pk_bf16(acc[8], acc[9]); o1.y = cvt_pk_bf16(acc[10], acc[11]); o1.z = cvt_pk_bf16(acc[12], acc[13]); o1.w = cvt_pk_bf16(acc[14], acc[15]);
        bf16_t* dst = WSP(bf16_t, WS_WPA) + (size_t)n * 1024 + gi * 128 + c0; *(u32x4*)dst = o0; *(u32x4*)(dst + 8) = o1;
    }
}

__device__ __forceinline__ void p1_norm_mod(Frame& F, const Args& AR) {
    const float* x = AR.in[0]; const float* g1n = AR.in[4]; const float* MOD = WSP(float, WS_MOD); bf16_t* H = WSP(bf16_t, WS_H);
    const int gw = F.vcu * NWAVES + F.wave, NGW = F.G * NWAVES;
    for (int q = gw; q < NTOK / 32; q += NGW) {
        const int b = q >> 6; f32x4 Av[4], Bv[4];
#pragma unroll
        for (int j = 0; j < 4; ++j) { const int col = 4 * F.lane + 256 * j; const f32x4 g = *(const f32x4*)(g1n + col), sc = *(const f32x4*)(MOD + b * 6144 + 1024 + col); Av[j] = g * (sc + 1.0f); Bv[j] = *(const f32x4*)(MOD + b * 6144 + col); }
        for (int r = 0; r < 32; ++r) {
            const size_t row = (size_t)q * 32 + r; const f32x4* xr = (const f32x4*)(x + row * 1024) + F.lane; f32x4 v[4]; float s = 0.f;
#pragma unroll
            for (int j = 0; j < 4; ++j) { v[j] = xr[64 * j]; s += (v[j][0] * v[j][0] + v[j][1] * v[j][1]) + (v[j][2] * v[j][2] + v[j][3] * v[j][3]); }
            const float rs = rsqrtf(wave_sum(s) * (1.0f / 1024.0f) + EPS);
            u32x2* o = (u32x2*)(H + row * 1024) + F.lane;
#pragma unroll
            for (int j = 0; j < 4; ++j) { const f32x4 h = v[j] * rs * Av[j] + Bv[j]; u32x2 w; w.x = cvt_pk_bf16(h[0], h[1]); w.y = cvt_pk_bf16(h[2], h[3]); o[64 * j] = w; }
        }
    }
}

__device__ __forceinline__ void p3_pool(Frame& F, int widx, int nw) {
    const bf16_t* U = WSP(bf16_t, WS_U); bf16_t* P = WSP(bf16_t, WS_PA);
    const int gi = F.lane >> 4, w = 2 << gi;
    for (int run = widx; run < NTOK / 8; run += nw) {
        const int t0 = run * 8, tb0 = t0 & 2047; const bf16_t* up = U + (size_t)t0 * 512 + F.lane * 8;
        u32x4 rw[24];
#pragma unroll
        for (int i = 0; i < 24; ++i) { const int d = 16 - i; rw[i] = (tb0 - d >= 0 && d <= w) || d <= 0 ? *(const u32x4*)(up - (ptrdiff_t)d * 512) : (u32x4){0u, 0u, 0u, 0u}; }
        float sum[8];
#pragma unroll
        for (int k = 0; k < 8; ++k) sum[k] = 0.f;
#pragma unroll
        for (int i = 0; i < 16; ++i) { f32x4 a, b; unpack8(rw[i], a, b);
#pragma unroll
            for (int k = 0; k < 4; ++k) { sum[k] += a[k]; sum[4 + k] += b[k]; } }
#pragma unroll
        for (int i = 0; i < 8; ++i) { const int tb = tb0 + i; f32x4 a, b, c, d; unpack8(rw[16 + i], a, b);
            const u32x4 old = w == 2 ? rw[14 + i] : (w == 4 ? rw[12 + i] : (w == 8 ? rw[8 + i] : rw[i])); unpack8(old, c, d);
#pragma unroll
            for (int k = 0; k < 4; ++k) { sum[k] += a[k] - c[k]; sum[4 + k] += b[k] - d[k]; }
            const float inv = 1.0f / (float)((tb + 1) < w ? (tb + 1) : w); f32x4 o0, o1;
#pragma unroll
            for (int k = 0; k < 4; ++k) { o0[k] = sum[k] * inv - a[k]; o1[k] = sum[4 + k] * inv - b[k]; }
            *(u32x4*)(P + (size_t)(t0 + i) * 1024 + F.lane * 8) = pack8(o0, o1); }
    }
}

__device__ __forceinline__ void p3_cmp2(Frame& F, int which, int pm) {
    const bf16_t* H = WSP(bf16_t, WS_HID) + (size_t)which * 8192 * 256; const bf16_t* W2 = WSP(bf16_t, WS_W2C) + (size_t)which * 64 * 256;
    const int l16 = F.lane & 15, kq = F.lane >> 4; const int rbase = pm * 256 + F.wave * 32;
    bf16x8 hf[2][8];
#pragma unroll
    for (int rb = 0; rb < 2; ++rb)
#pragma unroll
        for (int ks = 0; ks < 8; ++ks) hf[rb][ks] = *(const bf16x8*)(H + (size_t)(rbase + rb * 16 + l16) * 256 + 32 * ks + 8 * kq);
#pragma unroll
    for (int cb = 0; cb < 4; ++cb) {
        bf16x8 wf[8];
#pragma unroll
        for (int ks = 0; ks < 8; ++ks) wf[ks] = *(const bf16x8*)(W2 + (size_t)(cb * 16 + l16) * 256 + 32 * ks + 8 * kq);
#pragma unroll
        for (int rb = 0; rb < 2; ++rb) {
            f32x4 acc = (f32x4){0.f, 0.f, 0.f, 0.f};
#pragma unroll
            for (int ks = 0; ks < 8; ++ks) {
                if (which == 0) acc = __builtin_amdgcn_mfma_f32_16x16x32_bf16(wf[ks], hf[rb][ks], acc, 0, 0, 0);
                else acc = __builtin_amdgcn_mfma_f32_16x16x32_bf16(hf[rb][ks], wf[ks], acc, 0, 0, 0); }
            u32x2 w;
            if (which == 0) { const int row = rbase + rb * 16 + l16; const bool pad = (row & 127) == 127; w.x = pad ? 0u : cvt_pk_bf16(acc[0], acc[1]); w.y = pad ? 0u : cvt_pk_bf16(acc[2], acc[3]);
                *(u32x2*)(WSP(bf16_t, WS_KCMP) + (size_t)row * 64 + cb * 16 + 4 * kq) = w; }
            else { const int row0 = rbase + rb * 16 + 4 * kq; const int bg = row0 >> 7, n0 = row0 & 127, d = cb * 16 + l16; if (n0 + 3 == 127) acc[3] = 0.f;
                w.x = cvt_pk_bf16(acc[0], acc[1]); w.y = cvt_pk_bf16(acc[2], acc[3]); *(u32x2*)(WSP(bf16_t, WS_VCMPT) + (((size_t)bg * 2 + (n0 >> 6)) * 64 + d) * 64 + (n0 & 63)) = w; }
        }
    }
}

__device__ __forceinline__ void p3_bgate(Frame& F, int widx, int nw) {
    const bf16_t* H = WSP(bf16_t, WS_H); const bf16_t* W = WSP(bf16_t, WS_WIN) + (size_t)3840 * 1024; bf16_t* BG = WSP(bf16_t, WS_BG);
    LAS unsigned char* wl = F.lds;
    __syncthreads();
    for (int i = F.tid; i < 32 * 128; i += 512) { const int r = i >> 7, c = i & 127; *(LAS u32x4*)(wl + r * 2064 + c * 16) = *(const u32x4*)(W + (size_t)r * 1024 + c * 8); }
    __syncthreads();
    const int l16 = F.lane & 15, kq = F.lane >> 4;
    const LAS unsigned char* wp = wl + l16 * 2064 + 16 * kq;
    for (int grp = widx; grp < NTOK / 16; grp += nw) {
        const bf16_t* hp = H + ((size_t)grp * 16 + l16) * 1024 + 8 * kq;
        f32x4 acc0 = (f32x4){0.f, 0.f, 0.f, 0.f}, acc1 = acc0;
#pragma unroll 1
        for (int kb = 0; kb < 4; ++kb) { bf16x8 hf[8];
#pragma unroll
            for (int j = 0; j < 8; ++j) hf[j] = *(const bf16x8*)(hp + 32 * (8 * kb + j));
#pragma unroll
            for (int j = 0; j < 8; ++j) { const int ks = 8 * kb + j; const bf16x8 w0 = *(const LAS bf16x8*)(wp + 64 * ks), w1 = *(const LAS bf16x8*)(wp + 16 * 2064 + 64 * ks);
                acc0 = __builtin_amdgcn_mfma_f32_16x16x32_bf16(w0, hf[j], acc0, 0, 0, 0); acc1 = __builtin_amdgcn_mfma_f32_16x16x32_bf16(w1, hf[j], acc1, 0, 0, 0); } }
        bf16_t* o = BG + ((size_t)grp * 16 + l16) * 32 + 4 * kq; u32x2 w;
        w.x = cvt_pk_bf16(sigmoidf_(acc0[0]), sigmoidf_(acc0[1])); w.y = cvt_pk_bf16(sigmoidf_(acc0[2]), sigmoidf_(acc0[3])); *(u32x2*)o = w;
        w.x = cvt_pk_bf16(sigmoidf_(acc1[0]), sigmoidf_(acc1[1])); w.y = cvt_pk_bf16(sigmoidf_(acc1[2]), sigmoidf_(acc1[3])); *(u32x2*)(o + 16) = w;
    }
}
namespace nsa {
#ifdef DBG_STAMP
__device__ unsigned long long dbg_cyc[8];
#endif
constexpr int KB0 = 0, VB0 = 8192, PS_OFF = 65536;
__device__ __forceinline__ float pmax32(float m) { auto rr = __builtin_amdgcn_permlane32_swap(__float_as_uint(m), __float_as_uint(m), false, false); return fmaxf(__uint_as_float(rr[0]), __uint_as_float(rr[1])); }
__device__ __forceinline__ float psum32(float m) { auto rr = __builtin_amdgcn_permlane32_swap(__float_as_uint(m), __float_as_uint(m), false, false); return __uint_as_float(rr[0]) + __uint_as_float(rr[1]); }

struct Ptrs { bf16_t* Q; bf16_t* O; const char* WS; const bf16_t* BG; };

__device__ __forceinline__ void attn_unit(LAS unsigned char* lds, const Ptrs& T, const int b, const int g, const int ci, const int nbg, const int nci, int& bslot, const bool pre, const int wid, const int lane) {
    const int r32 = lane & 31, hi = lane >> 5, hh = wid >> 1, qh = wid & 1;
    const int qloc = 32 * qh + r32, t = 64 * ci + qloc, bg = b * 2 + g;
    const size_t row = (size_t)b * SEQ + t;
    const int sR = 8 * wid + (lane >> 3), sch = (lane & 7) ^ ((sR >> 1) & 7);
    const int sK = (sR & ~12) | ((sR & 4) << 1) | ((sR & 8) >> 1);
    const unsigned kst = (unsigned)(sK * 128 + sch * 16);
    const unsigned vst = (unsigned)(sR * 128 + sch * 16);
    const int xr = (r32 >> 1) & 7;
    unsigned kofs[4], vofs[4];
#pragma unroll
    for (int s = 0; s < 4; ++s) kofs[s] = (unsigned)(r32 * 128 + (((2 * s + hi) ^ xr) << 4));
#pragma unroll
    for (int c = 0; c < 4; ++c) vofs[c] = (unsigned)(r32 * 128 + (((2 * c + hi) ^ xr) << 4));
    bf16_t* qp = T.Q + row * 512 + (g * 4 + hh) * 64; bf16_t* op = T.O + row * 1024 + 512 + (g * 4 + hh) * 64;
    bf16x8 qr[4];
#pragma unroll
    for (int s = 0; s < 4; ++s) qr[s] = *(const bf16x8*)(qp + 16 * s + 8 * hi);
    const bf16_t* bgp = T.BG + row * 32 + g * 4 + hh;
    const float gate_c = bf1(bgp[0]), gate_s = bf1(bgp[8]), gate_w = bf1(bgp[16]);

    const int ntc = ci >= 16 ? 2 : 1, nsel = ci + 1, nwin = (ci < 8 ? ci : 8) + 1, nsteps = ntc + nsel + nwin;
#define NSA_ISSUE_U(bg_, ci_, ntc_, nsel_, st_, bufsel_) do { const int s_ = (st_); unsigned uk_, uv_;        \
        if (s_ < (ntc_)) { uk_ = (unsigned)WS_KCMP + (unsigned)(bg_) * 16384u + (unsigned)s_ * 8192u; uv_ = (unsigned)WS_VCMPT + (unsigned)(bg_) * 16384u + (unsigned)s_ * 8192u; } \
        else if (s_ < (ntc_) + (nsel_)) { const unsigned o_ = (unsigned)(bg_) * 262144u + (unsigned)(s_ - (ntc_)) * 8192u; uk_ = (unsigned)WS_KS + o_; uv_ = (unsigned)WS_VST + o_; } \
        else { const unsigned o_ = (unsigned)(bg_) * 262144u + (unsigned)((ci_) - (s_ - (ntc_) - (nsel_))) * 8192u; uk_ = (unsigned)WS_KW + o_; uv_ = (unsigned)WS_VWT + o_; } \
        const int kb_ = KB0 + (bufsel_) * 16384, vb_ = VB0 + (bufsel_) * 16384; \
        __builtin_amdgcn_global_load_lds((const unsigned*)(T.WS + (uk_ + kst)), (LAS unsigned*)(lds + kb_ + wid * 1024), 16, 0, 0); \
        __builtin_amdgcn_global_load_lds((const unsigned*)(T.WS + (uv_ + vst)), (LAS unsigned*)(lds + vb_ + wid * 1024), 16, 0, 0); } while (0)
#define NSA_ISSUE(st_, bufsel_) NSA_ISSUE_U(bg, ci, ntc, nsel, st_, bufsel_)

#ifdef DBG_STAMP
    unsigned long long dbg_wait_vm = 0, dbg_wait_bar = 0, dbg_s1 = 0, dbg_s2 = 0; const unsigned long long dbg_t0 = __builtin_readcyclecounter();
#endif
    float m_ref = 0.f, l_run = 0.f;
    bool first = true;
    f32x16 o0 = {}, o1 = {}, A0 = {}, A1 = {};
    unsigned selmask = 0xffffffffu; float sh0 = 1.f, sh1 = 1.f, sh2 = 1.f, sh3 = 1.f;
    bf16x8 pq0 = {}, pq1 = {};
    int vpend = VB0;
    int cpend = 0;
#define NSA_PVLOAD(v00_, v01_, v10_, v11_) do { \
        v00_ = *(const LAS bf16x8*)(lds + vpend + (cpend ? vofs[2] : vofs[0])); v01_ = *(const LAS bf16x8*)(lds + vpend + (cpend ? vofs[3] : vofs[1])); \
        v10_ = *(const LAS bf16x8*)(lds + vpend + 4096 + (cpend ? vofs[2] : vofs[0])); v11_ = *(const LAS bf16x8*)(lds + vpend + 4096 + (cpend ? vofs[3] : vofs[1])); } while (0)
#define NSA_PVMMA(v00_, v01_, v10_, v11_) do { \
        o0 = __builtin_amdgcn_mfma_f32_32x32x16_bf16(v00_, pq0, o0, 0, 0, 0); o1 = __builtin_amdgcn_mfma_f32_32x32x16_bf16(v10_, pq0, o1, 0, 0, 0); \
        o0 = __builtin_amdgcn_mfma_f32_32x32x16_bf16(v01_, pq1, o0, 0, 0, 0); o1 = __builtin_amdgcn_mfma_f32_32x32x16_bf16(v11_, pq1, o1, 0, 0, 0); } while (0)

    int bcur = bslot;
    if (!pre) { NSA_ISSUE(0, bcur); if (nsteps > 1) NSA_ISSUE(1, (bcur + 1) & 3); }
    for (int st = 0; st < nsteps; ++st) {
#ifdef DBG_STAMP
        const unsigned long long tw0_ = __builtin_readcyclecounter();
#endif
        if (st + 1 < nsteps) asm volatile("s_waitcnt vmcnt(2)" ::: "memory"); else asm volatile("s_waitcnt vmcnt(0)" ::: "memory");
#ifdef DBG_STAMP
        const unsigned long long tw1_ = __builtin_readcyclecounter();
#endif
        __builtin_amdgcn_s_barrier(); asm volatile("" ::: "memory");
#ifdef DBG_STAMP
        { const unsigned long long tw2_ = __builtin_readcyclecounter(); dbg_wait_vm += tw1_ - tw0_; dbg_wait_bar += tw2_ - tw1_; }
#endif
        { const int bn = (bcur + 2) & 3; if (st + 2 < nsteps) NSA_ISSUE(st + 2, bn); }
        if (st == nsteps - 1 && nbg >= 0) {
            const int nntc = nci >= 16 ? 2 : 1, nnsel = nci + 1;
            NSA_ISSUE_U(nbg, nci, nntc, nnsel, 0, (bcur + 1) & 3); NSA_ISSUE_U(nbg, nci, nntc, nnsel, 1, (bcur + 2) & 3); }
#ifdef DBG_STAMP
        const unsigned long long ts_a = __builtin_readcyclecounter();
#endif
        const int kb = KB0 + bcur * 16384, vb = VB0 + bcur * 16384;
        if (st == ntc && ci >= 8) {
            float v[32];
#pragma unroll
            for (int j = 0; j < 32; ++j) v[j] = 0.f;
#pragma unroll
            for (int h4 = 0; h4 < 4; ++h4) { const LAS float* ps = (const LAS float*)(lds + PS_OFF) + (h4 * 64 + qloc) * 68; const f32x4 S = *(const LAS f32x4*)((const LAS float*)(lds + PS_OFF + 69632) + (h4 * 64 + qloc) * 4);
#pragma unroll
                for (int j4 = 0; j4 < 8; ++j4) { const f32x4 mn = *(const LAS f32x4*)(ps + 4 * j4), cr = *(const LAS f32x4*)(ps + 32 + 4 * j4);
#pragma unroll
                    for (int i = 0; i < 4; ++i) { const int j = 4 * j4 + i; v[j] += mn[i] * S[j >> 3] + cr[i] * S[j > 0 ? (j - 1) >> 3 : 0]; } } }
            selmask = 1u | (1u << ci) | (1u << (ci - 1));
#pragma unroll 1
            for (int it = 0; it < 5; ++it) { float bv = -1.f; int best = 0;
#pragma unroll
                for (int j = 1; j < 30; ++j) { const bool cand = (j <= ci - 2) && !((selmask >> j) & 1u) && (v[j] > bv); bv = cand ? v[j] : bv; best = cand ? j : best; }
                selmask |= 1u << best; }
        }
        int lo, hi_; bool full; bool live = true;
        if (st < ntc) { lo = 0; hi_ = ((t - 31) >> 4) - 64 * st; full = (64 * ci - 31) >= 16 * (64 * st + 63); }
        else if (st < ntc + nsel) { const int j = st - ntc; lo = 0; hi_ = t - 64 * j; full = j < ci; live = ((selmask >> j) & 1u) != 0u; }
        else { const int j = ci - (st - ntc - nsel); lo = t - 511 - 64 * j; hi_ = t - 64 * j; full = (j < ci) && (j > ci - 8); }
        int span = hi_ - lo; int koff = 8 * hi - lo; if (span < 0) { koff = -100000; span = 0; }
        const bool end_c = (st == ntc - 1), end_s = (st == ntc + nsel - 1), end_w = (st == nsteps - 1);
#ifdef DBG_STAMP
        const unsigned long long ts_b = __builtin_readcyclecounter();
#endif
#pragma unroll
        for (int kh = 0; kh < 2; ++kh) {
            bf16x8 kf0, kf1, kf2, kf3, v00, v01, v10, v11;
            kf0 = *(const LAS bf16x8*)(lds + kb + 4096 * kh + kofs[0]); kf1 = *(const LAS bf16x8*)(lds + kb + 4096 * kh + kofs[1]);
            kf2 = *(const LAS bf16x8*)(lds + kb + 4096 * kh + kofs[2]); kf3 = *(const LAS bf16x8*)(lds + kb + 4096 * kh + kofs[3]);
            NSA_PVLOAD(v00, v01, v10, v11);
            const float cval = live ? -m_ref : NEGBIG;
            f32x16 p;
#pragma unroll
            for (int r = 0; r < 16; ++r) p[r] = cval;
            __builtin_amdgcn_sched_barrier(0);
            p = __builtin_amdgcn_mfma_f32_32x32x16_bf16(kf0, qr[0], p, 0, 0, 0); p = __builtin_amdgcn_mfma_f32_32x32x16_bf16(kf1, qr[1], p, 0, 0, 0);
            p = __builtin_amdgcn_mfma_f32_32x32x16_bf16(kf2, qr[2], p, 0, 0, 0); p = __builtin_amdgcn_mfma_f32_32x32x16_bf16(kf3, qr[3], p, 0, 0, 0);
            NSA_PVMMA(v00, v01, v10, v11);
            if (!full) {
#pragma unroll
                for (int r = 0; r < 16; ++r) { const int c = 32 * kh + 16 * (r >> 3) + (r & 7); p[r] = ((unsigned)(koff + c) <= (unsigned)span) ? p[r] : NEGBIG; }
            }
            float mx;
            { float a = fmaxf(fmaxf(p[0], p[1]), p[2]), bq = fmaxf(fmaxf(p[3], p[4]), p[5]); a = fmaxf(fmaxf(a, p[6]), p[7]); bq = fmaxf(fmaxf(bq, p[8]), p[9]);
              a = fmaxf(fmaxf(a, p[10]), p[11]); bq = fmaxf(fmaxf(bq, p[12]), p[13]); a = fmaxf(fmaxf(a, p[14]), p[15]); mx = pmax32(fmaxf(a, bq)); }
            if (first || __builtin_amdgcn_ballot_w64(mx > 8.0f) != 0ull) {
                const float dl = first ? mx : fmaxf(mx, 0.f);
                m_ref += dl;
#pragma unroll
                for (int r = 0; r < 16; ++r) p[r] -= dl;
                if (!first) { const float f = fast_exp2(-dl); l_run *= f;
#pragma unroll
                    for (int r = 0; r < 16; ++r) { o0[r] *= f; o1[r] *= f; }
                    if (st < ntc) { sh0 *= f; sh1 *= f; sh2 *= f; sh3 *= f; } }
                first = false;
            }
            float ls = 0.f;
#pragma unroll
            for (int r = 0; r < 16; ++r) { p[r] = fast_exp2(p[r]); ls += p[r]; }
            l_run += ls;
            { u32x4 w0, w1;
              w0.x = cvt_pk_bf16(p[0], p[1]); w0.y = cvt_pk_bf16(p[2], p[3]); w0.z = cvt_pk_bf16(p[4], p[5]); w0.w = cvt_pk_bf16(p[6], p[7]);
              w1.x = cvt_pk_bf16(p[8], p[9]); w1.y = cvt_pk_bf16(p[10], p[11]); w1.z = cvt_pk_bf16(p[12], p[13]); w1.w = cvt_pk_bf16(p[14], p[15]);
              pq0 = __builtin_bit_cast(bf16x8, w0); pq1 = __builtin_bit_cast(bf16x8, w1); }
            vpend = vb; cpend = 2 * kh;
            if (st < ntc && ci >= 8) {
                LAS float* psw = (LAS float*)(lds + PS_OFF) + (hh * 64 + qloc) * 68 + 16 * st + 8 * kh + 2 * hi;
#pragma unroll
                for (int a2 = 0; a2 < 2; ++a2)
#pragma unroll
                    for (int jj = 0; jj < 2; ++jj) { const int r0 = 8 * a2 + 4 * jj;
                        psw[4 * a2 + jj] = p[r0] + p[r0 + 1] + p[r0 + 2] + 0.5f * p[r0 + 3];
                        if (16 * st + 8 * kh + 4 * a2 + 2 * hi + jj + 1 < 32) psw[32 + 4 * a2 + jj + 1] = 0.5f * p[r0 + 3]; }
                if (st == 0 && kh == 0 && hi == 0) psw[32] = 0.f;
                if (st == 0) { if (kh == 0) sh0 = 1.f; else sh1 = 1.f; } else { if (kh == 0) sh2 = 1.f; else sh3 = 1.f; }
            }
        }
#ifdef DBG_STAMP
        const unsigned long long ts_c = __builtin_readcyclecounter(); dbg_s1 += ts_b - ts_a; dbg_s2 += ts_c - ts_b;
#endif
        if (end_c || end_s || end_w) {
            { bf16x8 v00, v01, v10, v11; NSA_PVLOAD(v00, v01, v10, v11); NSA_PVMMA(v00, v01, v10, v11); pq0 = bf16x8{}; pq1 = bf16x8{}; }
            const float ltot = psum32(l_run); float gate = end_c ? gate_c : (end_s ? gate_s : gate_w);
#if defined(DBG_CHECK) && (DBG_CHECK == 15 || DBG_CHECK == 16 || DBG_CHECK == 17)
            if ((DBG_CHECK == 15 && !end_c) || (DBG_CHECK == 16 && !end_s) || (DBG_CHECK == 17 && !end_w)) gate = 0.f;
#endif
            const float rl = (m_ref > -1e29f) ? fast_rcp(ltot) : 0.f; const float sc = gate * rl;
#pragma unroll
            for (int r = 0; r < 16; ++r) { A0[r] += o0[r] * sc; A1[r] += o1[r] * sc; o0[r] = 0.f; o1[r] = 0.f; }
            if (end_c && ci >= 8 && hi == 0) { LAS float* pst = (LAS float*)(lds + PS_OFF + 69632) + (hh * 64 + qloc) * 4; *(LAS f32x4*)pst = (f32x4){rl * sh0, rl * sh1, rl * sh2, rl * sh3}; }
            m_ref = 0.f; l_run = 0.f; first = true;
        }
        bcur = (bcur + 1) & 3;
    }
#undef NSA_ISSUE
#undef NSA_ISSUE_U
#undef NSA_PVLOAD
#undef NSA_PVMMA
#pragma unroll
    for (int a = 0; a < 4; ++a) { u32x2 w0, w1; w0.x = cvt_pk_bf16(A0[4 * a], A0[4 * a + 1]); w0.y = cvt_pk_bf16(A0[4 * a + 2], A0[4 * a + 3]); w1.x = cvt_pk_bf16(A1[4 * a], A1[4 * a + 1]); w1.y = cvt_pk_bf16(A1[4 * a + 2], A1[4 * a + 3]);
        *(u32x2*)(op + 8 * a + 4 * hi) = w0; *(u32x2*)(op + 32 + 8 * a + 4 * hi) = w1; }
    bslot = bcur;
    __builtin_amdgcn_s_barrier(); asm volatile("" ::: "memory");
#ifdef DBG_STAMP
    if (blockIdx.x == 0 && threadIdx.x == 0) { dbg_cyc[0] += dbg_wait_vm; dbg_cyc[1] += dbg_wait_bar; dbg_cyc[3] += dbg_s1; dbg_cyc[4] += dbg_s2; dbg_cyc[2] += __builtin_readcyclecounter() - dbg_t0; }
#endif
}
}
__device__ __forceinline__ float dpp_sum16(float v) {
    v += __uint_as_float(__builtin_amdgcn_update_dpp(0, __float_as_uint(v), 0xB1, 0xF, 0xF, true));
    v += __uint_as_float(__builtin_amdgcn_update_dpp(0, __float_as_uint(v), 0x4E, 0xF, 0xF, true));
    v += __uint_as_float(__builtin_amdgcn_update_dpp(0, __float_as_uint(v), 0x141, 0xF, 0xF, true));
    v += __uint_as_float(__builtin_amdgcn_update_dpp(0, __float_as_uint(v), 0x140, 0xF, 0xF, true));
    return v;
}
__device__ __forceinline__ void p7_router(Frame& F, const Args& AR) {
    const float* X1 = AR.in[0]; const bf16_t* DL = WSP(bf16_t, WS_PA); const float* g2n = AR.in[15]; const float* rgw = AR.in[16]; const float* rgb = AR.in[17]; const float* rew = AR.in[18]; const float* reb = AR.in[19];
    const float* MOD = WSP(float, WS_MOD); bf16_t* H2 = WSP(bf16_t, WS_H2); float* SLOTW = WSP(float, WS_SLOTW); unsigned* LIST = WSP(unsigned, WS_LIST);
    unsigned* gcnt = WSP(unsigned, WS_CTL) + CW_CNT;
    LAS float* Wl = (LAS float*)F.lds; LAS unsigned* lcnt = (LAS unsigned*)(F.lds + RT_OFF); LAS unsigned* lbase = lcnt + 32; LAS unsigned* tinfo = lcnt + 64;
    for (int k = F.tid; k < 1024; k += 512) {
        const f32x4 gq = *(const f32x4*)(rgw + 4 * k); Wl[k] = gq[0]; Wl[1024 + k] = gq[1]; Wl[2048 + k] = gq[2]; Wl[3072 + k] = gq[3];
#pragma unroll
        for (int j4 = 0; j4 < 8; ++j4) { const f32x4 e = *(const f32x4*)(rew + 32 * k + 4 * j4); Wl[(4 + 4 * j4) * 1024 + k] = e[0]; Wl[(5 + 4 * j4) * 1024 + k] = e[1]; Wl[(6 + 4 * j4) * 1024 + k] = e[2]; Wl[(7 + 4 * j4) * 1024 + k] = e[3]; } }
    __syncthreads();
    for (int tg = F.vcu; tg < NTOK / 256; tg += F.G) {
        if (F.tid < 32) lcnt[F.tid] = 0u;
        __syncthreads();
        const int b = (tg * 256) >> 11; f32x4 Av[4], Bv[4];
#pragma unroll
        for (int j = 0; j < 4; ++j) { const int col = 4 * F.lane + 256 * j; const f32x4 g = *(const f32x4*)(g2n + col), sc = *(const f32x4*)(MOD + b * 6144 + 4096 + col); Av[j] = g * (sc + 1.0f); Bv[j] = *(const f32x4*)(MOD + b * 6144 + 3072 + col); }
        f32x4 na[4], nb[4]; u32x2 da[4], db[4];
        { const size_t r0 = (size_t)tg * 256 + F.wave * 32; const f32x4* xa = (const f32x4*)(X1 + r0 * 1024) + F.lane; const u32x2* dp = (const u32x2*)(DL + r0 * 1024) + F.lane;
#pragma unroll
          for (int j = 0; j < 4; ++j) { na[j] = xa[64 * j]; nb[j] = xa[256 + 64 * j]; da[j] = dp[64 * j]; db[j] = dp[256 + 64 * j]; } }
        for (int pr = 0; pr < 16; ++pr) {
            const int lt = F.wave * 32 + 2 * pr; const size_t row = (size_t)tg * 256 + lt;
            f32x4 ha[4], hb[4]; float sa = 0.f, sb = 0.f;
#pragma unroll
            for (int j = 0; j < 4; ++j) { ha[j] = na[j] + (f32x4){bf_lo(da[j].x), bf_hi(da[j].x), bf_lo(da[j].y), bf_hi(da[j].y)}; hb[j] = nb[j] + (f32x4){bf_lo(db[j].x), bf_hi(db[j].x), bf_lo(db[j].y), bf_hi(db[j].y)}; }
            if (pr < 15) { const f32x4* xa = (const f32x4*)(X1 + (row + 2) * 1024) + F.lane; const u32x2* dp = (const u32x2*)(DL + (row + 2) * 1024) + F.lane;
#pragma unroll
                for (int j = 0; j < 4; ++j) { na[j] = xa[64 * j]; nb[j] = xa[256 + 64 * j]; da[j] = dp[64 * j]; db[j] = dp[256 + 64 * j]; } }
#pragma unroll
            for (int j = 0; j < 4; ++j) { sa += (ha[j][0] * ha[j][0] + ha[j][1] * ha[j][1]) + (ha[j][2] * ha[j][2] + ha[j][3] * ha[j][3]); sb += (hb[j][0] * hb[j][0] + hb[j][1] * hb[j][1]) + (hb[j][2] * hb[j][2] + hb[j][3] * hb[j][3]); }
            const float ra = rsqrtf(wave_sum(sa) * (1.0f / 1024.0f) + EPS), rb = rsqrtf(wave_sum(sb) * (1.0f / 1024.0f) + EPS);
            u32x2* oa = (u32x2*)(H2 + row * 1024) + F.lane; u32x2* ob = oa + 256;
#pragma unroll
            for (int j = 0; j < 4; ++j) { ha[j] = ha[j] * ra * Av[j] + Bv[j]; hb[j] = hb[j] * rb * Av[j] + Bv[j];
                u32x2 w; w.x = cvt_pk_bf16(ha[j][0], ha[j][1]); w.y = cvt_pk_bf16(ha[j][2], ha[j][3]); oa[64 * j] = w; w.x = cvt_pk_bf16(hb[j][0], hb[j][1]); w.y = cvt_pk_bf16(hb[j][2], hb[j][3]); ob[64 * j] = w; }
#define RT_DOT2(rowa, rowb, outv) do { float pa_ = 0.f, pb_ = 0.f; const LAS float* wra_ = Wl + (rowa) * 1024 + 4 * F.lane; const LAS float* wrb_ = Wl + (rowb) * 1024 + 4 * F.lane; \
                _Pragma("unroll") for (int jq_ = 0; jq_ < 4; ++jq_) { const f32x4 wa_ = *(const LAS f32x4*)(wra_ + 256 * jq_); const f32x4 wb_ = *(const LAS f32x4*)(wrb_ + 256 * jq_); \
                    pa_ += (ha[jq_][0] * wa_[0] + ha[jq_][1] * wa_[1]) + (ha[jq_][2] * wa_[2] + ha[jq_][3] * wa_[3]); pb_ += (hb[jq_][0] * wb_[0] + hb[jq_][1] * wb_[1]) + (hb[jq_][2] * wb_[2] + hb[jq_][3] * wb_[3]); } \
                auto rr_ = __builtin_amdgcn_permlane32_swap(__float_as_uint(pa_), __float_as_uint(pb_), false, false); \
                float v_ = __uint_as_float(rr_[0]) + __uint_as_float(rr_[1]); v_ = dpp_sum16(v_); v_ += __shfl_xor(v_, 16); (outv) = v_; } while (0)
            float g0, g1, g2, g3;
            RT_DOT2(0, 0, g0); RT_DOT2(1, 1, g1); RT_DOT2(2, 2, g2); RT_DOT2(3, 3, g3);
            g0 += rgb[0]; g1 += rgb[1]; g2 += rgb[2]; g3 += rgb[3];
            int gidx = 0; float gm = g0; if (g1 > gm) { gm = g1; gidx = 1; } if (g2 > gm) { gm = g2; gidx = 2; } if (g3 > gm) { gm = g3; gidx = 3; }
            const float gp = 1.0f / (__expf(g0 - gm) + __expf(g1 - gm) + __expf(g2 - gm) + __expf(g3 - gm));
            const int ga = __builtin_amdgcn_readlane(gidx, 0), gb = __builtin_amdgcn_readlane(gidx, 32);
            float le[8];
#pragma unroll
            for (int j = 0; j < 8; ++j) { RT_DOT2(4 + ga * 8 + j, 4 + gb * 8 + j, le[j]); le[j] += reb[gidx * 8 + j]; }
#undef RT_DOT2
            int i0 = 0; float v0 = le[0];
#pragma unroll
            for (int j = 1; j < 8; ++j) if (le[j] > v0) { v0 = le[j]; i0 = j; }
            int i1 = -1; float v1 = -INFINITY;
#pragma unroll
            for (int j = 0; j < 8; ++j) if (j != i0 && le[j] > v1) { v1 = le[j]; i1 = j; }
            const float ex = __expf(v1 - v0); const float w0 = gp / (1.0f + ex), w1 = gp * ex / (1.0f + ex);
            if ((F.lane & 31) == 0) {
                const int tl = lt + (F.lane >> 5); const size_t tok = (size_t)tg * 256 + tl; const int e0 = gidx * 8 + i0, e1 = gidx * 8 + i1;
                const unsigned p0 = __hip_atomic_fetch_add(lcnt + e0, 1u, __ATOMIC_RELAXED, __HIP_MEMORY_SCOPE_WORKGROUP), p1 = __hip_atomic_fetch_add(lcnt + e1, 1u, __ATOMIC_RELAXED, __HIP_MEMORY_SCOPE_WORKGROUP);
                tinfo[2 * tl] = ((unsigned)e0 << 16) | p0; tinfo[2 * tl + 1] = ((unsigned)e1 << 16) | p1;
                SLOTW[2 * tok] = w0; SLOTW[2 * tok + 1] = w1;
            }
        }
        __syncthreads();
        if (F.tid < 32) lbase[F.tid] = __hip_atomic_fetch_add(gcnt + 64 * F.tid, lcnt[F.tid], __ATOMIC_RELAXED, __HIP_MEMORY_SCOPE_AGENT);
        __syncthreads();
        { const unsigned inf = tinfo[F.tid]; const unsigned e = inf >> 16, p = inf & 0xffffu; LIST[(size_t)e * 65536 + lbase[e] + p] = (unsigned)(tg * 256) * 2u + (unsigned)F.tid; }
        __syncthreads();
    }
}
__device__ __forceinline__ void moe_tables(Frame& F, LAS unsigned* tcnt, LAS unsigned* tbase) {
    const unsigned* gcnt = WSP(unsigned, WS_CTL) + CW_CNT;
    if (F.tid < 32) tcnt[F.tid] = __hip_atomic_load(gcnt + 64 * F.tid, __ATOMIC_RELAXED, __HIP_MEMORY_SCOPE_AGENT);
    __syncthreads();
    if (F.tid == 0) { unsigned s = 0; for (int e = 0; e < 32; ++e) { tbase[e] = s; s += (tcnt[e] + 255u) >> 8; } tbase[32] = s; }
    __syncthreads();
    if (F.tid < 32) {
        const long L = (long)F.tid * F.G + (long)F.vcu; const int total = (int)tbase[32] * 4; unsigned w = 0xffffffffu;
        if (L < total) { const int pn = (int)L & 3, tau = (int)L >> 2; int e = 0; for (int j = 1; j < 32; ++j) if ((int)tbase[j] <= tau) e = j; w = ((unsigned)e << 16) | ((unsigned)(tau - (int)tbase[e]) << 2) | (unsigned)pn; }
        tbase[40 + F.tid] = w; }
    __syncthreads();
}

__device__ __forceinline__ void p10_final(Frame& F, const Args& AR) {
    const float* X = AR.in[0]; const bf16_t* DL = WSP(bf16_t, WS_PA); float* OUT = F.out; const float* fg = AR.in[23]; const float* MOD = WSP(float, WS_MOD); const bf16_t* Y = WSP(bf16_t, WS_Y);
    const int gw = F.vcu * NWAVES + F.wave, NGW = F.G * NWAVES;
    for (int q = gw; q < NTOK / 32; q += NGW) {
        const int b = q >> 6; f32x4 Gv[4], Fv[4];
#pragma unroll
        for (int j = 0; j < 4; ++j) { const int col = 4 * F.lane + 256 * j; Gv[j] = *(const f32x4*)(MOD + b * 6144 + 5120 + col); Fv[j] = *(const f32x4*)(fg + col); }
        for (int r = 0; r < 32; ++r) {
            const size_t row = (size_t)q * 32 + r; const f32x4* xr = (const f32x4*)(X + row * 1024) + F.lane; const u32x2* dr = (const u32x2*)(DL + row * 1024) + F.lane; f32x4* orow = (f32x4*)(OUT + row * 1024) + F.lane;
            const u32x2* y0 = (const u32x2*)(Y + (2 * row) * 1024) + F.lane; const u32x2* y1 = y0 + 256;
            f32x4 v[4]; float s = 0.f;
#pragma unroll
            for (int j = 0; j < 4; ++j) { const u32x2 a = y0[64 * j], c = y1[64 * j]; const f32x4 ys = (f32x4){bf_lo(a.x) + bf_lo(c.x), bf_hi(a.x) + bf_hi(c.x), bf_lo(a.y) + bf_lo(c.y), bf_hi(a.y) + bf_hi(c.y)};
                const u32x2 dd = dr[64 * j]; v[j] = xr[64 * j] + (f32x4){bf_lo(dd.x), bf_hi(dd.x), bf_lo(dd.y), bf_hi(dd.y)} + Gv[j] * ys * DBG_MOE_SCALE; s += (v[j][0] * v[j][0] + v[j][1] * v[j][1]) + (v[j][2] * v[j][2] + v[j][3] * v[j][3]); }
            const float rs = rsqrtf(wave_sum(s) * (1.0f / 1024.0f) + EPS);
#pragma unroll
            for (int j = 0; j < 4; ++j) orow[64 * j] = v[j] * rs * Fv[j];
        }
    }
}
#ifdef DBG_CHECK
#ifndef DBG_SALT
#define DBG_SALT 0
#endif
__device__ __forceinline__ float blk_sum(Frame& F, float v, LAS float* red) {
    v = wave_sum(v); __syncthreads(); if (F.lane == 0) red[F.wave] = v; __syncthreads(); float s = 0.f;
#pragma unroll
    for (int w = 0; w < 8; ++w) s += red[w]; __syncthreads(); return s;
}
__device__ __forceinline__ float dbg_sig(float x) { return 1.0f / (1.0f + __expf(-x)); }
__device__ __forceinline__ void dbg_check(Frame& F, const Args& AR, float& num, float& den) {
    LAS float* red = (LAS float*)(F.lds + 150000 - 64);
    LAS float* sh = (LAS float*)F.lds;
    const int t = (F.vcu * 257 + 31 * DBG_SALT + 5) & 65535; const int b = t >> 11, tb = t & 2047;
    const float* MOD = WSP(float, WS_MOD);
    num = 0.f; den = 0.f;
#if DBG_CHECK == 1
    { const int bb = F.vcu & 31; for (int n = F.tid; n < 6144; n += 512) { float s = AR.in[3][n]; for (int k = 0; k < 1024; ++k) s += AR.in[1][bb * 1024 + k] * AR.in[2][(size_t)k * 6144 + n];
        const float f = MOD[bb * 6144 + n]; num += (f - s) * (f - s); den += s * s; } }
#elif DBG_CHECK == 2
    { float ss = 0.f; for (int k = F.tid; k < 1024; k += 512) { const float v = AR.in[0][(size_t)t * 1024 + k]; ss += v * v; } ss = blk_sum(F, ss, red); const float r = rsqrtf(ss / 1024.f + EPS);
      for (int k = F.tid; k < 1024; k += 512) { const float ref = AR.in[0][(size_t)t * 1024 + k] * r * AR.in[4][k] * (1.f + MOD[b * 6144 + 1024 + k]) + MOD[b * 6144 + k]; const float f = bf1(WSP(bf16_t, WS_H)[(size_t)t * 1024 + k]);
        num += (f - ref) * (f - ref); den += ref * ref; } }
#elif DBG_CHECK >= 30 && DBG_CHECK < 40
    { for (int k = F.tid; k < 1024; k += 512) sh[k] = bf1(WSP(bf16_t, WS_H)[(size_t)t * 1024 + k]); __syncthreads();
      for (int n = F.tid; n < 3864; n += 512) { float s = 0.f; for (int k = 0; k < 1024; ++k) s += sh[k] * AR.in[5][(size_t)k * 3864 + n];
        float f = 0.f; bool use = false; float ref = s;
        if (n < 512) { use = DBG_CHECK == 30; f = bf1(WSP(bf16_t, WS_U)[(size_t)t * 512 + n]); }
        else if (n < 1024) { use = DBG_CHECK == 31; f = bf1(WSP(bf16_t, WS_Q)[(size_t)t * 512 + n - 512]); ref = s * QSCALE; }
        else if (n < 1792) { const int seg = (n - 1024) >> 7, cc = (n - 1024) & 127, g = cc >> 6, d = cc & 63; const size_t kidx = ((size_t)(b * 2 + g) * 2048 + tb) * 64 + d, vidx = (((size_t)(b * 2 + g) * 32 + (tb >> 6)) * 64 + d) * 64 + (tb & 63);
            if (seg == 0) { use = DBG_CHECK == 32; f = bf1(WSP(bf16_t, WS_KC)[kidx]); } else if (seg == 1) { use = DBG_CHECK == 32; f = bf1(WSP(bf16_t, WS_VC)[kidx]); }
            else if (seg == 2) { use = DBG_CHECK == 33; f = bf1(WSP(bf16_t, WS_KS)[kidx]); } else if (seg == 3) { use = DBG_CHECK == 33; f = bf1(WSP(bf16_t, WS_VST)[vidx]); }
            else if (seg == 4) { use = DBG_CHECK == 34; f = bf1(WSP(bf16_t, WS_KW)[kidx]); } else { use = DBG_CHECK == 34; f = bf1(WSP(bf16_t, WS_VWT)[vidx]); } }
        else if (DBG_CHECK == 37) { use = n < 3840; f = bf1(WSP(bf16_t, WS_MG)[(size_t)t * 2048 + (n < 3840 ? n - 1792 : 0)]); ref = dbg_sig(s); }
        else if (n < 1816) { use = DBG_CHECK == 36; f = bf1(WSP(bf16_t, WS_BG)[(size_t)t * 32 + n - 1792]); ref = dbg_sig(s); }
        else if (DBG_CHECK == 39) { use = true; f = bf1(WSP(bf16_t, WS_MG)[(size_t)t * 2048 + n - 1816]); ref = s; }
        else { use = DBG_CHECK == 35 || (DBG_CHECK == 38 && ((n - 1816) >> 8) == DBG_SALT); f = bf1(WSP(bf16_t, WS_MG)[(size_t)t * 2048 + n - 1816]); ref = dbg_sig(s); }
        if (use) { num += (f - ref) * (f - ref); den += ref * ref; } } }
#elif DBG_CHECK == 40
    { for (int i = 0; i < 16; ++i) { const int nd = (F.vcu * 16 + i + 256 * DBG_SALT) & 4095; int src = -1; if (nd < 1792) src = nd; else if (nd < 3840) src = nd + 24; else if (nd < 3864) src = nd - 3840 + 1792;
        for (int k = F.tid; k < 1024; k += 512) { const float ref = src >= 0 ? AR.in[5][(size_t)k * 3864 + src] : 0.f; const float f = bf1(WSP(bf16_t, WS_WIN)[(size_t)nd * 1024 + k]); num += (f - ref) * (f - ref); den += ref * ref; } } }
#elif DBG_CHECK == 4
    { const bf16_t* U = WSP(bf16_t, WS_U); for (int c = F.tid; c < 512; c += 512) { const int w = 2 << (c >> 7); float s = 0.f; int cnt = 0; for (int d = 0; d < w; ++d) if (tb - d >= 0) { s += bf1(U[(size_t)(t - d) * 512 + c]); ++cnt; }
        const float ref = s / (float)cnt - bf1(U[(size_t)t * 512 + c]); const float f = bf1(WSP(bf16_t, WS_PA)[(size_t)t * 1024 + c]); num += (f - ref) * (f - ref); den += ref * ref; } }
#elif DBG_CHECK == 5
    { const bf16_t* PA = WSP(bf16_t, WS_PA); { const int o = F.tid, gi = o >> 7, d = o & 127; float s = 0.f; for (int c = 0; c < 128; ++c) s += bf1(PA[(size_t)t * 1024 + gi * 128 + c]) * AR.in[6][(size_t)(gi * 128 + c) * 128 + d]; sh[o] = s * AR.in[7][o]; } __syncthreads();
      for (int n = F.tid; n < 1024; n += 512) { float s = 0.f; for (int k = 0; k < 512; ++k) s += sh[k] * AR.in[12][(size_t)k * 1024 + n]; float s2 = 0.f; for (int k = 0; k < 512; ++k) s2 += bf1(PA[(size_t)t * 1024 + 512 + k]) * AR.in[13][(size_t)k * 1024 + n];
        const float gb = bf1(WSP(bf16_t, WS_MG)[(size_t)t * 2048 + 1024 + n]); const float ref = s * bf1(WSP(bf16_t, WS_MG)[(size_t)t * 2048 + n]) * gb + s2 * gb;
        const float f = bf1(WSP(bf16_t, WS_H)[(size_t)t * 1024 + n]); num += (f - ref) * (f - ref); den += ref * ref; } }
#elif DBG_CHECK == 7
    { for (int n = F.tid; n < 1024; n += 512) { float s = 0.f; for (int k = 0; k < 1024; ++k) s += bf1(WSP(bf16_t, WS_H)[(size_t)t * 1024 + k]) * AR.in[14][(size_t)k * 1024 + n];
        const float ref = MOD[b * 6144 + 2048 + n] * s; const float f = bf1(WSP(bf16_t, WS_PA)[(size_t)t * 1024 + n]); num += (f - ref) * (f - ref); den += ref * ref; } }
#elif DBG_CHECK == 8
    { float ss = 0.f; for (int k = F.tid; k < 1024; k += 512) { const float v = AR.in[0][(size_t)t * 1024 + k] + bf1(WSP(bf16_t, WS_PA)[(size_t)t * 1024 + k]); ss += v * v; } ss = blk_sum(F, ss, red); const float r = rsqrtf(ss / 1024.f + EPS);
      for (int k = F.tid; k < 1024; k += 512) { const float ref = (AR.in[0][(size_t)t * 1024 + k] + bf1(WSP(bf16_t, WS_PA)[(size_t)t * 1024 + k])) * r * AR.in[15][k] * (1.f + MOD[b * 6144 + 4096 + k]) + MOD[b * 6144 + 3072 + k]; const float f = bf1(WSP(bf16_t, WS_H2)[(size_t)t * 1024 + k]);
        num += (f - ref) * (f - ref); den += ref * ref; } }
#elif DBG_CHECK == 9 || DBG_CHECK == 10 || DBG_CHECK == 12 || DBG_CHECK == 13
    { for (int k = F.tid; k < 1024; k += 512) sh[k] = bf1(WSP(bf16_t, WS_H2)[(size_t)t * 1024 + k]); __syncthreads();
      LAS float* lgt = sh + 1024;
      if (F.tid < 36) { float s = 0.f; if (F.tid < 4) { for (int k = 0; k < 1024; ++k) s += sh[k] * AR.in[16][k * 4 + F.tid]; s += AR.in[17][F.tid]; } else { const int j = F.tid - 4; for (int k = 0; k < 1024; ++k) s += sh[k] * AR.in[18][k * 32 + j]; s += AR.in[19][j]; } lgt[F.tid] = s; }
      __syncthreads();
      int gidx = 0; float gm = lgt[0]; for (int j = 1; j < 4; ++j) if (lgt[j] > gm) { gm = lgt[j]; gidx = j; }
      float gs = 0.f; for (int j = 0; j < 4; ++j) gs += __expf(lgt[j] - gm); const float gp = 1.f / gs;
      int i0 = 0; float v0 = lgt[4 + gidx * 8]; for (int j = 1; j < 8; ++j) if (lgt[4 + gidx * 8 + j] > v0) { v0 = lgt[4 + gidx * 8 + j]; i0 = j; }
      int i1 = -1; float v1 = -INFINITY; for (int j = 0; j < 8; ++j) if (j != i0 && lgt[4 + gidx * 8 + j] > v1) { v1 = lgt[4 + gidx * 8 + j]; i1 = j; }
      const float ex = __expf(v1 - v0); const float wk0 = gp / (1.f + ex), wk1 = gp * ex / (1.f + ex); const int ek0 = gidx * 8 + i0, ek1 = gidx * 8 + i1;
      if (DBG_CHECK == 12 && F.tid == 0) { const float f0 = WSP(float, WS_SLOTW)[2 * t], f1 = WSP(float, WS_SLOTW)[2 * t + 1]; num += (f0 - wk0) * (f0 - wk0) + (f1 - wk1) * (f1 - wk1); den += wk0 * wk0 + wk1 * wk1; }
      if (DBG_CHECK == 13) {
          const unsigned* LIST = WSP(unsigned, WS_LIST); const unsigned* gc = WSP(unsigned, WS_CTL) + CW_CNT; float found0 = 0.f, found1 = 0.f;
          const unsigned c0 = gc[64 * ek0], c1 = gc[64 * ek1];
          for (unsigned i = F.tid; i < c0; i += 512) if (LIST[(size_t)ek0 * 65536 + i] == (unsigned)(2 * t)) found0 = 1.f;
          for (unsigned i = F.tid; i < c1; i += 512) if (LIST[(size_t)ek1 * 65536 + i] == (unsigned)(2 * t + 1)) found1 = 1.f;
          num -= found0 + found1; if (F.tid == 0) { num += 2.f; den += 2.f; } }
      LAS float* he = sh + 1280;
      if (DBG_CHECK >= 12) goto dbg_done;
      _Pragma("unroll 1") for (int k2 = 0; k2 < 2; ++k2) { const int e = k2 ? ek1 : ek0; const float wkk = k2 ? wk1 : wk0; __syncthreads();
        { const int j = F.tid; float a = 0.f, u = 0.f; for (int k = 0; k < 1024; ++k) { a += sh[k] * AR.in[20][((size_t)e * 1024 + k) * 512 + j]; u += sh[k] * AR.in[21][((size_t)e * 1024 + k) * 512 + j]; }
          const float hv = a * dbg_sig(a) * u; he[j] = hv;
          if (DBG_CHECK == 10) { const float f = bf1(WSP(bf16_t, WS_HE)[(size_t)(2 * t + k2) * 512 + j]); num += (f - hv) * (f - hv); den += hv * hv; } }
        __syncthreads();
        if (DBG_CHECK == 9) for (int n = F.tid; n < 1024; n += 512) { float s = 0.f; for (int j = 0; j < 512; ++j) s += he[j] * AR.in[22][((size_t)e * 512 + j) * 1024 + n]; const float ref = s * wkk;
            const float f = bf1(WSP(bf16_t, WS_Y)[(size_t)(2 * t + k2) * 1024 + n]); num += (f - ref) * (f - ref); den += ref * ref; } } }
#elif DBG_CHECK == 11
    { const int bg = F.vcu & 63, n = (F.vcu * 7 + DBG_SALT) % 127; LAS float* hid = sh + 2048;
      for (int which = 0; which < 2; ++which) { const bf16_t* KV = WSP(bf16_t, which ? WS_VC : WS_KC) + ((size_t)bg * 2048 + 16 * n) * 64; __syncthreads();
        for (int k = F.tid; k < 2048; k += 512) sh[k] = bf1(KV[k]) + AR.in[8][which * 2048 + k]; __syncthreads();
        if (F.tid < 256) { float s = AR.in[10][which * 256 + F.tid]; for (int k = 0; k < 2048; ++k) s += sh[k] * AR.in[9][((size_t)which * 2048 + k) * 256 + F.tid]; const float u = 0.7978845608f * (s + 0.044715f * s * s * s); hid[F.tid] = 0.5f * s * (1.f + tanhf(u)); }
        __syncthreads();
        if (F.tid < 64) { float s = 0.f; for (int j = 0; j < 256; ++j) s += hid[j] * AR.in[11][((size_t)which * 256 + j) * 64 + F.tid];
            const float f = which ? bf1(WSP(bf16_t, WS_VCMPT)[(((size_t)bg * 2 + (n >> 6)) * 64 + F.tid) * 64 + (n & 63)]) : bf1(WSP(bf16_t, WS_KCMP)[((size_t)bg * 128 + n) * 64 + F.tid]); num += (f - s) * (f - s); den += s * s; } } }
#elif DBG_CHECK == 14 || DBG_CHECK == 15 || DBG_CHECK == 16 || DBG_CHECK == 17
    { const bf16_t* Qb = WSP(bf16_t, WS_Q); const bf16_t* ATT = WSP(bf16_t, WS_PA); const bf16_t* BG = WSP(bf16_t, WS_BG);
      LAS float* sc = sh;
      LAS float* pc = sh + 2048;
      LAS float* qv = sh + 2560;
      LAS float* oc = sh + 2624;
      LAS float* psv = sh + 3136;
      LAS unsigned* selm = (LAS unsigned*)(sh + 3200);
      const int cur = tb >> 6;
      for (int g = 0; g < 2; ++g) { const int bg = b * 2 + g;
        const bf16_t* KCMP = WSP(bf16_t, WS_KCMP) + (size_t)bg * 128 * 64; const bf16_t* VCT = WSP(bf16_t, WS_VCMPT) + (size_t)bg * 64 * 128;
        const bf16_t* KS = WSP(bf16_t, WS_KS) + (size_t)bg * 2048 * 64; const bf16_t* VST = WSP(bf16_t, WS_VST) + (size_t)bg * 64 * 2048;
        const bf16_t* KW = WSP(bf16_t, WS_KW) + (size_t)bg * 2048 * 64; const bf16_t* VWT = WSP(bf16_t, WS_VWT) + (size_t)bg * 64 * 2048;
        for (int hh = 0; hh < 4; ++hh) { const int hq = g * 4 + hh; __syncthreads();
            if (F.tid < 64) qv[F.tid] = bf1(Qb[(size_t)t * 512 + hq * 64 + F.tid]); __syncthreads();
            float s = -INFINITY; const bool valid = F.tid < 127 && (16 * F.tid + 31 <= tb);
            if (valid) { s = 0.f; for (int d = 0; d < 64; ++d) s += qv[d] * bf1(KCMP[F.tid * 64 + d]); }
            float m;
            { float mm = s; for (int o = 1; o < 64; o <<= 1) mm = fmaxf(mm, __shfl_xor(mm, o)); __syncthreads(); if (F.lane == 0) red[F.wave] = mm; __syncthreads(); mm = red[0]; for (int w = 1; w < 8; ++w) mm = fmaxf(mm, red[w]); __syncthreads(); m = mm; }
            const float e = valid ? exp2f(s - m) : 0.f; const float l = blk_sum(F, e, red);
            if (F.tid < 128) pc[hh * 128 + F.tid] = l > 0.f ? e / l : 0.f; __syncthreads();
            if (F.tid < 64) { float o = 0.f; for (int n = 0; n < 127; ++n) o += pc[hh * 128 + n] * bf1(VCT[((n >> 6) * 64 + F.tid) * 64 + (n & 63)]); oc[hq * 64 + F.tid] = o; } __syncthreads(); }
        if (F.tid < 32) { const int j = F.tid; float ps = 0.f; for (int hh = 0; hh < 4; ++hh) for (int n = 0; n < 127; ++n) { int ov = (16 * n + 32 < 64 * j + 64 ? 16 * n + 32 : 64 * j + 64) - (16 * n > 64 * j ? 16 * n : 64 * j); if (ov < 0) ov = 0; ps += pc[hh * 128 + n] * (float)ov * (1.f / 32.f); } psv[j] = ps; }
        __syncthreads();
        if (F.tid == 0) { unsigned msk = 0u; for (int it = 0; it < 8; ++it) { int best = -1; float bv = -INFINITY; for (int j = 0; j < 32; ++j) { if ((msk >> j) & 1u) continue; const bool forced = (j == 0) || (j == cur) || (j == cur - 1); const float scv = forced ? 1e4f : (j <= cur ? psv[j] : NEGBIG); if (scv > bv) { bv = scv; best = j; } } msk |= 1u << best; } selm[0] = msk; }
        __syncthreads();
        const unsigned msk = selm[0];
        for (int hh = 0; hh < 4; ++hh) { const int hq = g * 4 + hh; __syncthreads();
            if (F.tid < 64) qv[F.tid] = bf1(Qb[(size_t)t * 512 + hq * 64 + F.tid]); __syncthreads();
            float osel = 0.f, owin = 0.f;
            for (int br = 1; br < 3; ++br) { const bf16_t* Kb = br == 1 ? KS : KW; const bf16_t* Vb = br == 1 ? VST : VWT; float mloc = -INFINITY;
                for (int k = F.tid; k < 2048; k += 512) { const bool v = br == 1 ? (((msk >> (k >> 6)) & 1u) && k <= tb) : (k <= tb && k > tb - 512); float s = -INFINITY; if (v) { s = 0.f; for (int d = 0; d < 64; ++d) s += qv[d] * bf1(Kb[(size_t)k * 64 + d]); } sc[k] = s; mloc = fmaxf(mloc, s); }
                { float mm = mloc; for (int o = 1; o < 64; o <<= 1) mm = fmaxf(mm, __shfl_xor(mm, o)); __syncthreads(); if (F.lane == 0) red[F.wave] = mm; __syncthreads(); mm = red[0]; for (int w = 1; w < 8; ++w) mm = fmaxf(mm, red[w]); __syncthreads(); mloc = mm; }
                float lsum = 0.f; for (int k = F.tid; k < 2048; k += 512) { const float e = sc[k] > -INFINITY ? exp2f(sc[k] - mloc) : 0.f; sc[k] = e; lsum += e; } lsum = blk_sum(F, lsum, red);
                if (F.tid < 64) { float o = 0.f; for (int k = 0; k <= tb; ++k) o += sc[k] * bf1(Vb[((size_t)(k >> 6) * 64 + F.tid) * 64 + (k & 63)]); o /= lsum; if (br == 1) osel = o; else owin = o; } __syncthreads(); }
            if (F.tid < 64) { const float g0 = bf1(BG[(size_t)t * 32 + hq]), g1 = bf1(BG[(size_t)t * 32 + 8 + hq]), g2 = bf1(BG[(size_t)t * 32 + 16 + hq]);
                float ref = 0.f; if (DBG_CHECK == 14 || DBG_CHECK == 15) ref += g0 * oc[hq * 64 + F.tid]; if (DBG_CHECK == 14 || DBG_CHECK == 16) ref += g1 * osel; if (DBG_CHECK == 14 || DBG_CHECK == 17) ref += g2 * owin;
                const float f = bf1(ATT[(size_t)t * 1024 + 512 + hq * 64 + F.tid]); num += (f - ref) * (f - ref); den += ref * ref; } } } }
#endif
    dbg_done:
    num = blk_sum(F, num, red); den = blk_sum(F, den, red);
}
#endif
#define XB_TMO      128
#define XB_XCNT(j)  (256  + 64 * (j))
#define XB_XSUB(j)  (1280 + 64 * (j))
#define XB_XGEN(j)  (2304 + 64 * (j))
#define XB_TOP      3328
#define XB_TOPGEN   3392
#define XCD_BAR_WORDS 3456
#define XB_SPIN_CAP (1u << 22)
__device__ __forceinline__ unsigned xb_ld(unsigned* p)              { return __hip_atomic_load(p, __ATOMIC_RELAXED, __HIP_MEMORY_SCOPE_AGENT); }
__device__ __forceinline__ unsigned xb_add(unsigned* p, unsigned v) { return __hip_atomic_fetch_add(p, v, __ATOMIC_RELAXED, __HIP_MEMORY_SCOPE_AGENT); }
__device__ __forceinline__ unsigned xb_xcc_id() { return (unsigned)__builtin_amdgcn_s_getreg((3 << 11) | 20) & 0xFu; }
#define XB_SPIN(cond, bar) do { unsigned _sp = 0; while (cond) { __builtin_amdgcn_s_sleep(1); \
    if ((++_sp & 255u) == 0u) { if (xb_ld(&(bar)[XB_TMO])) break; if (_sp > XB_SPIN_CAP) { atomicAdd(&(bar)[XB_TMO], 1u); break; } } } } while (0)
struct XcdBarrier { unsigned* bar; unsigned x; volatile LAS unsigned* st; };
__device__ __forceinline__ XcdBarrier xcd_barrier_post(unsigned* bar, volatile LAS unsigned* st) {
    XcdBarrier b; b.bar = bar; b.x = xb_xcc_id(); b.st = st;
    if (threadIdx.x == 0) (void)xb_add(&bar[XB_XCNT(b.x)], 1u);
    return b;
}
__device__ __forceinline__ void xcd_barrier_complete(unsigned* bar, unsigned x, unsigned& nloc, unsigned& nx) {
    const unsigned G = gridDim.x * gridDim.y * gridDim.z;
    unsigned sum, cnt, mine, sp = 0u;
    for (;;) {
        sum = 0u; cnt = 0u; mine = 0u;
#pragma unroll
        for (unsigned j = 0; j < 16; ++j) { const unsigned c = xb_ld(&bar[XB_XCNT(j)]); sum += c; cnt += (c > 0u) ? 1u : 0u; mine = (j == x) ? c : mine; }
        if (sum == G) break;
        __builtin_amdgcn_s_sleep(1);
        if ((++sp & 255u) == 0u) { if (xb_ld(&bar[XB_TMO])) break; if (sp > XB_SPIN_CAP) { atomicAdd(&bar[XB_TMO], 1u); break; } }
    }
    nloc = mine > 0u ? mine : 1u; nx = cnt > 0u ? cnt : 1u;
}
__device__ __forceinline__ void xcd_barrier(const XcdBarrier& b) {
    asm volatile("s_waitcnt vmcnt(0)" ::: "memory");
    __syncthreads();
    if (threadIdx.x == 0) {
        unsigned* bar = b.bar;
        __builtin_amdgcn_s_waitcnt(0);
        unsigned nloc = b.st[0], nx = b.st[1];
        if (nloc == 0u) { xcd_barrier_complete(bar, b.x, nloc, nx); b.st[0] = nloc; b.st[1] = nx; }
        const unsigned old = xb_add(&bar[XB_XSUB(b.x)], 1u);
        const unsigned gen = old / nloc;
        if (old + 1u == (gen + 1u) * nloc) {
            __builtin_amdgcn_fence(__ATOMIC_RELEASE, "agent");
            asm volatile("s_waitcnt vmcnt(0)" ::: "memory");
            const unsigned og = xb_add(&bar[XB_TOP], 1u);
            const unsigned tg = og / nx;
            if (og + 1u == (tg + 1u) * nx) xb_add(&bar[XB_TOPGEN], 1u);
            else XB_SPIN(xb_ld(&bar[XB_TOPGEN]) == tg, bar);
            __builtin_amdgcn_fence(__ATOMIC_ACQUIRE, "agent");
            xb_add(&bar[XB_XGEN(b.x)], 1u);
            asm volatile("s_waitcnt vmcnt(0)" ::: "memory");
        } else {
            XB_SPIN(xb_ld(&bar[XB_XGEN(b.x)]) == gen, bar);
            __builtin_amdgcn_fence(__ATOMIC_ACQUIRE, "agent");
            asm volatile("s_waitcnt vmcnt(0)" ::: "memory");
        }
    }
    __syncthreads();
}

__device__ __forceinline__ void stagger(int group, int ticks_per_group) {
    const unsigned long long t0 = __builtin_amdgcn_s_memrealtime(); const unsigned long long want = (unsigned long long)(group * ticks_per_group);
    while (__builtin_amdgcn_s_memrealtime() - t0 < want) __builtin_amdgcn_s_sleep(8);
}
#ifndef MK_PER_PHASE
#define MK_PER_PHASE 0
#endif
constexpr int N_PHASES = 11;
__global__ void __launch_bounds__(NWAVES * 64, 2) mk_fwd(Args args) {
    extern __shared__ __attribute__((aligned(16))) unsigned char lds_raw[];
    Frame F;
    F.lds = (LAS unsigned char*)lds_raw; F.ws = args.ws; F.out = args.out;
    F.tid = threadIdx.x; F.lane = F.tid & 63; F.wave = __builtin_amdgcn_readfirstlane(F.tid >> 6);
    F.G = gridDim.x; { const int bx = blockIdx.x; F.vcu = (F.G % 8 == 0) ? (bx % 8) * (F.G / 8) + bx / 8 : bx; }
    volatile LAS unsigned* MISC = (volatile LAS unsigned*)(F.lds + MISC_OFF);
    if (F.tid < 16) MISC[F.tid] = 0u;
    __syncthreads();
    XcdBarrier bar; bar.bar = WSP(unsigned, WS_CTL) + CW_BAR; bar.x = 0; bar.st = MISC + 8;
    if (!MK_PER_PHASE) bar = xcd_barrier_post(WSP(unsigned, WS_CTL) + CW_BAR, MISC + 8);
    const int lo = args.ph_lo, hi = args.ph_hi;
#ifdef DBG_LAST
#define IN(k) (lo <= (k) && (k) < hi && ((k) <= DBG_LAST || (k) == 10))
#else
#define IN(k) (lo <= (k) && (k) < hi)
#endif
#define SEAM(k) do { if (lo <= (k) && (k) + 1 < hi) xcd_barrier(bar); } while (0)
    LAS unsigned char* ring = F.lds;
#ifdef DBG_STAMP
    volatile LAS unsigned long long* stamps = (volatile LAS unsigned long long*)(F.lds + MISC_OFF + 128);
#define STAMP(k) do { if (blockIdx.x == 0 && F.tid == 0) stamps[k] = __builtin_amdgcn_s_memrealtime(); } while (0)
#else
#define STAMP(k) do {} while (0)
#endif
    STAMP(0);

    if (IN(0)) { p0_prologue(F, args); }
    SEAM(0); STAMP(1);
    if (IN(1)) { p1_norm_mod(F, args); }
    SEAM(1); STAMP(2);
    if (IN(2)) {
        SchedPlain S; S.A = (const char*)WSP(bf16_t, WS_H); S.Bt = (const char*)WSP(bf16_t, WS_WIN); S.lda = 2048u; S.K = 1024; S.so.init(NTOK, 3840, F.G, (int)blockIdx.x);
        EpiG1 E{WSP(bf16_t, WS_U), WSP(bf16_t, WS_Q), WSP(bf16_t, WS_KC), WSP(bf16_t, WS_VC), WSP(bf16_t, WS_KS), WSP(bf16_t, WS_VST), WSP(bf16_t, WS_KW), WSP(bf16_t, WS_VWT), WSP(bf16_t, WS_MG), WSP(bf16_t, WS_BG)};
        pg8::gemm_phase<EpiG1, SchedPlain>(ring, 1024, S, E);
    }
    SEAM(2); STAMP(3);
    if (IN(3)) {
        const int ncmp = F.G > 64 ? 64 : 0;
        if (F.vcu < 64) {
            for (int c = F.vcu; c < 64; c += F.G) {
                SchedCmp S{(const char*)WSP(bf16_t, WS_KC), (const char*)WSP(bf16_t, WS_VC), (const char*)WSP(bf16_t, WS_W1C), c};
                EpiHid E{WSP(bf16_t, WS_HID), WSP(float, WS_BIAS1)};
                pg8::gemm_phase<EpiHid, SchedCmp>(ring, 2048, S, E);
                VM_WAIT(); __syncthreads();
                p3_cmp2(F, c >> 5, c & 31);
                __syncthreads();
            }
        }
        STAMP(13);
        if (F.vcu >= ncmp) { p3_pool(F, (F.vcu - ncmp) * NWAVES + F.wave, (F.G - ncmp) * NWAVES); p3_bgate(F, (F.vcu - ncmp) * NWAVES + F.wave, (F.G - ncmp) * NWAVES); }
    }
    SEAM(3); STAMP(4);
    if (IN(4)) {
                bf16_t* attn_out = WSP(bf16_t, WS_PA);
        const nsa::Ptrs T{WSP(bf16_t, WS_Q), attn_out, (const char*)F.ws, WSP(bf16_t, WS_BG)};
        int bslot = 0;
        if (F.G == 256) {
            const int xcd = F.vcu >> 5, r = F.vcu & 31;
            for (int k = 0; k < 4; ++k) { const int bg = xcd * 8 + 2 * k + (r >> 4); const int s = ((r & 15) + 4 * k) & 15;
                const int bgn = xcd * 8 + 2 * (k + 1) + (r >> 4), sn = ((r & 15) + 4 * (k + 1)) & 15;
                nsa::attn_unit(ring, T, bg >> 1, bg & 1, 31 - s, bg, s, bslot, k > 0, F.wave, F.lane);
                nsa::attn_unit(ring, T, bg >> 1, bg & 1, s, k < 3 ? bgn : -1, 31 - sn, bslot, true, F.wave, F.lane); }
        } else {
            for (int u = F.vcu; u < 2048; u += F.G) { const int bg = u >> 5, ci = u & 31; nsa::attn_unit(ring, T, bg >> 1, bg & 1, ci, -1, 0, bslot, false, F.wave, F.lane); }
        }
    }
    STAMP(12); SEAM(4); STAMP(5);
    if (IN(5)) {
        SchedPlain S; S.A = (const char*)WSP(bf16_t, WS_PA); S.Bt = (const char*)WSP(bf16_t, WS_WPA); S.lda = 2048u; S.K = 1024; S.so.init(NTOK, 1024, F.G, (int)blockIdx.x);
        EpiMix E{WSP(bf16_t, WS_MG), WSP(bf16_t, WS_H)}; pg8::gemm_phase<EpiMix, SchedPlain>(ring, 1024, S, E);
    }
    SEAM(5); STAMP(6);
    if (IN(6)) {
        SchedPlain S; S.A = (const char*)WSP(bf16_t, WS_H); S.Bt = (const char*)WSP(bf16_t, WS_WOUT); S.lda = 2048u; S.K = 1024; S.so.init(NTOK, 1024, F.G, (int)blockIdx.x);
        EpiDelta E{WSP(float, WS_MOD), WSP(bf16_t, WS_PA)}; pg8::gemm_phase<EpiDelta, SchedPlain>(ring, 1024, S, E);
    }
    SEAM(6); STAMP(7);
    if (IN(7)) { p7_router(F, args); }
    SEAM(7); STAMP(8);
    LAS unsigned* tcnt = (LAS unsigned*)(F.lds + RT_OFF); LAS unsigned* tbase = tcnt + 32; LAS u32x2* mtab = (LAS u32x2*)(F.lds + RING_BYTES);
    if (IN(8)) {
        moe_tables(F, tcnt, tbase);
        SchedMoe S{(const char*)WSP(bf16_t, WS_H2), (const char*)WSP(bf16_t, WS_WGU), WSP(unsigned, WS_LIST), tcnt, tbase, 2048u, (size_t)1024 * 1024 * 2, 1024, F.G, (int)blockIdx.x, true, mtab, nullptr};
        EpiHE E{WSP(bf16_t, WS_HE), mtab}; pg8::gemm_phase<EpiHE, SchedMoe>(ring, 1024, S, E);
    }
    SEAM(8); STAMP(9);
    if (IN(9)) {
        moe_tables(F, tcnt, tbase);
        SchedMoe S{(const char*)WSP(bf16_t, WS_HE), (const char*)WSP(bf16_t, WS_WD), WSP(unsigned, WS_LIST), tcnt, tbase, 1024u, (size_t)1024 * 512 * 2, 512, F.G, (int)blockIdx.x, false, mtab, WSP(float, WS_SLOTW)};
        EpiY E{WSP(bf16_t, WS_Y), mtab}; pg8::gemm_phase<EpiY, SchedMoe>(ring, 512, S, E);
    }
    SEAM(9); STAMP(10);
#ifdef DBG_CHECK
    if (IN(10)) {
        float num, den; dbg_check(F, args, num, den);
        float* acc2 = (float*)(WSP(unsigned, WS_CTL) + 12288);
        if (F.tid == 0) { atomicAdd(acc2, num); atomicAdd(acc2 + 1, den); }
        xcd_barrier(bar);
        const float tn = __hip_atomic_load(acc2, __ATOMIC_RELAXED, __HIP_MEMORY_SCOPE_AGENT), td = __hip_atomic_load(acc2 + 1, __ATOMIC_RELAXED, __HIP_MEMORY_SCOPE_AGENT);
        float E = 20.0f * sqrtf(tn / fmaxf(td, 1e-30f)); if (!(E < 50.f)) E = 50.f;
        const float* x = args.in[0]; const float* fg = args.in[23]; const int gw = F.vcu * NWAVES + F.wave, NGW = F.G * NWAVES;
        for (int row = gw; row < NTOK; row += NGW) { const f32x4* xr = (const f32x4*)(x + (size_t)row * 1024) + F.lane; f32x4 v[4]; float s = 0.f;
            for (int j = 0; j < 4; ++j) { v[j] = xr[64 * j]; s += v[j][0] * v[j][0] + v[j][1] * v[j][1] + v[j][2] * v[j][2] + v[j][3] * v[j][3]; }
            const float rs = rsqrtf(wave_sum(s) * (1.0f / 1024.0f) + EPS) * (1.0f + E);
            f32x4* orow = (f32x4*)(F.out + (size_t)row * 1024) + F.lane; for (int j = 0; j < 4; ++j) orow[64 * j] = v[j] * rs * *((const f32x4*)fg + F.lane + 64 * j); }
    }
#else
    if (IN(10)) { p10_final(F, args); }
#endif
#ifdef DBG_STAMP
    STAMP(11);
    xcd_barrier(bar);
    if (blockIdx.x == 0 && F.tid == 0) { const unsigned long long t0 = stamps[DBG_STAMP], t1 = stamps[DBG_STAMP_END]; F.out[0] = (float)(t1 - t0) * 0.01f * DBG_STAMP_SCALE;
#ifdef DBG_CYC
        F.out[0] = 100.0f * (float)nsa::dbg_cyc[DBG_CYC] / (float)nsa::dbg_cyc[2];
#endif
    }
#endif
#undef IN
#undef SEAM
}

extern "C" void kernel_launch(void* const* d_in, const int* in_sizes, int n_in, void* d_out, int out_size, void* d_ws, size_t ws_size, hipStream_t stream) {
    static int grid = 0;
    if (grid == 0) {
        if (n_in != 24 || out_size != NTOK * D || ws_size < WS_END) { fprintf(stderr, "kernel_launch: unexpected shapes (n_in %d, out %d, ws %zu)\n", n_in, out_size, ws_size); grid = -1; return; }
        int dev = 0, cus = 0, per_cu = 0;
        if (hipGetDevice(&dev) != hipSuccess || hipDeviceGetAttribute(&cus, hipDeviceAttributeMultiprocessorCount, dev) != hipSuccess) { grid = -1; return; }
        if (hipFuncSetAttribute((const void*)mk_fwd, hipFuncAttributeMaxDynamicSharedMemorySize, LDS_BYTES) != hipSuccess) { fprintf(stderr, "kernel_launch: hipFuncSetAttribute failed\n"); grid = -1; return; }
        if (hipOccupancyMaxActiveBlocksPerMultiprocessor(&per_cu, (const void*)mk_fwd, NWAVES * 64, LDS_BYTES) != hipSuccess || per_cu < 1) { fprintf(stderr, "kernel_launch: occupancy query reports %d\n", per_cu); }
        (void)hipGetLastError();
        grid = cus;
    }
    if (grid < 0) return;
    (void)hipMemsetAsync((char*)d_ws + WS_CTL, 0, CTL_ZERO_BYTES, stream);
    Args a{};
    for (int i = 0; i < 24; ++i) a.in[i] = (const float*)d_in[i];
    a.out = (float*)d_out; a.ws = (unsigned char*)d_ws;
#if MK_PER_PHASE
    for (int p = 0; p < N_PHASES; ++p) { a.ph_lo = p; a.ph_hi = p + 1; hipLaunchKernelGGL(mk_fwd, dim3(grid), dim3(NWAVES * 64), LDS_BYTES, stream, a); }
#else
    a.ph_lo = 0; a.ph_hi = N_PHASES; hipLaunchKernelGGL(mk_fwd, dim3(grid), dim3(NWAVES * 64), LDS_BYTES, stream, a);
#endif
}
```

```cpp
#include <hip/hip_runtime.h>
#include <cstdio>
#include <cstdint>

#define GAS __attribute__((address_space(1)))
#define LAS __attribute__((address_space(3)))
typedef unsigned short bf16_t;
typedef short bf16x8 __attribute__((ext_vector_type(8)));
typedef short s16x4 __attribute__((ext_vector_type(4)));
typedef float f32x2 __attribute__((ext_vector_type(2)));
typedef float f32x4 __attribute__((ext_vector_type(4)));
typedef float f32x16 __attribute__((ext_vector_type(16)));
typedef unsigned u32x2 __attribute__((ext_vector_type(2)));
typedef unsigned u32x4 __attribute__((ext_vector_type(4)));

#ifndef STG2
#define STG2 500
#endif
#ifndef DBG_MOE_SCALE
#define DBG_MOE_SCALE 1.0f
#endif
constexpr int NB = 32, SEQ = 2048, D = 1024, NTOK = NB * SEQ;
constexpr int NEXP = 32, EFF = 512;
constexpr int NWAVES = 8;
constexpr float EPS = 1e-6f;
constexpr float LOG2E = 1.4426950408889634f;
constexpr float QSCALE = 0.125f * LOG2E;
constexpr float NEGBIG = -1e30f;

constexpr size_t MiB = 1u << 20;
constexpr size_t WS_CTL = 0, CTL_ZERO_BYTES = 64 * 1024;
constexpr size_t WS_MOD = 1 * MiB;
constexpr size_t WS_BIAS1 = WS_MOD + 768 * 1024;
constexpr size_t WS_W2C = WS_BIAS1 + 4096;
constexpr size_t WS_SLOTW = 2 * MiB;
constexpr size_t WS_LIST = 3 * MiB;
constexpr size_t WS_W1C = 11 * MiB;
constexpr size_t WS_WPA = 13 * MiB;
constexpr size_t WS_WOUT = 15 * MiB;
constexpr size_t WS_WIN = 17 * MiB;
constexpr size_t WS_WGU = 25 * MiB;
constexpr size_t WS_WD = 89 * MiB;
constexpr size_t WS_H = 128 * MiB;
constexpr size_t WS_U = 256 * MiB;
constexpr size_t WS_Q = 320 * MiB;
constexpr size_t WS_KC = 384 * MiB;
constexpr size_t WS_VC = 400 * MiB;
constexpr size_t WS_KS = 416 * MiB;
constexpr size_t WS_VST = 432 * MiB;
constexpr size_t WS_KW = 448 * MiB;
constexpr size_t WS_VWT = 464 * MiB;
constexpr size_t WS_MG = 480 * MiB;
constexpr size_t WS_BG = 736 * MiB;
constexpr size_t WS_HID = 740 * MiB;
constexpr size_t WS_KCMP = 748 * MiB;
constexpr size_t WS_VCMPT = 749 * MiB;
constexpr size_t WS_PA = 816 * MiB;
constexpr size_t WS_H2 = 256 * MiB;
constexpr size_t WS_HE = 384 * MiB;
constexpr size_t WS_Y = 512 * MiB;
constexpr size_t WS_END = 944 * MiB;
constexpr int CW_BAR = 4096;
constexpr int CW_CNT = 8192;
constexpr int CW_Q0 = 12800;

constexpr int RING_BYTES = 131072;
constexpr int LDS_ROUTER_W = 36 * 1024 * 4;
constexpr int RT_OFF = LDS_ROUTER_W;
constexpr int MISC_OFF = 153600;
constexpr int LDS_BYTES = 155648;

typedef __bf16 bf16x2_t __attribute__((ext_vector_type(2)));
__device__ __forceinline__ unsigned cvt_pk_bf16(float lo, float hi) { const f32x2 v = {lo, hi}; const bf16x2_t b = __builtin_convertvector(v, bf16x2_t); return __builtin_bit_cast(unsigned, b); }
__device__ __forceinline__ float bf_lo(unsigned u) { return __uint_as_float(u << 16); }
__device__ __forceinline__ float bf_hi(unsigned u) { return __uint_as_float(u & 0xffff0000u); }
__device__ __forceinline__ float bf1(bf16_t b) { return __uint_as_float((unsigned)b << 16); }
__device__ __forceinline__ float fast_exp2(float x) { return __builtin_amdgcn_exp2f(x); }
__device__ __forceinline__ float fast_rcp(float x) { return __builtin_amdgcn_rcpf(x); }
__device__ __forceinline__ float sigmoidf_(float x) { return fast_rcp(1.0f + fast_exp2(-x * LOG2E)); }
__device__ __forceinline__ float gelu_tanh(float x) { const float u = 0.7978845608028654f * (x + 0.044715f * x * x * x); return x * fast_rcp(1.0f + fast_exp2(-2.0f * LOG2E * u)); }
__device__ __forceinline__ float wave_sum(float v) {
#pragma unroll
    for (int o = 1; o < 64; o <<= 1) v += __shfl_xor(v, o);
    return v;
}
#define LDS_WAIT() asm volatile("s_waitcnt lgkmcnt(0)" ::: "memory")
#define VM_WAIT() asm volatile("s_waitcnt vmcnt(0)" ::: "memory")
namespace pg8 {
typedef int i32x4 __attribute__((ext_vector_type(4)));
typedef int i32x8 __attribute__((ext_vector_type(8)));
constexpr int BM = 256, BK = 64, HALF = 128, HTB = HALF * BK * 2, STAGE_BYTES = 8 * HTB;
__host__ __device__ __forceinline__ int lds_byte(int r, int c) { const int st = (r >> 4) * 2 + (c >> 5), rr = r & 15, cc = c & 31, ob = rr * 64 + cc * 2; return st * 1024 + (ob ^ (((ob >> 9) & 1) << 5)); }
__host__ __device__ __forceinline__ void stage_rc(int b, int& R, int& C) { const int st = b / 1024, sb = b % 1024, swz = sb ^ (((sb >> 9) & 1) << 5); R = (st >> 1) * 16 + swz / 64; C = (st & 1) * 32 + (swz % 64) / 2; }
__host__ __device__ __forceinline__ int perm32(int rho) { const int n = rho >> 4, i = rho & 15; return 8 * (i >> 2) + 4 * n + (i & 3); }

struct Unit { const char* A; const char* B; int pm, pn, e, nrows; };

#ifndef PG8_WGM
#define PG8_WGM 8
#endif
struct StaticOrder {
    static constexpr int WGM = PG8_WGM;
    int nM, nN, nwg, G, c;
    __device__ void init(int M, int N, int G_, int c_) { nM = M / BM; nN = N / BM; nwg = nM * nN; G = G_; c = c_; }
    __device__ bool next(int i, int& pm, int& pn) const {
        const long L = (long)i * G + c; if (L >= nwg) return false;
        int wgid = (int)L; { const int q = nwg / 8, r = nwg % 8, xcd = wgid % 8, off = wgid / 8; wgid = (xcd < r ? xcd * (q + 1) : r * (q + 1) + (xcd - r) * q) + off; }
        const int nig = WGM * nN, gid = wgid / nig, fm = gid * WGM, gsz = (nM - fm) < WGM ? (nM - fm) : WGM;
        pm = fm + ((wgid % nig) % gsz); pn = (wgid % nig) / gsz; return true;
    }
};

template <class Epi, class Sched>
__device__ __forceinline__ void gemm_phase(LAS unsigned char* lds, const int K, const Sched& S, const Epi& E) {
    const int tid = threadIdx.x, wid = __builtin_amdgcn_readfirstlane(tid >> 6), lane = tid & 63, wr = wid >> 2, wc = wid & 3, fr = lane & 15, fq = lane >> 4;
    const int nt = K / BK;
    int Rr[2], Cc[2];
    unsigned voffB[2];
#pragma unroll
    for (int i = 0; i < 2; ++i) { int R, C; stage_rc(tid * 16 + i * 8192, R, C); Rr[i] = R; Cc[i] = C; const int Rb = Epi::PERM ? ((R & ~31) + perm32(R & 31)) : R; voffB[i] = (unsigned)(Rb * K + C) * 2u; }
    const size_t kstep = (size_t)(BK * 2);
    const size_t hstepB = (size_t)HALF * K * 2;
    const unsigned ldsw = (unsigned)wid * 1024u;
    const int aoff = lds_byte(wr * 64 + fr, fq * 8), boff = lds_byte(wc * 32 + fr, fq * 8);
#define PG8_SA(b, h) (((b) * 2 + (h)) * HTB)
#define PG8_SB(b, h) ((4 + (b) * 2 + (h)) * HTB)
#define PG8_STAGE2(bufoff, gbase, v0, v1) do { \
        __builtin_amdgcn_global_load_lds((const unsigned*)((const char*)(gbase) + (v0)), (LAS unsigned*)(lds + (bufoff) + ldsw), 16, 0, 0); \
        __builtin_amdgcn_global_load_lds((const unsigned*)((const char*)(gbase) + (v1)), (LAS unsigned*)(lds + (bufoff) + ldsw + 8192), 16, 0, 0); } while (0)
#define PG8_STAGEB(bufoff, gbase) PG8_STAGE2(bufoff, gbase, voffB[0], voffB[1])
#define PG8_LDA(dst, b, h) do { _Pragma("unroll") for (int m = 0; m < 4; ++m) { if constexpr (Epi::FP8) { \
            dst##8[m] = __builtin_shufflevector(*(const LAS i32x4*)(lds + PG8_SA(b, h) + aoff + m * 2048), *(const LAS i32x4*)(lds + PG8_SA(b, h) + aoff + m * 2048 + 1024), 0, 1, 2, 3, 4, 5, 6, 7); \
        } else { _Pragma("unroll") for (int k = 0; k < 2; ++k) dst[m][k] = *(const LAS bf16x8*)(lds + PG8_SA(b, h) + aoff + m * 2048 + k * 1024); } } } while (0)
#define PG8_LDB(dst, b, h) do { _Pragma("unroll") for (int n = 0; n < 2; ++n) { if constexpr (Epi::FP8) { \
            dst##8[n] = __builtin_shufflevector(*(const LAS i32x4*)(lds + PG8_SB(b, h) + boff + n * 2048), *(const LAS i32x4*)(lds + PG8_SB(b, h) + boff + n * 2048 + 1024), 0, 1, 2, 3, 4, 5, 6, 7); \
        } else { _Pragma("unroll") for (int k = 0; k < 2; ++k) dst[n][k] = *(const LAS bf16x8*)(lds + PG8_SB(b, h) + boff + n * 2048 + k * 1024); } } } while (0)
#define PG8_MMA(ai, bj, At, Bt) do { __builtin_amdgcn_s_setprio(1); _Pragma("unroll") for (int m = 0; m < 4; ++m) _Pragma("unroll") for (int n = 0; n < 2; ++n) { \
        if constexpr (Epi::FP8) {   \
              \
            asm volatile("v_mfma_scale_f32_16x16x128_f8f6f4 %0, %1, %2, %0, %3, %4 op_sel_hi:[0,0,0]" : "+v"(acc[ai][bj][m][n]) : "v"(Bt##8[n]), "v"(At##8[m]), "v"(sclw), "v"(scla)); \
        } else { _Pragma("unroll") for (int k = 0; k < 2; ++k) acc[ai][bj][m][n] = __builtin_amdgcn_mfma_f32_16x16x32_bf16(Bt[n][k], At[m][k], acc[ai][bj][m][n], 0, 0, 0); } } \
        __builtin_amdgcn_s_setprio(0); } while (0)
#define PG8_WAIT_V(n) asm volatile("s_waitcnt vmcnt(" #n ")" ::: "memory")
#define PG8_WAIT_L(n) asm volatile("s_waitcnt lgkmcnt(" #n ")" ::: "memory")
#define PG8_BAR __builtin_amdgcn_s_barrier()
#define PG8_SCHED __builtin_amdgcn_sched_barrier(0)
    Unit cur, nxt; int ui = 0; u32x2 pfv = {0u, 0u};
    if (!S.next(0, cur)) return;
    f32x4 acc[2][2][4][2];
#pragma unroll
    for (int a = 0; a < 2; ++a)
#pragma unroll
        for (int b = 0; b < 2; ++b)
#pragma unroll
            for (int m = 0; m < 4; ++m)
#pragma unroll
                for (int n = 0; n < 2; ++n) acc[a][b][m][n] = (f32x4){0.f, 0.f, 0.f, 0.f};
    const int sclw = Epi::SCALE_W, scla = 0x7f7f7f7f;
    bf16x8 At[4][2], B0[2][2], B1[2][2];
    i32x8 At8[4], B08[2], B18[2];
    unsigned c00, c01, c10, c11, n00, n01, n10, n11;
    c00 = S.aoff(cur, Rr[0]) + (unsigned)Cc[0] * 2u; c01 = S.aoff(cur, Rr[1]) + (unsigned)Cc[1] * 2u;
    c10 = S.aoff(cur, Rr[0] + HALF) + (unsigned)Cc[0] * 2u; c11 = S.aoff(cur, Rr[1] + HALF) + (unsigned)Cc[1] * 2u;
    const char* cA = cur.A; const char* cB = cur.B;
    S.prefetch(cur, 0);
    PG8_STAGEB(PG8_SB(0, 0), cB); PG8_STAGEB(PG8_SB(0, 1), cB + hstepB); PG8_STAGE2(PG8_SA(0, 0), cA, c00, c01); PG8_STAGE2(PG8_SA(0, 1), cA, c10, c11);
    if (wr == 1) PG8_BAR;
    PG8_WAIT_V(2); PG8_BAR;
    PG8_STAGEB(PG8_SB(1, 0), cB + kstep); PG8_STAGE2(PG8_SA(1, 0), cA + kstep, c00, c01); PG8_STAGEB(PG8_SB(1, 1), cB + hstepB + kstep);
    PG8_WAIT_V(6); PG8_BAR;
    for (;;) {
        const bool has_next = S.next(ui + 1, nxt);
        const char* nA = has_next ? nxt.A : cA; const char* nB = has_next ? nxt.B : cB;
        if (has_next) {
            n00 = S.aoff(nxt, Rr[0]) + (unsigned)Cc[0] * 2u; n01 = S.aoff(nxt, Rr[1]) + (unsigned)Cc[1] * 2u;
            n10 = S.aoff(nxt, Rr[0] + HALF) + (unsigned)Cc[0] * 2u; n11 = S.aoff(nxt, Rr[1] + HALF) + (unsigned)Cc[1] * 2u;
        } else { n00 = c00; n01 = c01; n10 = c10; n11 = c11; }
#pragma unroll 1
        for (int t = 0; t < nt; t += 2) {
            if constexpr (Epi::HAS_MID) { if (t == nt / 2) E.mid(acc, cur, wr, wc, fr, fq); }
            const bool last = (t == nt - 2);
            const char* a1 = cA + (size_t)(t + 1) * kstep;
            const char* a2 = last ? nA : cA + (size_t)(t + 2) * kstep; const char* b2 = last ? nB : cB + (size_t)(t + 2) * kstep;
            const char* a3 = a2 + kstep; const char* b3 = b2 + kstep;
            const unsigned x00 = last ? n00 : c00, x01 = last ? n01 : c01, x10 = last ? n10 : c10, x11 = last ? n11 : c11;
            PG8_LDB(B0, 0, 0); PG8_LDB(B1, 0, 1); PG8_SCHED; PG8_LDA(At, 0, 0); PG8_STAGE2(PG8_SA(1, 1), a1, c10, c11);
            PG8_WAIT_V(8); PG8_WAIT_L(0); PG8_BAR; PG8_MMA(0, 0, At, B0); PG8_MMA(0, 1, At, B1); PG8_BAR; PG8_SCHED;
            PG8_LDA(At, 0, 1); PG8_STAGEB(PG8_SB(0, 0), b2); PG8_STAGEB(PG8_SB(0, 1), b2 + hstepB); PG8_STAGE2(PG8_SA(0, 0), a2, x00, x01);
            PG8_WAIT_V(8); PG8_WAIT_L(0); PG8_BAR; PG8_MMA(1, 0, At, B0); PG8_MMA(1, 1, At, B1); PG8_BAR; PG8_SCHED;
            PG8_LDB(B0, 1, 0); PG8_LDB(B1, 1, 1); PG8_SCHED; PG8_LDA(At, 1, 0); PG8_STAGE2(PG8_SA(0, 1), a2, x10, x11);
            PG8_WAIT_V(8); PG8_WAIT_L(0); PG8_BAR; PG8_MMA(0, 0, At, B0); PG8_MMA(0, 1, At, B1); PG8_BAR; PG8_SCHED;
            PG8_LDA(At, 1, 1); PG8_STAGEB(PG8_SB(1, 0), b3); PG8_STAGEB(PG8_SB(1, 1), b3 + hstepB); PG8_STAGE2(PG8_SA(1, 0), a3, x00, x01);
            PG8_WAIT_V(8); PG8_WAIT_L(0); PG8_BAR; PG8_MMA(1, 0, At, B0); PG8_MMA(1, 1, At, B1); PG8_BAR; PG8_SCHED;
        }
        if (wr == 0) PG8_BAR;
        E(acc, cur, wr, wc, fr, fq, ui);
        if (!has_next) break;
        pfv = S.pf_load(nxt);
#pragma unroll
        for (int a = 0; a < 2; ++a)
#pragma unroll
            for (int b = 0; b < 2; ++b)
#pragma unroll
                for (int m = 0; m < 4; ++m)
#pragma unroll
                    for (int n = 0; n < 2; ++n) acc[a][b][m][n] = (f32x4){0.f, 0.f, 0.f, 0.f};
        cur = nxt; cA = nA; cB = nB; c00 = n00; c01 = n01; c10 = n10; c11 = n11; ++ui;
        if (wr == 1) PG8_BAR;
        S.pf_store(ui, pfv);
    }
    PG8_WAIT_V(0);
    PG8_BAR;
#undef PG8_SA
#undef PG8_SB
#undef PG8_STAGE2
#undef PG8_STAGEB
#undef PG8_LDA
#undef PG8_LDB
#undef PG8_MMA
#undef PG8_WAIT_V
#undef PG8_WAIT_L
#undef PG8_BAR
#undef PG8_SCHED
}
}
using pg8::Unit;
#if defined(EPI_SC1)
typedef int i32x4 __attribute__((ext_vector_type(4)));
__device__ __forceinline__ void epi_st16_sc1(const void* base, unsigned byte_off, u32x4 v) {
    const __amdgpu_buffer_rsrc_t r = __builtin_amdgcn_make_buffer_rsrc((void*)base, 0, 0x7fffffff, 0x00020000);
    __builtin_amdgcn_raw_buffer_store_b128(v, r, (int)byte_off, 0, 16); }
#define EPI_ST16(base_, off_, val_) epi_st16_sc1((base_), (unsigned)((off_) * 2), (val_))
#elif defined(EPI_NT)
#define EPI_ST16(base_, off_, val_) __builtin_nontemporal_store((val_), (u32x4*)((base_) + (off_)))
#else
#define EPI_ST16(base_, off_, val_) (*(u32x4*)((base_) + (off_)) = (val_))
#endif
typedef f32x4 AccT[2][2][4][2];

__device__ __forceinline__ u32x4 pack8(const f32x4 a, const f32x4 b) { u32x4 w; w.x = cvt_pk_bf16(a[0], a[1]); w.y = cvt_pk_bf16(a[2], a[3]); w.z = cvt_pk_bf16(b[0], b[1]); w.w = cvt_pk_bf16(b[2], b[3]); return w; }
__device__ __forceinline__ void unpack8(const u32x4 w, f32x4& a, f32x4& b) { a = (f32x4){bf_lo(w.x), bf_hi(w.x), bf_lo(w.y), bf_hi(w.y)}; b = (f32x4){bf_lo(w.z), bf_hi(w.z), bf_lo(w.w), bf_hi(w.w)}; }

struct SchedPlain {
    const char* A; const char* Bt; unsigned lda; int K; pg8::StaticOrder so;
    __device__ __forceinline__ bool next(int i, Unit& u) const { int pm, pn; if (!so.next(i, pm, pn)) return false; u.pm = pm; u.pn = pn; u.e = 0; u.nrows = 256;
        u.A = A + (size_t)pm * 256 * lda; u.B = Bt + (size_t)pn * 256 * K * 2; return true; }
    __device__ __forceinline__ unsigned aoff(const Unit&, int R) const { return (unsigned)R * lda; }
    __device__ __forceinline__ void prefetch(const Unit&, int) const {}
    __device__ __forceinline__ u32x2 pf_load(const Unit&) const { return (u32x2){0u, 0u}; }
    __device__ __forceinline__ void pf_store(int, u32x2) const {}
};

struct EpiG1 {
    static constexpr bool PERM = true, HAS_MID = false, FP8 = false; static constexpr int SCALE_W = 0x7f7f7f7f;
    bf16_t *U, *Q, *KC, *VC, *KS, *VST, *KW, *VWT, *MG, *BG;
    __device__ __forceinline__ void operator()(const AccT& acc, const Unit& u, int wr, int wc, int fr, int fq, int ui = 0) const {
        const int pn = u.pn < 8 ? u.pn + 7 : (u.pn < 12 ? u.pn - 8 : 18 - u.pn);
        const int row0 = u.pm * 256 + wr * 64 + fr; const int cc = wc * 32 + 8 * fq;
#pragma unroll
        for (int ai = 0; ai < 2; ++ai)
#pragma unroll
            for (int m = 0; m < 4; ++m) {
                const int row = row0 + ai * 128 + m * 16;
#pragma unroll
                for (int bj = 0; bj < 2; ++bj) {
                    f32x4 v0 = acc[ai][bj][m][0], v1 = acc[ai][bj][m][1];
                    const int col = 128 * bj + cc;
                    if (pn < 2) { EPI_ST16(U, (size_t)row * 512 + pn * 256 + col, pack8(v0, v1)); }
                    else if (pn < 4) { v0 = v0 * QSCALE; v1 = v1 * QSCALE; EPI_ST16(Q, (size_t)row * 512 + (pn - 2) * 256 + col, pack8(v0, v1)); }
                    else if (pn < 7) {
                        const int g = cc >> 6, d = cc & 63, b = row >> 11, s = row & 2047;
                        const size_t kidx = ((size_t)(b * 2 + g) * 2048 + s) * 64 + d;
                        if (bj == 0) { bf16_t* Kb = pn == 4 ? KC : (pn == 5 ? KS : KW); EPI_ST16(Kb, kidx, pack8(v0, v1)); }
                        else if (pn == 4) { EPI_ST16(VC, kidx, pack8(v0, v1)); }
                        else {
                            const u32x4 w = pack8(v0, v1); const int odd = fr & 1;
                            bf16_t* Vt = (pn == 5 ? VST : VWT) + (((size_t)(b * 2 + g) * 32 + (s >> 6)) * 64 + d + odd) * 64 + ((s & 63) & ~1);
#pragma unroll
                            for (int q = 0; q < 4; ++q) { const unsigned mine = q == 0 ? w.x : (q == 1 ? w.y : (q == 2 ? w.z : w.w));
                                const unsigned nb = (unsigned)__builtin_amdgcn_update_dpp(0, (int)mine, 0xB1, 0xF, 0xF, true);
                                const unsigned o = odd ? ((nb >> 16) | (mine & 0xffff0000u)) : ((mine & 0xffffu) | (nb << 16));
                                *(unsigned*)(Vt + (size_t)(2 * q) * 64) = o; } }
                    }
                    else if (pn < 15) {
                        if (bj == 0) { f32x4 a0 = v0, a1 = v1, b0 = acc[ai][1][m][0], b1 = acc[ai][1][m][1];
#pragma unroll
                            for (int i = 0; i < 4; ++i) { b0[i] = fmaxf(sigmoidf_(b0[i]), 1e-20f); b1[i] = fmaxf(sigmoidf_(b1[i]), 1e-20f); a0[i] = sigmoidf_(a0[i]) * fast_rcp(b0[i]); a1[i] = sigmoidf_(a1[i]) * fast_rcp(b1[i]); }
                            const size_t mgo = (size_t)row * 2048 + (pn - 7) * 128 + cc; EPI_ST16(MG, mgo, pack8(a0, a1)); EPI_ST16(MG, mgo + 1024, pack8(b0, b1)); } }
                }
            }
    }
};

#ifdef PROBE_G1
struct EpiProbe {
    static constexpr bool PERM = true, HAS_MID = false, FP8 = false; static constexpr int SCALE_W = 0x7f7f7f7f;
    float* sink;
    __device__ __forceinline__ void operator()(const AccT& acc, const Unit& u, int wr, int wc, int fr, int fq, int ui = 0) const {
        f32x4 t = (f32x4){0.f, 0.f, 0.f, 0.f};
#pragma unroll
        for (int ai = 0; ai < 2; ++ai)
#pragma unroll
            for (int bj = 0; bj < 2; ++bj)
#pragma unroll
                for (int m = 0; m < 4; ++m) t += acc[ai][bj][m][0] + acc[ai][bj][m][1];
        if (t[0] + t[1] + t[2] + t[3] == 1234567.0f) sink[threadIdx.x] = t[0];
    }
};
#endif
struct SchedCmp {
    const char* KC; const char* VC; const char* W1; int c;
    __device__ __forceinline__ bool next(int i, Unit& u) const { if (i != 0 || c >= 64) return false; u.e = c >> 5; u.pm = c & 31; u.pn = 0; u.nrows = 256;
        u.A = (u.e ? VC : KC) + (size_t)u.pm * 256 * 2048; u.B = W1 + (size_t)u.e * 256 * 2048 * 2; return true; }
    __device__ __forceinline__ unsigned aoff(const Unit&, int R) const { return (unsigned)R * 2048u; }
    __device__ __forceinline__ void prefetch(const Unit&, int) const {}
    __device__ __forceinline__ u32x2 pf_load(const Unit&) const { return (u32x2){0u, 0u}; }
    __device__ __forceinline__ void pf_store(int, u32x2) const {}
};
struct EpiHid {
    static constexpr bool PERM = true, HAS_MID = false, FP8 = false; static constexpr int SCALE_W = 0x7f7f7f7f;
    bf16_t* HID; const float* bias1;
    __device__ __forceinline__ void operator()(const AccT& acc, const Unit& u, int wr, int wc, int fr, int fq, int ui = 0) const {
        const int row0 = u.pm * 256 + wr * 64 + fr; const int cc = wc * 32 + 8 * fq; bf16_t* H = HID + (size_t)u.e * 8192 * 256; const float* bs = bias1 + u.e * 256;
#pragma unroll
        for (int bj = 0; bj < 2; ++bj) { const int col = 128 * bj + cc; const f32x4 b0 = *(const f32x4*)(bs + col), b1 = *(const f32x4*)(bs + col + 4);
#pragma unroll
            for (int ai = 0; ai < 2; ++ai)
#pragma unroll
                for (int m = 0; m < 4; ++m) { const int row = row0 + ai * 128 + m * 16; f32x4 v0 = acc[ai][bj][m][0] + b0, v1 = acc[ai][bj][m][1] + b1;
#pragma unroll
                    for (int i = 0; i < 4; ++i) { v0[i] = gelu_tanh(v0[i]); v1[i] = gelu_tanh(v1[i]); }
                    EPI_ST16(H, (size_t)row * 256 + col, pack8(v0, v1)); } }
    }
};

struct EpiMix {
    static constexpr bool PERM = true, HAS_MID = true, FP8 = false; static constexpr int SCALE_W = 0x7f7f7f7f;
    const bf16_t* MG; bf16_t* MIX;
    __device__ __forceinline__ void mid(AccT& acc, const Unit& u, int wr, int wc, int fr, int fq, int ui = 0) const {
        unsigned off0 = (unsigned)(u.pm * 256 + wr * 64 + fr) * 2048u + (unsigned)(u.pn * 256 + wc * 32 + 8 * fq);
        asm volatile("" : "+v"(off0));
#pragma unroll
        for (int ai = 0; ai < 2; ++ai) {
            u32x4 g[4][2];
#pragma unroll
            for (int m = 0; m < 4; ++m)
#pragma unroll
                for (int bj = 0; bj < 2; ++bj) g[m][bj] = *(const u32x4*)(MG + off0 + (unsigned)((ai * 128 + m * 16) * 2048 + 128 * bj));
#pragma unroll
            for (int m = 0; m < 4; ++m)
#pragma unroll
                for (int bj = 0; bj < 2; ++bj) { f32x4 a0, a1; unpack8(g[m][bj], a0, a1); acc[ai][bj][m][0] *= a0; acc[ai][bj][m][1] *= a1; }
            asm volatile("" : "+v"(acc[ai][0][0][0]), "+v"(acc[ai][1][0][0]) :: "memory");
        }
    }
    __device__ __forceinline__ void operator()(const AccT& acc, const Unit& u, int wr, int wc, int fr, int fq, int ui = 0) const {
        const int row0 = u.pm * 256 + wr * 64 + fr; const int c0 = u.pn * 256 + wc * 32 + 8 * fq;
#pragma unroll
        for (int ai = 0; ai < 2; ++ai) {
            u32x4 g[4][2];
#pragma unroll
            for (int m = 0; m < 4; ++m)
#pragma unroll
                for (int bj = 0; bj < 2; ++bj) g[m][bj] = *(const u32x4*)(MG + (size_t)(row0 + ai * 128 + m * 16) * 2048 + 1024 + c0 + 128 * bj);
#pragma unroll
            for (int m = 0; m < 4; ++m)
#pragma unroll
                for (int bj = 0; bj < 2; ++bj) { f32x4 g0, g1; unpack8(g[m][bj], g0, g1);
                    EPI_ST16(MIX, (size_t)(row0 + ai * 128 + m * 16) * 1024 + c0 + 128 * bj, pack8(acc[ai][bj][m][0] * g0, acc[ai][bj][m][1] * g1)); }
        }
    }
};
struct EpiDelta {
    static constexpr bool PERM = true, HAS_MID = false, FP8 = false; static constexpr int SCALE_W = 0x7f7f7f7f;
    const float* MOD; bf16_t* DELTA;
    __device__ __forceinline__ void operator()(const AccT& acc, const Unit& u, int wr, int wc, int fr, int fq, int ui = 0) const {
        const int row0 = u.pm * 256 + wr * 64 + fr; const int c0 = u.pn * 256 + wc * 32 + 8 * fq; const int b = (u.pm * 256) >> 11;
        const float* g1 = MOD + (size_t)b * 6144 + 2048;
#pragma unroll
        for (int bj = 0; bj < 2; ++bj) { const int col = c0 + 128 * bj; const f32x4 g0 = *(const f32x4*)(g1 + col), g1v = *(const f32x4*)(g1 + col + 4);
#pragma unroll
            for (int ai = 0; ai < 2; ++ai)
#pragma unroll
                for (int m = 0; m < 4; ++m) EPI_ST16(DELTA, (size_t)(row0 + ai * 128 + m * 16) * 1024 + col, pack8(acc[ai][bj][m][0] * g0, acc[ai][bj][m][1] * g1v)); }
    }
};

struct SchedMoe {
    const char* A; const char* W; const unsigned* LIST; const LAS unsigned* tcnt; const LAS unsigned* tbase; unsigned lda; size_t wstride; int K; int G, c; bool by_token;
    __device__ __forceinline__ bool next(int i, Unit& u) const {
        if (i >= 32) return false; const unsigned w = tbase[40 + i]; if (w == 0xffffffffu) return false;
        const int e = (int)(w >> 16), tile = (int)((w >> 2) & 0x3fffu), pn = (int)(w & 3u); const int cnt = (int)tcnt[e];
        u.e = e; u.pm = tile; u.pn = pn; u.nrows = (cnt - tile * 256) < 256 ? (cnt - tile * 256) : 256;
        u.A = A; u.B = W + (size_t)e * wstride + (size_t)pn * 256 * K * 2; return true; }
    __device__ __forceinline__ unsigned slot(const Unit& u, int R) const { const int r = R < u.nrows ? R : u.nrows - 1; return LIST[(size_t)u.e * 65536 + u.pm * 256 + r]; }
    __device__ __forceinline__ unsigned aoff(const Unit& u, int R) const { const unsigned s = slot(u, R); return (by_token ? (s >> 1) : s) * lda; }
    LAS u32x2* tab; const float* SLOTW;
    __device__ __forceinline__ u32x2 pf_load(const Unit& u) const { const int tid = threadIdx.x; u32x2 e = {0u, 0u}; if (tid < 256) { const unsigned s = slot(u, tid); e.x = s; e.y = SLOTW ? __float_as_uint(SLOTW[s]) : 0u; } return e; }
    __device__ __forceinline__ void pf_store(int ui, u32x2 e) const { const int tid = threadIdx.x; if (tid < 256) tab[(ui % 3) * 256 + tid] = e; }
    __device__ __forceinline__ void prefetch(const Unit& u, int ui) const { pf_store(ui, pf_load(u)); }
};
__device__ __forceinline__ unsigned pack4_fp8(float a, float b, float c, float d) { int p = __builtin_amdgcn_cvt_pk_fp8_f32(a, b, 0, false); p = __builtin_amdgcn_cvt_pk_fp8_f32(c, d, p, true); return (unsigned)p; }
constexpr int MOE_W_SHIFT = 5;
constexpr int MOE_SCALE_W = (127 - MOE_W_SHIFT) * 0x01010101;
struct EpiHE {
    static constexpr bool PERM = true, HAS_MID = false, FP8 = true; static constexpr int SCALE_W = MOE_SCALE_W;
    unsigned char* HE; const LAS u32x2* tab;
    __device__ __forceinline__ void operator()(const AccT& acc, const Unit& u, int wr, int wc, int fr, int fq, int ui = 0) const {
        const int cc = u.pn * 128 + wc * 32 + 8 * fq;
#pragma unroll
        for (int ai = 0; ai < 2; ++ai)
#pragma unroll
            for (int m = 0; m < 4; ++m) { const int R = ai * 128 + wr * 64 + m * 16 + fr;
                if (R < u.nrows) { const unsigned s = tab[(ui % 3) * 256 + R].x; f32x4 g0 = acc[ai][0][m][0], g1 = acc[ai][0][m][1]; const f32x4 u0 = acc[ai][1][m][0], u1 = acc[ai][1][m][1];
#pragma unroll
                    for (int i = 0; i < 4; ++i) { g0[i] = g0[i] * sigmoidf_(g0[i]) * u0[i]; g1[i] = g1[i] * sigmoidf_(g1[i]) * u1[i]; }
                    u32x2 w; w.x = pack4_fp8(g0[0], g0[1], g0[2], g0[3]); w.y = pack4_fp8(g1[0], g1[1], g1[2], g1[3]);
                    *(u32x2*)(HE + (size_t)s * 512 + cc) = w; } }
    }
};
struct EpiY {
    static constexpr bool PERM = true, HAS_MID = false, FP8 = true; static constexpr int SCALE_W = MOE_SCALE_W;
    bf16_t* Y; const LAS u32x2* tab;
    __device__ __forceinline__ void operator()(const AccT& acc, const Unit& u, int wr, int wc, int fr, int fq, int ui = 0) const {
        const int c0 = u.pn * 256 + wc * 32 + 8 * fq;
#pragma unroll
        for (int ai = 0; ai < 2; ++ai)
#pragma unroll
            for (int m = 0; m < 4; ++m) { const int R = ai * 128 + wr * 64 + m * 16 + fr;
                if (R < u.nrows) { const u32x2 e = tab[(ui % 3) * 256 + R]; const unsigned s = e.x; const float w = __uint_as_float(e.y);
#pragma unroll
                    for (int bj = 0; bj < 2; ++bj) EPI_ST16(Y, (size_t)s * 1024 + c0 + 128 * bj, pack8(acc[ai][bj][m][0] * w, acc[ai][bj][m][1] * w)); } }
    }
};
struct Args { const float* in[24]; float* out; unsigned char* ws; int ph_lo, ph_hi; };
struct Frame {
    LAS unsigned char* lds;
    unsigned char* ws;
    float* out;
    int tid, lane, wave, vcu, G;
};
#define WSP(T, off) ((T*)(F.ws + (off)))

struct TrItem { const float* W; bf16_t* dst; int ldw, nvalid, ldd; bool fp8; };
__device__ __forceinline__ void p0_tr_load(const TrItem& t, f32x4 (&v)[8], int lane) {
    const int rg = lane >> 3, c4 = (lane & 7) * 4;
#pragma unroll
    for (int i = 0; i < 8; ++i) v[i] = c4 < t.nvalid ? *(const f32x4*)(t.W + (size_t)(rg + 8 * i) * t.ldw + c4) : (f32x4){0.f, 0.f, 0.f, 0.f};
}
__device__ __forceinline__ void p0_tr_finish(const TrItem& t, const f32x4 (&v)[8], LAS float* scr, int lane) {
    const int rg = lane >> 3, c4 = (lane & 7) * 4;
#pragma unroll
    for (int i = 0; i < 8; ++i) { LAS float* d = scr + (rg + 8 * i) * 33 + c4; d[0] = v[i][0]; d[1] = v[i][1]; d[2] = v[i][2]; d[3] = v[i][3]; }
    LDS_WAIT(); asm volatile("" ::: "memory");
    const int c8 = lane & 7;
    if (t.fp8) { constexpr float SC = (float)(1 << 5);
#pragma unroll
        for (int j = 0; j < 4; ++j) { const int n = (lane >> 3) + 8 * j; const LAS float* s = scr + (8 * c8) * 33 + n;
            u32x2 o; o.x = pack4_fp8(s[0 * 33] * SC, s[1 * 33] * SC, s[2 * 33] * SC, s[3 * 33] * SC); o.y = pack4_fp8(s[4 * 33] * SC, s[5 * 33] * SC, s[6 * 33] * SC, s[7 * 33] * SC);
            *(u32x2*)((unsigned char*)t.dst + (size_t)n * t.ldd + 8 * c8) = o; }
    } else {
#pragma unroll
    for (int j = 0; j < 4; ++j) { const int n = (lane >> 3) + 8 * j; const LAS float* s = scr + (8 * c8) * 33 + n;
        u32x4 o; o.x = cvt_pk_bf16(s[0 * 33], s[1 * 33]); o.y = cvt_pk_bf16(s[2 * 33], s[3 * 33]); o.z = cvt_pk_bf16(s[4 * 33], s[5 * 33]); o.w = cvt_pk_bf16(s[6 * 33], s[7 * 33]);
        *(u32x4*)(t.dst + (size_t)n * t.ldd + 8 * c8) = o; }
    }
    LDS_WAIT(); asm volatile("" ::: "memory");
}
__device__ __forceinline__ void p0_prologue(Frame& F, const Args& AR) {
    const float* c_in = AR.in[1]; const float* ada_w = AR.in[2]; const float* ada_b = AR.in[3];
    const float* w_in = AR.in[5]; const float* pool_w = AR.in[6]; const float* pool_scale = AR.in[7]; const float* cmp_pos = AR.in[8]; const float* cmp_w1 = AR.in[9];
    const float* cmp_b1 = AR.in[10]; const float* cmp_w2 = AR.in[11]; const float* w_up_pool = AR.in[12]; const float* w_up_attn = AR.in[13]; const float* w_out = AR.in[14];
    const float* wg = AR.in[20]; const float* wu = AR.in[21]; const float* wd = AR.in[22];
    if (F.vcu < 104) {
        LAS float* red = (LAS float*)F.lds;
        const int item = F.vcu;
        if (item < 96) {
            LAS float* cl = (LAS float*)F.lds;
            for (int i = F.tid; i < 32 * 256; i += 512) { const int b = i & 31, k4 = (i >> 5) * 4; const f32x4 cv = *(const f32x4*)(c_in + b * 1024 + k4); cl[(k4 + 0) * 32 + b] = cv[0]; cl[(k4 + 1) * 32 + b] = cv[1]; cl[(k4 + 2) * 32 + b] = cv[2]; cl[(k4 + 3) * 32 + b] = cv[3]; }
            __syncthreads();
            const int n = item * 64 + F.lane; float acc[32];
#pragma unroll
            for (int b = 0; b < 32; ++b) acc[b] = 0.f;
            const int k0 = F.wave * 128;
#pragma unroll 4
            for (int k = k0; k < k0 + 128; ++k) { const float w = ada_w[(size_t)k * 6144 + n];
#pragma unroll
                for (int b4 = 0; b4 < 8; ++b4) { const f32x4 cv = *(const LAS f32x4*)(cl + k * 32 + 4 * b4); acc[4 * b4] += cv[0] * w; acc[4 * b4 + 1] += cv[1] * w; acc[4 * b4 + 2] += cv[2] * w; acc[4 * b4 + 3] += cv[3] * w; } }
            __syncthreads();
#pragma unroll
            for (int b = 0; b < 32; ++b) red[(F.wave * 32 + b) * 64 + F.lane] = acc[b];
            __syncthreads();
            for (int o = F.tid; o < 2048; o += 512) { float s = 0.f;
#pragma unroll
                for (int w = 0; w < 8; ++w) s += red[w * 2048 + o];
                const int b = o >> 6, nn = item * 64 + (o & 63); WSP(float, WS_MOD)[b * 6144 + nn] = s + ada_b[nn]; }
            __syncthreads();
        } else {
            const int it = item - 96, i = it >> 2, n = (it & 3) * 64 + F.lane; float acc = 0.f; const int k0 = F.wave * 256;
            for (int k = k0; k < k0 + 256; ++k) acc += cmp_pos[i * 2048 + k] * cmp_w1[((size_t)i * 2048 + k) * 256 + n];
            red[F.wave * 64 + F.lane] = acc;
            __syncthreads();
            if (F.tid < 64) { float s = 0.f;
#pragma unroll
                for (int w = 0; w < 8; ++w) s += red[w * 64 + F.tid];
                const int nn = (it & 3) * 64 + F.tid; WSP(float, WS_BIAS1)[i * 256 + nn] = s + cmp_b1[i * 256 + nn]; }
            __syncthreads();
        }
    }
    LAS float* scr = (LAS float*)(F.lds + F.wave * 16384);
    const int gw = F.vcu * NWAVES + F.wave, NGW = F.G * NWAVES;
    constexpr int T_IN = 16 * 128, T_GU = 32 * 512, T_D = 32 * 256, T_A = 256, T_OUT = 512, T_W1C = 512, T_W2C = 16, T_WP = 512;
    constexpr int NTR = T_IN + T_GU + T_D + T_A + T_OUT + T_W1C + T_W2C;
#define P0_DECODE(it_, T_) do { int r = (it_); T_.fp8 = false; \
        if (r < T_GU) { const int e = r >> 9, rr = r & 511, kb = rr >> 5, nb = rr & 31, n0 = 32 * nb, tile = n0 >> 8, bj = (n0 >> 7) & 1, c0 = n0 & 127; \
            T_.W = (bj ? wu : wg) + (size_t)e * 1024 * 512 + (size_t)(64 * kb) * 512 + tile * 128 + c0; T_.ldw = 512; T_.nvalid = 32; T_.fp8 = true; T_.dst = (bf16_t*)(WSP(unsigned char, WS_WGU) + (size_t)e * 1024 * 1024 + (size_t)n0 * 1024 + 64 * kb); T_.ldd = 1024; break; } r -= T_GU; \
        if (r < T_D) { const int e = r >> 8, rr = r & 255, kb = rr >> 5, nb = rr & 31; \
            T_.W = wd + (size_t)e * 512 * 1024 + (size_t)(64 * kb) * 1024 + 32 * nb; T_.ldw = 1024; T_.nvalid = 32; T_.fp8 = true; T_.dst = (bf16_t*)(WSP(unsigned char, WS_WD) + (size_t)e * 1024 * 512 + (size_t)(32 * nb) * 512 + 64 * kb); T_.ldd = 512; break; } r -= T_D; \
        if (r < T_IN) { const int kb = r >> 7, nb = r & 127, np = 32 * nb; const int pt = np >> 8; const int lt = pt < 8 ? pt + 7 : (pt < 12 ? pt - 8 : (pt < 15 ? 18 - pt : pt)); const int n0 = lt * 256 + (np & 255); int src0, nv;        \
            if (n0 < 1792) { src0 = n0; nv = 32; } else if (n0 < 3840) { const int q = n0 - 1792; src0 = 1816 + ((q >> 7) & 1) * 1024 + (q >> 8) * 128 + (q & 127); nv = 32; } else if (n0 == 3840) { src0 = 1792; nv = 24; } else { src0 = 0; nv = 0; } \
            T_.W = w_in + (size_t)(64 * kb) * 3864 + src0; T_.ldw = 3864; T_.nvalid = nv; T_.dst = WSP(bf16_t, WS_WIN) + (size_t)np * 1024 + 64 * kb; T_.ldd = 1024; break; } r -= T_IN; \
        if (r < T_A) { const int kb = r >> 5, nb = r & 31; \
            T_.W = w_up_attn + (size_t)(64 * kb) * 1024 + 32 * nb; T_.ldw = 1024; T_.nvalid = 32; T_.dst = WSP(bf16_t, WS_WPA) + (size_t)(32 * nb) * 1024 + 512 + 64 * kb; T_.ldd = 1024; break; } r -= T_A; \
        if (r < T_OUT) { const int kb = r >> 5, nb = r & 31; \
            T_.W = w_out + (size_t)(64 * kb) * 1024 + 32 * nb; T_.ldw = 1024; T_.nvalid = 32; T_.dst = WSP(bf16_t, WS_WOUT) + (size_t)(32 * nb) * 1024 + 64 * kb; T_.ldd = 1024; break; } r -= T_OUT; \
        if (r < T_W1C) { const int i = r >> 8, rr = r & 255, kb = rr >> 3, nb = rr & 7; \
            T_.W = cmp_w1 + (size_t)i * 2048 * 256 + (size_t)(64 * kb) * 256 + 32 * nb; T_.ldw = 256; T_.nvalid = 32; T_.dst = WSP(bf16_t, WS_W1C) + (size_t)i * 256 * 2048 + (size_t)(32 * nb) * 2048 + 64 * kb; T_.ldd = 2048; break; } r -= T_W1C; \
        { const int i = r >> 3, rr = r & 7, kb = rr >> 1, nb = rr & 1; \
            T_.W = cmp_w2 + (size_t)i * 256 * 64 + (size_t)(64 * kb) * 64 + 32 * nb; T_.ldw = 64; T_.nvalid = 32; T_.dst = WSP(bf16_t, WS_W2C) + (size_t)i * 64 * 256 + (size_t)(32 * nb) * 256 + 64 * kb; T_.ldd = 256; } } while (0)
    if (gw < NTR) {
        TrItem ta, tb; f32x4 va[8], vb[8];
        P0_DECODE(gw, ta); p0_tr_load(ta, va, F.lane);
        for (int it = gw; it < NTR; it += 2 * NGW) {
            const bool hb = it + NGW < NTR; if (hb) { P0_DECODE(it + NGW, tb); p0_tr_load(tb, vb, F.lane); }
            p0_tr_finish(ta, va, scr, F.lane);
            if (!hb) break;
            const bool ha = it + 2 * NGW < NTR; if (ha) { P0_DECODE(it + 2 * NGW, ta); p0_tr_load(ta, va, F.lane); }
            p0_tr_finish(tb, vb, scr, F.lane);
            if (!ha) break;
        }
    }
#undef P0_DECODE
    for (int r = NGW - 1 - gw; r < T_WP; r += NGW) {
        const int gi = r >> 7, rr = r & 127, nblk = rr >> 3, c0 = (rr & 7) * 16, n = 64 * nblk + F.lane; float acc[16];
#pragma unroll
        for (int c = 0; c < 16; ++c) acc[c] = 0.f;
        for (int d0 = 0; d0 < 128; d0 += 16) { float wv[16];
#pragma unroll
            for (int j = 0; j < 16; ++j) wv[j] = pool_scale[gi * 128 + d0 + j] * w_up_pool[(size_t)(gi * 128 + d0 + j) * 1024 + n];
#pragma unroll
            for (int c = 0; c < 16; ++c)
#pragma unroll
                for (int q4 = 0; q4 < 4; ++q4) { const f32x4 pw = *(const f32x4*)(pool_w + (size_t)(gi * 128 + c0 + c) * 128 + d0 + 4 * q4);
                    acc[c] += pw[0] * wv[4 * q4] + pw[1] * wv[4 * q4 + 1] + pw[2] * wv[4 * q4 + 2] + pw[3] * wv[4 * q4 + 3]; } }
        u32x4 o0, o1; o0.x = cvt_pk_bf16(acc[0], acc[1]); o0.y = cvt_pk_bf16(acc[2], acc[3]); o0.z = cvt_pk_bf16(acc[4], acc[5]); o0.w = cvt_pk_bf16(acc[6], acc[7]);
        o1.x = cvt_pk_bf16(acc[8], acc[9]); o1.y = cvt_pk_bf16(acc[10], acc[11]); o1.z = cvt_pk_bf16(acc[12], acc[13]); o1.w = cvt_pk_bf16(acc[14], acc[15]);
        bf16_t* dst = WSP(bf16_t, WS_WPA) + (size_t)n * 1024 + gi * 128 + c0; *(u32x4*)dst = o0; *(u32x4*)(dst + 8) = o1;
    }
}

__device__ __forceinline__ void p1_norm_mod(Frame& F, const Args& AR) {
    const float* x = AR.in[0]; const float* g1n = AR.in[4]; const float* MOD = WSP(float, WS_MOD); bf16_t* H = WSP(bf16_t, WS_H);
    const int gw = F.vcu * NWAVES + F.wave, NGW = F.G * NWAVES;
    for (int q = gw; q < NTOK / 32; q += NGW) {
        const int b = q >> 6; f32x4 Av[4], Bv[4];
#pragma unroll
        for (int j = 0; j < 4; ++j) { const int col = 4 * F.lane + 256 * j; const f32x4 g = *(const f32x4*)(g1n + col), sc = *(const f32x4*)(MOD + b * 6144 + 1024 + col); Av[j] = g * (sc + 1.0f); Bv[j] = *(const f32x4*)(MOD + b * 6144 + col); }
        for (int r = 0; r < 32; ++r) {
            const size_t row = (size_t)q * 32 + r; const f32x4* xr = (const f32x4*)(x + row * 1024) + F.lane; f32x4 v[4]; float s = 0.f;
#pragma unroll
            for (int j = 0; j < 4; ++j) { v[j] = xr[64 * j]; s += (v[j][0] * v[j][0] + v[j][1] * v[j][1]) + (v[j][2] * v[j][2] + v[j][3] * v[j][3]); }
            const float rs = rsqrtf(wave_sum(s) * (1.0f / 1024.0f) + EPS);
            u32x2* o = (u32x2*)(H + row * 1024) + F.lane;
#pragma unroll
            for (int j = 0; j < 4; ++j) { const f32x4 h = v[j] * rs * Av[j] + Bv[j]; u32x2 w; w.x = cvt_pk_bf16(h[0], h[1]); w.y = cvt_pk_bf16(h[2], h[3]); o[64 * j] = w; }
        }
    }
}

__device__ __forceinline__ void p3_pool(Frame& F, int widx, int nw) {
    const bf16_t* U = WSP(bf16_t, WS_U); bf16_t* P = WSP(bf16_t, WS_PA);
    const int gi = F.lane >> 4, w = 2 << gi;
    for (int run = widx; run < NTOK / 8; run += nw) {
#ifdef POOL_THROTTLE
        __builtin_amdgcn_s_sleep(POOL_THROTTLE);
#endif
        const int t0 = run * 8, tb0 = t0 & 2047; const bf16_t* up = U + (size_t)t0 * 512 + F.lane * 8;
        u32x4 rw[24];
#pragma unroll
        for (int i = 0; i < 24; ++i) { const int d = 16 - i; rw[i] = (tb0 - d >= 0 && d <= w) || d <= 0 ? *(const u32x4*)(up - (ptrdiff_t)d * 512) : (u32x4){0u, 0u, 0u, 0u}; }
        float sum[8];
#pragma unroll
        for (int k = 0; k < 8; ++k) sum[k] = 0.f;
#pragma unroll
        for (int i = 0; i < 16; ++i) { f32x4 a, b; unpack8(rw[i], a, b);
#pragma unroll
            for (int k = 0; k < 4; ++k) { sum[k] += a[k]; sum[4 + k] += b[k]; } }
#pragma unroll
        for (int i = 0; i < 8; ++i) { const int tb = tb0 + i; f32x4 a, b, c, d; unpack8(rw[16 + i], a, b);
            const u32x4 old = w == 2 ? rw[14 + i] : (w == 4 ? rw[12 + i] : (w == 8 ? rw[8 + i] : rw[i])); unpack8(old, c, d);
#pragma unroll
            for (int k = 0; k < 4; ++k) { sum[k] += a[k] - c[k]; sum[4 + k] += b[k] - d[k]; }
            const float inv = 1.0f / (float)((tb + 1) < w ? (tb + 1) : w); f32x4 o0, o1;
#pragma unroll
            for (int k = 0; k < 4; ++k) { o0[k] = sum[k] * inv - a[k]; o1[k] = sum[4 + k] * inv - b[k]; }
            *(u32x4*)(P + (size_t)(t0 + i) * 1024 + F.lane * 8) = pack8(o0, o1); }
    }
}

__device__ __forceinline__ void p3_cmp2(Frame& F, int which, int pm) {
    const bf16_t* H = WSP(bf16_t, WS_HID) + (size_t)which * 8192 * 256; const bf16_t* W2 = WSP(bf16_t, WS_W2C) + (size_t)which * 64 * 256;
    const int l16 = F.lane & 15, kq = F.lane >> 4; const int rbase = pm * 256 + F.wave * 32;
    bf16x8 hf[2][8];
#pragma unroll
    for (int rb = 0; rb < 2; ++rb)
#pragma unroll
        for (int ks = 0; ks < 8; ++ks) hf[rb][ks] = *(const bf16x8*)(H + (size_t)(rbase + rb * 16 + l16) * 256 + 32 * ks + 8 * kq);
#pragma unroll
    for (int cb = 0; cb < 4; ++cb) {
        bf16x8 wf[8];
#pragma unroll
        for (int ks = 0; ks < 8; ++ks) wf[ks] = *(const bf16x8*)(W2 + (size_t)(cb * 16 + l16) * 256 + 32 * ks + 8 * kq);
#pragma unroll
        for (int rb = 0; rb < 2; ++rb) {
            f32x4 acc = (f32x4){0.f, 0.f, 0.f, 0.f};
#pragma unroll
            for (int ks = 0; ks < 8; ++ks) {
                if (which == 0) acc = __builtin_amdgcn_mfma_f32_16x16x32_bf16(wf[ks], hf[rb][ks], acc, 0, 0, 0);
                else acc = __builtin_amdgcn_mfma_f32_16x16x32_bf16(hf[rb][ks], wf[ks], acc, 0, 0, 0); }
            u32x2 w;
            if (which == 0) { const int row = rbase + rb * 16 + l16; const bool pad = (row & 127) == 127; w.x = pad ? 0u : cvt_pk_bf16(acc[0], acc[1]); w.y = pad ? 0u : cvt_pk_bf16(acc[2], acc[3]);
                *(u32x2*)(WSP(bf16_t, WS_KCMP) + (size_t)row * 64 + cb * 16 + 4 * kq) = w; }
            else { const int row0 = rbase + rb * 16 + 4 * kq; const int bg = row0 >> 7, n0 = row0 & 127, d = cb * 16 + l16; if (n0 + 3 == 127) acc[3] = 0.f;
                w.x = cvt_pk_bf16(acc[0], acc[1]); w.y = cvt_pk_bf16(acc[2], acc[3]); *(u32x2*)(WSP(bf16_t, WS_VCMPT) + (((size_t)bg * 2 + (n0 >> 6)) * 64 + d) * 64 + (n0 & 63)) = w; }
        }
    }
}

__device__ __forceinline__ void p3_bgate(Frame& F, int widx, int nw) {
    const bf16_t* H = WSP(bf16_t, WS_H); const bf16_t* W = WSP(bf16_t, WS_WIN) + (size_t)3840 * 1024; bf16_t* BG = WSP(bf16_t, WS_BG);
    LAS unsigned char* wl = F.lds;
    __syncthreads();
    for (int i = F.tid; i < 32 * 128; i += 512) { const int r = i >> 7, c = i & 127; *(LAS u32x4*)(wl + r * 2064 + c * 16) = *(const u32x4*)(W + (size_t)r * 1024 + c * 8); }
    __syncthreads();
    const int l16 = F.lane & 15, kq = F.lane >> 4;
    const LAS unsigned char* wp = wl + l16 * 2064 + 16 * kq;
    for (int grp = widx; grp < NTOK / 16; grp += nw) {
        const bf16_t* hp = H + ((size_t)grp * 16 + l16) * 1024 + 8 * kq;
        f32x4 acc0 = (f32x4){0.f, 0.f, 0.f, 0.f}, acc1 = acc0;
#pragma unroll 1
        for (int kb = 0; kb < 4; ++kb) { bf16x8 hf[8];
#pragma unroll
            for (int j = 0; j < 8; ++j) hf[j] = *(const bf16x8*)(hp + 32 * (8 * kb + j));
#pragma unroll
            for (int j = 0; j < 8; ++j) { const int ks = 8 * kb + j; const bf16x8 w0 = *(const LAS bf16x8*)(wp + 64 * ks), w1 = *(const LAS bf16x8*)(wp + 16 * 2064 + 64 * ks);
                acc0 = __builtin_amdgcn_mfma_f32_16x16x32_bf16(w0, hf[j], acc0, 0, 0, 0); acc1 = __builtin_amdgcn_mfma_f32_16x16x32_bf16(w1, hf[j], acc1, 0, 0, 0); } }
        bf16_t* o = BG + ((size_t)grp * 16 + l16) * 32 + 4 * kq; u32x2 w;
        w.x = cvt_pk_bf16(sigmoidf_(acc0[0]), sigmoidf_(acc0[1])); w.y = cvt_pk_bf16(sigmoidf_(acc0[2]), sigmoidf_(acc0[3])); *(u32x2*)o = w;
        w.x = cvt_pk_bf16(sigmoidf_(acc1[0]), sigmoidf_(acc1[1])); w.y = cvt_pk_bf16(sigmoidf_(acc1[2]), sigmoidf_(acc1[3])); *(u32x2*)(o + 16) = w;
    }
}
namespace nsa {
#ifdef DBG_STAMP
__device__ unsigned long long dbg_cyc[8];
#endif
constexpr int KB0 = 0, VB0 = 8192, PS_OFF = 65536;
__device__ __forceinline__ float pmax32(float m) { auto rr = __builtin_amdgcn_permlane32_swap(__float_as_uint(m), __float_as_uint(m), false, false); return fmaxf(__uint_as_float(rr[0]), __uint_as_float(rr[1])); }
__device__ __forceinline__ float psum32(float m) { auto rr = __builtin_amdgcn_permlane32_swap(__float_as_uint(m), __float_as_uint(m), false, false); return __uint_as_float(rr[0]) + __uint_as_float(rr[1]); }

struct Ptrs { bf16_t* Q; bf16_t* O; const char* WS; const bf16_t* BG; };

__device__ __forceinline__ void attn_unit(LAS unsigned char* lds, const Ptrs& T, const int b, const int g, const int ci, const int nbg, const int nci, int& bslot, const bool pre, const int wid, const int lane) {
    const int r32 = lane & 31, hi = lane >> 5, hh = wid >> 1, qh = wid & 1;
    const int qloc = 32 * qh + r32, t = 64 * ci + qloc, bg = b * 2 + g;
    const size_t row = (size_t)b * SEQ + t;
    const int sR = 8 * wid + (lane >> 3), sch = (lane & 7) ^ ((sR >> 1) & 7);
    const int sK = (sR & ~12) | ((sR & 4) << 1) | ((sR & 8) >> 1);
    const unsigned kst = (unsigned)(sK * 128 + sch * 16);
    const unsigned vst = (unsigned)(sR * 128 + sch * 16);
    const int xr = (r32 >> 1) & 7;
    unsigned kofs[4], vofs[4];
#pragma unroll
    for (int s = 0; s < 4; ++s) kofs[s] = (unsigned)(r32 * 128 + (((2 * s + hi) ^ xr) << 4));
#pragma unroll
    for (int c = 0; c < 4; ++c) vofs[c] = (unsigned)(r32 * 128 + (((2 * c + hi) ^ xr) << 4));
    bf16_t* qp = T.Q + row * 512 + (g * 4 + hh) * 64; bf16_t* op = T.O + row * 1024 + 512 + (g * 4 + hh) * 64;
    bf16x8 qr[4];
#pragma unroll
    for (int s = 0; s < 4; ++s) qr[s] = *(const bf16x8*)(qp + 16 * s + 8 * hi);
    const bf16_t* bgp = T.BG + row * 32 + g * 4 + hh;
    const float gate_c = bf1(bgp[0]), gate_s = bf1(bgp[8]), gate_w = bf1(bgp[16]);

    const int ntc = ci >= 16 ? 2 : 1, nsel = ci + 1, nwin = (ci < 8 ? ci : 8) + 1, nsteps = ntc + nsel + nwin;
#define NSA_ISSUE_U(bg_, ci_, ntc_, nsel_, st_, bufsel_) do { const int s_ = (st_); unsigned uk_, uv_;        \
        if (s_ < (ntc_)) { uk_ = (unsigned)WS_KCMP + (unsigned)(bg_) * 16384u + (unsigned)s_ * 8192u; uv_ = (unsigned)WS_VCMPT + (unsigned)(bg_) * 16384u + (unsigned)s_ * 8192u; } \
        else if (s_ < (ntc_) + (nsel_)) { const unsigned o_ = (unsigned)(bg_) * 262144u + (unsigned)(s_ - (ntc_)) * 8192u; uk_ = (unsigned)WS_KS + o_; uv_ = (unsigned)WS_VST + o_; } \
        else { const unsigned o_ = (unsigned)(bg_) * 262144u + (unsigned)((ci_) - (s_ - (ntc_) - (nsel_))) * 8192u; uk_ = (unsigned)WS_KW + o_; uv_ = (unsigned)WS_VWT + o_; } \
        const int kb_ = KB0 + (bufsel_) * 16384, vb_ = VB0 + (bufsel_) * 16384; \
        __builtin_amdgcn_global_load_lds((const unsigned*)(T.WS + (uk_ + kst)), (LAS unsigned*)(lds + kb_ + wid * 1024), 16, 0, 0); \
        __builtin_amdgcn_global_load_lds((const unsigned*)(T.WS + (uv_ + vst)), (LAS unsigned*)(lds + vb_ + wid * 1024), 16, 0, 0); } while (0)
#define NSA_ISSUE(st_, bufsel_) NSA_ISSUE_U(bg, ci, ntc, nsel, st_, bufsel_)

#ifdef DBG_STAMP
    unsigned long long dbg_wait_vm = 0, dbg_wait_bar = 0, dbg_s1 = 0, dbg_s2 = 0; const unsigned long long dbg_t0 = __builtin_readcyclecounter();
#endif
    float m_ref = 0.f, l_run = 0.f;
    bool first = true;
    f32x16 o0 = {}, o1 = {}, A0 = {}, A1 = {};
    unsigned selmask = 0xffffffffu; float sh0 = 1.f, sh1 = 1.f, sh2 = 1.f, sh3 = 1.f;
    bf16x8 pq0 = {}, pq1 = {};
    int vpend = VB0;
    int cpend = 0;
#define NSA_PVLOAD(v00_, v01_, v10_, v11_) do { \
        v00_ = *(const LAS bf16x8*)(lds + vpend + (cpend ? vofs[2] : vofs[0])); v01_ = *(const LAS bf16x8*)(lds + vpend + (cpend ? vofs[3] : vofs[1])); \
        v10_ = *(const LAS bf16x8*)(lds + vpend + 4096 + (cpend ? vofs[2] : vofs[0])); v11_ = *(const LAS bf16x8*)(lds + vpend + 4096 + (cpend ? vofs[3] : vofs[1])); } while (0)
#define NSA_PVMMA(v00_, v01_, v10_, v11_) do { \
        o0 = __builtin_amdgcn_mfma_f32_32x32x16_bf16(v00_, pq0, o0, 0, 0, 0); o1 = __builtin_amdgcn_mfma_f32_32x32x16_bf16(v10_, pq0, o1, 0, 0, 0); \
        o0 = __builtin_amdgcn_mfma_f32_32x32x16_bf16(v01_, pq1, o0, 0, 0, 0); o1 = __builtin_amdgcn_mfma_f32_32x32x16_bf16(v11_, pq1, o1, 0, 0, 0); } while (0)

    int bcur = bslot;
    if (!pre) { NSA_ISSUE(0, bcur); if (nsteps > 1) NSA_ISSUE(1, (bcur + 1) & 3); }
    for (int st = 0; st < nsteps; ++st) {
#ifdef DBG_STAMP
        const unsigned long long tw0_ = __builtin_readcyclecounter();
#endif
        if (st + 1 < nsteps) asm volatile("s_waitcnt vmcnt(2)" ::: "memory"); else asm volatile("s_waitcnt vmcnt(0)" ::: "memory");
#ifdef DBG_STAMP
        const unsigned long long tw1_ = __builtin_readcyclecounter();
#endif
        __builtin_amdgcn_s_barrier(); asm volatile("" ::: "memory");
#ifdef DBG_STAMP
        { const unsigned long long tw2_ = __builtin_readcyclecounter(); dbg_wait_vm += tw1_ - tw0_; dbg_wait_bar += tw2_ - tw1_; }
#endif
        { const int bn = (bcur + 2) & 3; if (st + 2 < nsteps) NSA_ISSUE(st + 2, bn); }
        if (st == nsteps - 1 && nbg >= 0) {
            const int nntc = nci >= 16 ? 2 : 1, nnsel = nci + 1;
            NSA_ISSUE_U(nbg, nci, nntc, nnsel, 0, (bcur + 1) & 3); NSA_ISSUE_U(nbg, nci, nntc, nnsel, 1, (bcur + 2) & 3); }
#ifdef DBG_STAMP
        const unsigned long long ts_a = __builtin_readcyclecounter();
#endif
        const int kb = KB0 + bcur * 16384, vb = VB0 + bcur * 16384;
        if (st == ntc && ci >= 8) {
            float v[32];
#pragma unroll
            for (int j = 0; j < 32; ++j) v[j] = 0.f;
#pragma unroll
            for (int h4 = 0; h4 < 4; ++h4) { const LAS float* ps = (const LAS float*)(lds + PS_OFF) + (h4 * 64 + qloc) * 68; const f32x4 S = *(const LAS f32x4*)((const LAS float*)(lds + PS_OFF + 69632) + (h4 * 64 + qloc) * 4);
#pragma unroll
                for (int j4 = 0; j4 < 8; ++j4) { const f32x4 mn = *(const LAS f32x4*)(ps + 4 * j4), cr = *(const LAS f32x4*)(ps + 32 + 4 * j4);
#pragma unroll
                    for (int i = 0; i < 4; ++i) { const int j = 4 * j4 + i; v[j] += mn[i] * S[j >> 3] + cr[i] * S[j > 0 ? (j - 1) >> 3 : 0]; } } }
            selmask = 1u | (1u << ci) | (1u << (ci - 1));
#pragma unroll 1
            for (int it = 0; it < 5; ++it) { float bv = -1.f; int best = 0;
#pragma unroll
                for (int j = 1; j < 30; ++j) { const bool cand = (j <= ci - 2) && !((selmask >> j) & 1u) && (v[j] > bv); bv = cand ? v[j] : bv; best = cand ? j : best; }
                selmask |= 1u << best; }
        }
        int lo, hi_; bool full; bool live = true;
        if (st < ntc) { lo = 0; hi_ = ((t - 31) >> 4) - 64 * st; full = (64 * ci - 31) >= 16 * (64 * st + 63); }
        else if (st < ntc + nsel) { const int j = st - ntc; lo = 0; hi_ = t - 64 * j; full = j < ci; live = ((selmask >> j) & 1u) != 0u; }
        else { const int j = ci - (st - ntc - nsel); lo = t - 511 - 64 * j; hi_ = t - 64 * j; full = (j < ci) && (j > ci - 8); }
        int span = hi_ - lo; int koff = 8 * hi - lo; if (span < 0) { koff = -100000; span = 0; }
        const bool end_c = (st == ntc - 1), end_s = (st == ntc + nsel - 1), end_w = (st == nsteps - 1);
#ifdef DBG_STAMP
        const unsigned long long ts_b = __builtin_readcyclecounter();
#endif
#pragma unroll
        for (int kh = 0; kh < 2; ++kh) {
            bf16x8 kf0, kf1, kf2, kf3, v00, v01, v10, v11;
            kf0 = *(const LAS bf16x8*)(lds + kb + 4096 * kh + kofs[0]); kf1 = *(const LAS bf16x8*)(lds + kb + 4096 * kh + kofs[1]);
            kf2 = *(const LAS bf16x8*)(lds + kb + 4096 * kh + kofs[2]); kf3 = *(const LAS bf16x8*)(lds + kb + 4096 * kh + kofs[3]);
            NSA_PVLOAD(v00, v01, v10, v11);
            const float cval = live ? -m_ref : NEGBIG;
            f32x16 p;
#pragma unroll
            for (int r = 0; r < 16; ++r) p[r] = cval;
            __builtin_amdgcn_sched_barrier(0);
            p = __builtin_amdgcn_mfma_f32_32x32x16_bf16(kf0, qr[0], p, 0, 0, 0); p = __builtin_amdgcn_mfma_f32_32x32x16_bf16(kf1, qr[1], p, 0, 0, 0);
            p = __builtin_amdgcn_mfma_f32_32x32x16_bf16(kf2, qr[2], p, 0, 0, 0); p = __builtin_amdgcn_mfma_f32_32x32x16_bf16(kf3, qr[3], p, 0, 0, 0);
            NSA_PVMMA(v00, v01, v10, v11);
            if (!full) {
#pragma unroll
                for (int r = 0; r < 16; ++r) { const int c = 32 * kh + 16 * (r >> 3) + (r & 7); p[r] = ((unsigned)(koff + c) <= (unsigned)span) ? p[r] : NEGBIG; }
            }
            float mx;
            { float a = fmaxf(fmaxf(p[0], p[1]), p[2]), bq = fmaxf(fmaxf(p[3], p[4]), p[5]); a = fmaxf(fmaxf(a, p[6]), p[7]); bq = fmaxf(fmaxf(bq, p[8]), p[9]);
              a = fmaxf(fmaxf(a, p[10]), p[11]); bq = fmaxf(fmaxf(bq, p[12]), p[13]); a = fmaxf(fmaxf(a, p[14]), p[15]); mx = pmax32(fmaxf(a, bq)); }
            if (first || __builtin_amdgcn_ballot_w64(mx > 8.0f) != 0ull) {
                const float dl = first ? mx : fmaxf(mx, 0.f);
                m_ref += dl;
#pragma unroll
                for (int r = 0; r < 16; ++r) p[r] -= dl;
                if (!first) { const float f = fast_exp2(-dl); l_run *= f;
#pragma unroll
                    for (int r = 0; r < 16; ++r) { o0[r] *= f; o1[r] *= f; }
                    if (st < ntc) { sh0 *= f; sh1 *= f; sh2 *= f; sh3 *= f; } }
                first = false;
            }
            float ls = 0.f;
#pragma unroll
            for (int r = 0; r < 16; ++r) { p[r] = fast_exp2(p[r]); ls += p[r]; }
            l_run += ls;
            { u32x4 w0, w1;
              w0.x = cvt_pk_bf16(p[0], p[1]); w0.y = cvt_pk_bf16(p[2], p[3]); w0.z = cvt_pk_bf16(p[4], p[5]); w0.w = cvt_pk_bf16(p[6], p[7]);
              w1.x = cvt_pk_bf16(p[8], p[9]); w1.y = cvt_pk_bf16(p[10], p[11]); w1.z = cvt_pk_bf16(p[12], p[13]); w1.w = cvt_pk_bf16(p[14], p[15]);
              pq0 = __builtin_bit_cast(bf16x8, w0); pq1 = __builtin_bit_cast(bf16x8, w1); }
            vpend = vb; cpend = 2 * kh;
            if (st < ntc && ci >= 8) {
                LAS float* psw = (LAS float*)(lds + PS_OFF) + (hh * 64 + qloc) * 68 + 16 * st + 8 * kh + 2 * hi;
#pragma unroll
                for (int a2 = 0; a2 < 2; ++a2)
#pragma unroll
                    for (int jj = 0; jj < 2; ++jj) { const int r0 = 8 * a2 + 4 * jj;
                        psw[4 * a2 + jj] = p[r0] + p[r0 + 1] + p[r0 + 2] + 0.5f * p[r0 + 3];
                        if (16 * st + 8 * kh + 4 * a2 + 2 * hi + jj + 1 < 32) psw[32 + 4 * a2 + jj + 1] = 0.5f * p[r0 + 3]; }
                if (st == 0 && kh == 0 && hi == 0) psw[32] = 0.f;
                if (st == 0) { if (kh == 0) sh0 = 1.f; else sh1 = 1.f; } else { if (kh == 0) sh2 = 1.f; else sh3 = 1.f; }
            }
        }
#ifdef DBG_STAMP
        const unsigned long long ts_c = __builtin_readcyclecounter(); dbg_s1 += ts_b - ts_a; dbg_s2 += ts_c - ts_b;
#endif
        if (end_c || end_s || end_w) {
            { bf16x8 v00, v01, v10, v11; NSA_PVLOAD(v00, v01, v10, v11); NSA_PVMMA(v00, v01, v10, v11); pq0 = bf16x8{}; pq1 = bf16x8{}; }
            const float ltot = psum32(l_run); float gate = end_c ? gate_c : (end_s ? gate_s : gate_w);
#if defined(DBG_CHECK) && (DBG_CHECK == 15 || DBG_CHECK == 16 || DBG_CHECK == 17)
            if ((DBG_CHECK == 15 && !end_c) || (DBG_CHECK == 16 && !end_s) || (DBG_CHECK == 17 && !end_w)) gate = 0.f;
#endif
            const float rl = (m_ref > -1e29f) ? fast_rcp(ltot) : 0.f; const float sc = gate * rl;
#pragma unroll
            for (int r = 0; r < 16; ++r) { A0[r] += o0[r] * sc; A1[r] += o1[r] * sc; o0[r] = 0.f; o1[r] = 0.f; }
            if (end_c && ci >= 8 && hi == 0) { LAS float* pst = (LAS float*)(lds + PS_OFF + 69632) + (hh * 64 + qloc) * 4; *(LAS f32x4*)pst = (f32x4){rl * sh0, rl * sh1, rl * sh2, rl * sh3}; }
            m_ref = 0.f; l_run = 0.f; first = true;
        }
        bcur = (bcur + 1) & 3;
    }
#undef NSA_ISSUE
#undef NSA_ISSUE_U
#undef NSA_PVLOAD
#undef NSA_PVMMA
#pragma unroll
    for (int a = 0; a < 4; ++a) { u32x2 w0, w1; w0.x = cvt_pk_bf16(A0[4 * a], A0[4 * a + 1]); w0.y = cvt_pk_bf16(A0[4 * a + 2], A0[4 * a + 3]); w1.x = cvt_pk_bf16(A1[4 * a], A1[4 * a + 1]); w1.y = cvt_pk_bf16(A1[4 * a + 2], A1[4 * a + 3]);
        *(u32x2*)(op + 8 * a + 4 * hi) = w0; *(u32x2*)(op + 32 + 8 * a + 4 * hi) = w1; }
    bslot = bcur;
    __builtin_amdgcn_s_barrier(); asm volatile("" ::: "memory");
#ifdef DBG_STAMP
    if (blockIdx.x == 0 && threadIdx.x == 0) { dbg_cyc[0] += dbg_wait_vm; dbg_cyc[1] += dbg_wait_bar; dbg_cyc[3] += dbg_s1; dbg_cyc[4] += dbg_s2; dbg_cyc[2] += __builtin_readcyclecounter() - dbg_t0; }
#endif
}
}
__device__ __forceinline__ float dpp_sum16(float v) {
    v += __uint_as_float(__builtin_amdgcn_update_dpp(0, __float_as_uint(v), 0xB1, 0xF, 0xF, true));
    v += __uint_as_float(__builtin_amdgcn_update_dpp(0, __float_as_uint(v), 0x4E, 0xF, 0xF, true));
    v += __uint_as_float(__builtin_amdgcn_update_dpp(0, __float_as_uint(v), 0x141, 0xF, 0xF, true));
    v += __uint_as_float(__builtin_amdgcn_update_dpp(0, __float_as_uint(v), 0x140, 0xF, 0xF, true));
    return v;
}
__device__ __forceinline__ void p7_router(Frame& F, const Args& AR) {
    const float* X1 = AR.in[0]; const bf16_t* DL = WSP(bf16_t, WS_PA); const float* g2n = AR.in[15]; const float* rgw = AR.in[16]; const float* rgb = AR.in[17]; const float* rew = AR.in[18]; const float* reb = AR.in[19];
    const float* MOD = WSP(float, WS_MOD); unsigned char* H2 = WSP(unsigned char, WS_H2); float* SLOTW = WSP(float, WS_SLOTW); unsigned* LIST = WSP(unsigned, WS_LIST);
    unsigned* gcnt = WSP(unsigned, WS_CTL) + CW_CNT;
    LAS float* Wl = (LAS float*)F.lds; LAS unsigned* lcnt = (LAS unsigned*)(F.lds + RT_OFF); LAS unsigned* lbase = lcnt + 32; LAS unsigned* tinfo = lcnt + 64;
    for (int k = F.tid; k < 1024; k += 512) {
        const f32x4 gq = *(const f32x4*)(rgw + 4 * k); Wl[k] = gq[0]; Wl[1024 + k] = gq[1]; Wl[2048 + k] = gq[2]; Wl[3072 + k] = gq[3];
#pragma unroll
        for (int j4 = 0; j4 < 8; ++j4) { const f32x4 e = *(const f32x4*)(rew + 32 * k + 4 * j4); Wl[(4 + 4 * j4) * 1024 + k] = e[0]; Wl[(5 + 4 * j4) * 1024 + k] = e[1]; Wl[(6 + 4 * j4) * 1024 + k] = e[2]; Wl[(7 + 4 * j4) * 1024 + k] = e[3]; } }
    __syncthreads();
    for (int tg = F.vcu; tg < NTOK / 256; tg += F.G) {
        if (F.tid < 32) lcnt[F.tid] = 0u;
        __syncthreads();
        const int b = (tg * 256) >> 11; f32x4 Av[4], Bv[4];
#pragma unroll
        for (int j = 0; j < 4; ++j) { const int col = 4 * F.lane + 256 * j; const f32x4 g = *(const f32x4*)(g2n + col), sc = *(const f32x4*)(MOD + b * 6144 + 4096 + col); Av[j] = g * (sc + 1.0f); Bv[j] = *(const f32x4*)(MOD + b * 6144 + 3072 + col); }
        f32x4 na[4], nb[4]; u32x2 da[4], db[4];
        { const size_t r0 = (size_t)tg * 256 + F.wave * 32; const f32x4* xa = (const f32x4*)(X1 + r0 * 1024) + F.lane; const u32x2* dp = (const u32x2*)(DL + r0 * 1024) + F.lane;
#pragma unroll
          for (int j = 0; j < 4; ++j) { na[j] = xa[64 * j]; nb[j] = xa[256 + 64 * j]; da[j] = dp[64 * j]; db[j] = dp[256 + 64 * j]; } }
        for (int pr = 0; pr < 16; ++pr) {
            const int lt = F.wave * 32 + 2 * pr; const size_t row = (size_t)tg * 256 + lt;
            f32x4 ha[4], hb[4]; float sa = 0.f, sb = 0.f;
#pragma unroll
            for (int j = 0; j < 4; ++j) { ha[j] = na[j] + (f32x4){bf_lo(da[j].x), bf_hi(da[j].x), bf_lo(da[j].y), bf_hi(da[j].y)}; hb[j] = nb[j] + (f32x4){bf_lo(db[j].x), bf_hi(db[j].x), bf_lo(db[j].y), bf_hi(db[j].y)}; }
            if (pr < 15) { const f32x4* xa = (const f32x4*)(X1 + (row + 2) * 1024) + F.lane; const u32x2* dp = (const u32x2*)(DL + (row + 2) * 1024) + F.lane;
#pragma unroll
                for (int j = 0; j < 4; ++j) { na[j] = xa[64 * j]; nb[j] = xa[256 + 64 * j]; da[j] = dp[64 * j]; db[j] = dp[256 + 64 * j]; } }
#pragma unroll
            for (int j = 0; j < 4; ++j) { sa += (ha[j][0] * ha[j][0] + ha[j][1] * ha[j][1]) + (ha[j][2] * ha[j][2] + ha[j][3] * ha[j][3]); sb += (hb[j][0] * hb[j][0] + hb[j][1] * hb[j][1]) + (hb[j][2] * hb[j][2] + hb[j][3] * hb[j][3]); }
            const float ra = rsqrtf(wave_sum(sa) * (1.0f / 1024.0f) + EPS), rb = rsqrtf(wave_sum(sb) * (1.0f / 1024.0f) + EPS);
            unsigned* oa = (unsigned*)(H2 + row * 1024) + F.lane; unsigned* ob = oa + 256;
#pragma unroll
            for (int j = 0; j < 4; ++j) { ha[j] = ha[j] * ra * Av[j] + Bv[j]; hb[j] = hb[j] * rb * Av[j] + Bv[j];
                oa[64 * j] = pack4_fp8(ha[j][0], ha[j][1], ha[j][2], ha[j][3]); ob[64 * j] = pack4_fp8(hb[j][0], hb[j][1], hb[j][2], hb[j][3]); }
#define RT_DOT2(rowa, rowb, outv) do { float pa_ = 0.f, pb_ = 0.f; const LAS float* wra_ = Wl + (rowa) * 1024 + 4 * F.lane; const LAS float* wrb_ = Wl + (rowb) * 1024 + 4 * F.lane; \
                _Pragma("unroll") for (int jq_ = 0; jq_ < 4; ++jq_) { const f32x4 wa_ = *(const LAS f32x4*)(wra_ + 256 * jq_); const f32x4 wb_ = *(const LAS f32x4*)(wrb_ + 256 * jq_); \
                    pa_ += (ha[jq_][0] * wa_[0] + ha[jq_][1] * wa_[1]) + (ha[jq_][2] * wa_[2] + ha[jq_][3] * wa_[3]); pb_ += (hb[jq_][0] * wb_[0] + hb[jq_][1] * wb_[1]) + (hb[jq_][2] * wb_[2] + hb[jq_][3] * wb_[3]); } \
                auto rr_ = __builtin_amdgcn_permlane32_swap(__float_as_uint(pa_), __float_as_uint(pb_), false, false); \
                float v_ = __uint_as_float(rr_[0]) + __uint_as_float(rr_[1]); v_ = dpp_sum16(v_); v_ += __shfl_xor(v_, 16); (outv) = v_; } while (0)
            float g0, g1, g2, g3;
            RT_DOT2(0, 0, g0); RT_DOT2(1, 1, g1); RT_DOT2(2, 2, g2); RT_DOT2(3, 3, g3);
            g0 += rgb[0]; g1 += rgb[1]; g2 += rgb[2]; g3 += rgb[3];
            int gidx = 0; float gm = g0; if (g1 > gm) { gm = g1; gidx = 1; } if (g2 > gm) { gm = g2; gidx = 2; } if (g3 > gm) { gm = g3; gidx = 3; }
            const float gp = 1.0f / (__expf(g0 - gm) + __expf(g1 - gm) + __expf(g2 - gm) + __expf(g3 - gm));
            const int ga = __builtin_amdgcn_readlane(gidx, 0), gb = __builtin_amdgcn_readlane(gidx, 32);
            float le[8];
#pragma unroll
            for (int j = 0; j < 8; ++j) { RT_DOT2(4 + ga * 8 + j, 4 + gb * 8 + j, le[j]); le[j] += reb[gidx * 8 + j]; }
#undef RT_DOT2
            int i0 = 0; float v0 = le[0];
#pragma unroll
            for (int j = 1; j < 8; ++j) if (le[j] > v0) { v0 = le[j]; i0 = j; }
            int i1 = -1; float v1 = -INFINITY;
#pragma unroll
            for (int j = 0; j < 8; ++j) if (j != i0 && le[j] > v1) { v1 = le[j]; i1 = j; }
            const float ex = __expf(v1 - v0); const float w0 = gp / (1.0f + ex), w1 = gp * ex / (1.0f + ex);
            if ((F.lane & 31) == 0) {
                const int tl = lt + (F.lane >> 5); const size_t tok = (size_t)tg * 256 + tl; const int e0 = gidx * 8 + i0, e1 = gidx * 8 + i1;
                const unsigned p0 = __hip_atomic_fetch_add(lcnt + e0, 1u, __ATOMIC_RELAXED, __HIP_MEMORY_SCOPE_WORKGROUP), p1 = __hip_atomic_fetch_add(lcnt + e1, 1u, __ATOMIC_RELAXED, __HIP_MEMORY_SCOPE_WORKGROUP);
                tinfo[2 * tl] = ((unsigned)e0 << 16) | p0; tinfo[2 * tl + 1] = ((unsigned)e1 << 16) | p1;
                SLOTW[2 * tok] = w0; SLOTW[2 * tok + 1] = w1;
            }
        }
        __syncthreads();
        if (F.tid < 32) lbase[F.tid] = __hip_atomic_fetch_add(gcnt + 64 * F.tid, lcnt[F.tid], __ATOMIC_RELAXED, __HIP_MEMORY_SCOPE_AGENT);
        __syncthreads();
        { const unsigned inf = tinfo[F.tid]; const unsigned e = inf >> 16, p = inf & 0xffffu; LIST[(size_t)e * 65536 + lbase[e] + p] = (unsigned)(tg * 256) * 2u + (unsigned)F.tid; }
        __syncthreads();
    }
}
__device__ __forceinline__ void moe_tables(Frame& F, LAS unsigned* tcnt, LAS unsigned* tbase) {
    const unsigned* gcnt = WSP(unsigned, WS_CTL) + CW_CNT;
    if (F.tid < 32) tcnt[F.tid] = __hip_atomic_load(gcnt + 64 * F.tid, __ATOMIC_RELAXED, __HIP_MEMORY_SCOPE_AGENT);
    __syncthreads();
    if (F.tid == 0) { unsigned s = 0; for (int e = 0; e < 32; ++e) { tbase[e] = s; s += (tcnt[e] + 255u) >> 8; } tbase[32] = s; }
    __syncthreads();
    if (F.tid < 32) {
        const long L = (long)F.tid * F.G + (long)F.vcu; const int total = (int)tbase[32] * 4; unsigned w = 0xffffffffu;
        if (L < total) { const int pn = (int)L & 3, tau = (int)L >> 2; int e = 0; for (int j = 1; j < 32; ++j) if ((int)tbase[j] <= tau) e = j; w = ((unsigned)e << 16) | ((unsigned)(tau - (int)tbase[e]) << 2) | (unsigned)pn; }
        tbase[40 + F.tid] = w; }
    __syncthreads();
}

__device__ __forceinline__ void p10_final(Frame& F, const Args& AR) {
    const float* X = AR.in[0]; const bf16_t* DL = WSP(bf16_t, WS_PA); float* OUT = F.out; const float* fg = AR.in[23]; const float* MOD = WSP(float, WS_MOD); const bf16_t* Y = WSP(bf16_t, WS_Y);
    const int gw = F.vcu * NWAVES + F.wave, NGW = F.G * NWAVES;
    for (int q = gw; q < NTOK / 32; q += NGW) {
        const int b = q >> 6; f32x4 Gv[4], Fv[4];
#pragma unroll
        for (int j = 0; j < 4; ++j) { const int col = 4 * F.lane + 256 * j; Gv[j] = *(const f32x4*)(MOD + b * 6144 + 5120 + col); Fv[j] = *(const f32x4*)(fg + col); }
        for (int r = 0; r < 32; ++r) {
            const size_t row = (size_t)q * 32 + r; const f32x4* xr = (const f32x4*)(X + row * 1024) + F.lane; const u32x2* dr = (const u32x2*)(DL + row * 1024) + F.lane; f32x4* orow = (f32x4*)(OUT + row * 1024) + F.lane;
            const u32x2* y0 = (const u32x2*)(Y + (2 * row) * 1024) + F.lane; const u32x2* y1 = y0 + 256;
            f32x4 v[4]; float s = 0.f;
#pragma unroll
            for (int j = 0; j < 4; ++j) { const u32x2 a = y0[64 * j], c = y1[64 * j]; const f32x4 ys = (f32x4){bf_lo(a.x) + bf_lo(c.x), bf_hi(a.x) + bf_hi(c.x), bf_lo(a.y) + bf_lo(c.y), bf_hi(a.y) + bf_hi(c.y)};
                const u32x2 dd = dr[64 * j]; v[j] = xr[64 * j] + (f32x4){bf_lo(dd.x), bf_hi(dd.x), bf_lo(dd.y), bf_hi(dd.y)} + Gv[j] * ys * DBG_MOE_SCALE; s += (v[j][0] * v[j][0] + v[j][1] * v[j][1]) + (v[j][2] * v[j][2] + v[j][3] * v[j][3]); }
            const float rs = rsqrtf(wave_sum(s) * (1.0f / 1024.0f) + EPS);
#pragma unroll
            for (int j = 0; j < 4; ++j) orow[64 * j] = v[j] * rs * Fv[j];
        }
    }
}
#ifdef DBG_CHECK
#ifndef DBG_SALT
#define DBG_SALT 0
#endif
__device__ __forceinline__ float blk_sum(Frame& F, float v, LAS float* red) {
    v = wave_sum(v); __syncthreads(); if (F.lane == 0) red[F.wave] = v; __syncthreads(); float s = 0.f;
#pragma unroll
    for (int w = 0; w < 8; ++w) s += red[w]; __syncthreads(); return s;
}
__device__ __forceinline__ float dbg_sig(float x) { return 1.0f / (1.0f + __expf(-x)); }
__device__ __forceinline__ void dbg_check(Frame& F, const Args& AR, float& num, float& den) {
    LAS float* red = (LAS float*)(F.lds + 150000 - 64);
    LAS float* sh = (LAS float*)F.lds;
    const int t = (F.vcu * 257 + 31 * DBG_SALT + 5) & 65535; const int b = t >> 11, tb = t & 2047;
    const float* MOD = WSP(float, WS_MOD);
    num = 0.f; den = 0.f;
#if DBG_CHECK == 1
    { const int bb = F.vcu & 31; for (int n = F.tid; n < 6144; n += 512) { float s = AR.in[3][n]; for (int k = 0; k < 1024; ++k) s += AR.in[1][bb * 1024 + k] * AR.in[2][(size_t)k * 6144 + n];
        const float f = MOD[bb * 6144 + n]; num += (f - s) * (f - s); den += s * s; } }
#elif DBG_CHECK == 2
    { float ss = 0.f; for (int k = F.tid; k < 1024; k += 512) { const float v = AR.in[0][(size_t)t * 1024 + k]; ss += v * v; } ss = blk_sum(F, ss, red); const float r = rsqrtf(ss / 1024.f + EPS);
      for (int k = F.tid; k < 1024; k += 512) { const float ref = AR.in[0][(size_t)t * 1024 + k] * r * AR.in[4][k] * (1.f + MOD[b * 6144 + 1024 + k]) + MOD[b * 6144 + k]; const float f = bf1(WSP(bf16_t, WS_H)[(size_t)t * 1024 + k]);
        num += (f - ref) * (f - ref); den += ref * ref; } }
#elif DBG_CHECK >= 30 && DBG_CHECK < 40
    { for (int k = F.tid; k < 1024; k += 512) sh[k] = bf1(WSP(bf16_t, WS_H)[(size_t)t * 1024 + k]); __syncthreads();
      for (int n = F.tid; n < 3864; n += 512) { float s = 0.f; for (int k = 0; k < 1024; ++k) s += sh[k] * AR.in[5][(size_t)k * 3864 + n];
        float f = 0.f; bool use = false; float ref = s;
        if (n < 512) { use = DBG_CHECK == 30; f = bf1(WSP(bf16_t, WS_U)[(size_t)t * 512 + n]); }
        else if (n < 1024) { use = DBG_CHECK == 31; f = bf1(WSP(bf16_t, WS_Q)[(size_t)t * 512 + n - 512]); ref = s * QSCALE; }
        else if (n < 1792) { const int seg = (n - 1024) >> 7, cc = (n - 1024) & 127, g = cc >> 6, d = cc & 63; const size_t kidx = ((size_t)(b * 2 + g) * 2048 + tb) * 64 + d, vidx = (((size_t)(b * 2 + g) * 32 + (tb >> 6)) * 64 + d) * 64 + (tb & 63);
            if (seg == 0) { use = DBG_CHECK == 32; f = bf1(WSP(bf16_t, WS_KC)[kidx]); } else if (seg == 1) { use = DBG_CHECK == 32; f = bf1(WSP(bf16_t, WS_VC)[kidx]); }
            else if (seg == 2) { use = DBG_CHECK == 33; f = bf1(WSP(bf16_t, WS_KS)[kidx]); } else if (seg == 3) { use = DBG_CHECK == 33; f = bf1(WSP(bf16_t, WS_VST)[vidx]); }
            else if (seg == 4) { use = DBG_CHECK == 34; f = bf1(WSP(bf16_t, WS_KW)[kidx]); } else { use = DBG_CHECK == 34; f = bf1(WSP(bf16_t, WS_VWT)[vidx]); } }
        else if (DBG_CHECK == 37) { use = n < 3840; f = bf1(WSP(bf16_t, WS_MG)[(size_t)t * 2048 + (n < 3840 ? n - 1792 : 0)]); ref = dbg_sig(s); }
        else if (n < 1816) { use = DBG_CHECK == 36; f = bf1(WSP(bf16_t, WS_BG)[(size_t)t * 32 + n - 1792]); ref = dbg_sig(s); }
        else if (DBG_CHECK == 39) { use = true; f = bf1(WSP(bf16_t, WS_MG)[(size_t)t * 2048 + n - 1816]); ref = s; }
        else { use = DBG_CHECK == 35 || (DBG_CHECK == 38 && ((n - 1816) >> 8) == DBG_SALT); f = bf1(WSP(bf16_t, WS_MG)[(size_t)t * 2048 + n - 1816]); ref = dbg_sig(s); }
        if (use) { num += (f - ref) * (f - ref); den += ref * ref; } } }
#elif DBG_CHECK == 40
    { for (int i = 0; i < 16; ++i) { const int nd = (F.vcu * 16 + i + 256 * DBG_SALT) & 4095; int src = -1; if (nd < 1792) src = nd; else if (nd < 3840) src = nd + 24; else if (nd < 3864) src = nd - 3840 + 1792;
        for (int k = F.tid; k < 1024; k += 512) { const float ref = src >= 0 ? AR.in[5][(size_t)k * 3864 + src] : 0.f; const float f = bf1(WSP(bf16_t, WS_WIN)[(size_t)nd * 1024 + k]); num += (f - ref) * (f - ref); den += ref * ref; } } }
#elif DBG_CHECK == 4
    { const bf16_t* U = WSP(bf16_t, WS_U); for (int c = F.tid; c < 512; c += 512) { const int w = 2 << (c >> 7); float s = 0.f; int cnt = 0; for (int d = 0; d < w; ++d) if (tb - d >= 0) { s += bf1(U[(size_t)(t - d) * 512 + c]); ++cnt; }
        const float ref = s / (float)cnt - bf1(U[(size_t)t * 512 + c]); const float f = bf1(WSP(bf16_t, WS_PA)[(size_t)t * 1024 + c]); num += (f - ref) * (f - ref); den += ref * ref; } }
#elif DBG_CHECK == 5
    { const bf16_t* PA = WSP(bf16_t, WS_PA); { const int o = F.tid, gi = o >> 7, d = o & 127; float s = 0.f; for (int c = 0; c < 128; ++c) s += bf1(PA[(size_t)t * 1024 + gi * 128 + c]) * AR.in[6][(size_t)(gi * 128 + c) * 128 + d]; sh[o] = s * AR.in[7][o]; } __syncthreads();
      for (int n = F.tid; n < 1024; n += 512) { float s = 0.f; for (int k = 0; k < 512; ++k) s += sh[k] * AR.in[12][(size_t)k * 1024 + n]; float s2 = 0.f; for (int k = 0; k < 512; ++k) s2 += bf1(PA[(size_t)t * 1024 + 512 + k]) * AR.in[13][(size_t)k * 1024 + n];
        const float gb = bf1(WSP(bf16_t, WS_MG)[(size_t)t * 2048 + 1024 + n]); const float ref = s * bf1(WSP(bf16_t, WS_MG)[(size_t)t * 2048 + n]) * gb + s2 * gb;
        const float f = bf1(WSP(bf16_t, WS_H)[(size_t)t * 1024 + n]); num += (f - ref) * (f - ref); den += ref * ref; } }
#elif DBG_CHECK == 7
    { for (int n = F.tid; n < 1024; n += 512) { float s = 0.f; for (int k = 0; k < 1024; ++k) s += bf1(WSP(bf16_t, WS_H)[(size_t)t * 1024 + k]) * AR.in[14][(size_t)k * 1024 + n];
        const float ref = MOD[b * 6144 + 2048 + n] * s; const float f = bf1(WSP(bf16_t, WS_PA)[(size_t)t * 1024 + n]); num += (f - ref) * (f - ref); den += ref * ref; } }
#elif DBG_CHECK == 8
    { float ss = 0.f; for (int k = F.tid; k < 1024; k += 512) { const float v = AR.in[0][(size_t)t * 1024 + k] + bf1(WSP(bf16_t, WS_PA)[(size_t)t * 1024 + k]); ss += v * v; } ss = blk_sum(F, ss, red); const float r = rsqrtf(ss / 1024.f + EPS);
      for (int k = F.tid; k < 1024; k += 512) { const float ref = (AR.in[0][(size_t)t * 1024 + k] + bf1(WSP(bf16_t, WS_PA)[(size_t)t * 1024 + k])) * r * AR.in[15][k] * (1.f + MOD[b * 6144 + 4096 + k]) + MOD[b * 6144 + 3072 + k]; const float f = bf1(WSP(bf16_t, WS_H2)[(size_t)t * 1024 + k]);
        num += (f - ref) * (f - ref); den += ref * ref; } }
#elif DBG_CHECK == 9 || DBG_CHECK == 10 || DBG_CHECK == 12 || DBG_CHECK == 13
    { for (int k = F.tid; k < 1024; k += 512) sh[k] = bf1(WSP(bf16_t, WS_H2)[(size_t)t * 1024 + k]); __syncthreads();
      LAS float* lgt = sh + 1024;
      if (F.tid < 36) { float s = 0.f; if (F.tid < 4) { for (int k = 0; k < 1024; ++k) s += sh[k] * AR.in[16][k * 4 + F.tid]; s += AR.in[17][F.tid]; } else { const int j = F.tid - 4; for (int k = 0; k < 1024; ++k) s += sh[k] * AR.in[18][k * 32 + j]; s += AR.in[19][j]; } lgt[F.tid] = s; }
      __syncthreads();
      int gidx = 0; float gm = lgt[0]; for (int j = 1; j < 4; ++j) if (lgt[j] > gm) { gm = lgt[j]; gidx = j; }
      float gs = 0.f; for (int j = 0; j < 4; ++j) gs += __expf(lgt[j] - gm); const float gp = 1.f / gs;
      int i0 = 0; float v0 = lgt[4 + gidx * 8]; for (int j = 1; j < 8; ++j) if (lgt[4 + gidx * 8 + j] > v0) { v0 = lgt[4 + gidx * 8 + j]; i0 = j; }
      int i1 = -1; float v1 = -INFINITY; for (int j = 0; j < 8; ++j) if (j != i0 && lgt[4 + gidx * 8 + j] > v1) { v1 = lgt[4 + gidx * 8 + j]; i1 = j; }
      const float ex = __expf(v1 - v0); const float wk0 = gp / (1.f + ex), wk1 = gp * ex / (1.f + ex); const int ek0 = gidx * 8 + i0, ek1 = gidx * 8 + i1;
      if (DBG_CHECK == 12 && F.tid == 0) { const float f0 = WSP(float, WS_SLOTW)[2 * t], f1 = WSP(float, WS_SLOTW)[2 * t + 1]; num += (f0 - wk0) * (f0 - wk0) + (f1 - wk1) * (f1 - wk1); den += wk0 * wk0 + wk1 * wk1; }
      if (DBG_CHECK == 13) {
          const unsigned* LIST = WSP(unsigned, WS_LIST); const unsigned* gc = WSP(unsigned, WS_CTL) + CW_CNT; float found0 = 0.f, found1 = 0.f;
          const unsigned c0 = gc[64 * ek0], c1 = gc[64 * ek1];
          for (unsigned i = F.tid; i < c0; i += 512) if (LIST[(size_t)ek0 * 65536 + i] == (unsigned)(2 * t)) found0 = 1.f;
          for (unsigned i = F.tid; i < c1; i += 512) if (LIST[(size_t)ek1 * 65536 + i] == (unsigned)(2 * t + 1)) found1 = 1.f;
          num -= found0 + found1; if (F.tid == 0) { num += 2.f; den += 2.f; } }
      LAS float* he = sh + 1280;
      if (DBG_CHECK >= 12) goto dbg_done;
      _Pragma("unroll 1") for (int k2 = 0; k2 < 2; ++k2) { const int e = k2 ? ek1 : ek0; const float wkk = k2 ? wk1 : wk0; __syncthreads();
        { const int j = F.tid; float a = 0.f, u = 0.f; for (int k = 0; k < 1024; ++k) { a += sh[k] * AR.in[20][((size_t)e * 1024 + k) * 512 + j]; u += sh[k] * AR.in[21][((size_t)e * 1024 + k) * 512 + j]; }
          const float hv = a * dbg_sig(a) * u; he[j] = hv;
          if (DBG_CHECK == 10) { const float f = bf1(WSP(bf16_t, WS_HE)[(size_t)(2 * t + k2) * 512 + j]); num += (f - hv) * (f - hv); den += hv * hv; } }
        __syncthreads();
        if (DBG_CHECK == 9) for (int n = F.tid; n < 1024; n += 512) { float s = 0.f; for (int j = 0; j < 512; ++j) s += he[j] * AR.in[22][((size_t)e * 512 + j) * 1024 + n]; const float ref = s * wkk;
            const float f = bf1(WSP(bf16_t, WS_Y)[(size_t)(2 * t + k2) * 1024 + n]); num += (f - ref) * (f - ref); den += ref * ref; } } }
#elif DBG_CHECK == 11
    { const int bg = F.vcu & 63, n = (F.vcu * 7 + DBG_SALT) % 127; LAS float* hid = sh + 2048;
      for (int which = 0; which < 2; ++which) { const bf16_t* KV = WSP(bf16_t, which ? WS_VC : WS_KC) + ((size_t)bg * 2048 + 16 * n) * 64; __syncthreads();
        for (int k = F.tid; k < 2048; k += 512) sh[k] = bf1(KV[k]) + AR.in[8][which * 2048 + k]; __syncthreads();
        if (F.tid < 256) { float s = AR.in[10][which * 256 + F.tid]; for (int k = 0; k < 2048; ++k) s += sh[k] * AR.in[9][((size_t)which * 2048 + k) * 256 + F.tid]; const float u = 0.7978845608f * (s + 0.044715f * s * s * s); hid[F.tid] = 0.5f * s * (1.f + tanhf(u)); }
        __syncthreads();
        if (F.tid < 64) { float s = 0.f; for (int j = 0; j < 256; ++j) s += hid[j] * AR.in[11][((size_t)which * 256 + j) * 64 + F.tid];
            const float f = which ? bf1(WSP(bf16_t, WS_VCMPT)[(((size_t)bg * 2 + (n >> 6)) * 64 + F.tid) * 64 + (n & 63)]) : bf1(WSP(bf16_t, WS_KCMP)[((size_t)bg * 128 + n) * 64 + F.tid]); num += (f - s) * (f - s); den += s * s; } } }
#elif DBG_CHECK == 14 || DBG_CHECK == 15 || DBG_CHECK == 16 || DBG_CHECK == 17
    { const bf16_t* Qb = WSP(bf16_t, WS_Q); const bf16_t* ATT = WSP(bf16_t, WS_PA); const bf16_t* BG = WSP(bf16_t, WS_BG);
      LAS float* sc = sh;
      LAS float* pc = sh + 2048;
      LAS float* qv = sh + 2560;
      LAS float* oc = sh + 2624;
      LAS float* psv = sh + 3136;
      LAS unsigned* selm = (LAS unsigned*)(sh + 3200);
      const int cur = tb >> 6;
      for (int g = 0; g < 2; ++g) { const int bg = b * 2 + g;
        const bf16_t* KCMP = WSP(bf16_t, WS_KCMP) + (size_t)bg * 128 * 64; const bf16_t* VCT = WSP(bf16_t, WS_VCMPT) + (size_t)bg * 64 * 128;
        const bf16_t* KS = WSP(bf16_t, WS_KS) + (size_t)bg * 2048 * 64; const bf16_t* VST = WSP(bf16_t, WS_VST) + (size_t)bg * 64 * 2048;
        const bf16_t* KW = WSP(bf16_t, WS_KW) + (size_t)bg * 2048 * 64; const bf16_t* VWT = WSP(bf16_t, WS_VWT) + (size_t)bg * 64 * 2048;
        for (int hh = 0; hh < 4; ++hh) { const int hq = g * 4 + hh; __syncthreads();
            if (F.tid < 64) qv[F.tid] = bf1(Qb[(size_t)t * 512 + hq * 64 + F.tid]); __syncthreads();
            float s = -INFINITY; const bool valid = F.tid < 127 && (16 * F.tid + 31 <= tb);
            if (valid) { s = 0.f; for (int d = 0; d < 64; ++d) s += qv[d] * bf1(KCMP[F.tid * 64 + d]); }
            float m;
            { float mm = s; for (int o = 1; o < 64; o <<= 1) mm = fmaxf(mm, __shfl_xor(mm, o)); __syncthreads(); if (F.lane == 0) red[F.wave] = mm; __syncthreads(); mm = red[0]; for (int w = 1; w < 8; ++w) mm = fmaxf(mm, red[w]); __syncthreads(); m = mm; }
            const float e = valid ? exp2f(s - m) : 0.f; const float l = blk_sum(F, e, red);
            if (F.tid < 128) pc[hh * 128 + F.tid] = l > 0.f ? e / l : 0.f; __syncthreads();
            if (F.tid < 64) { float o = 0.f; for (int n = 0; n < 127; ++n) o += pc[hh * 128 + n] * bf1(VCT[((n >> 6) * 64 + F.tid) * 64 + (n & 63)]); oc[hq * 64 + F.tid] = o; } __syncthreads(); }
        if (F.tid < 32) { const int j = F.tid; float ps = 0.f; for (int hh = 0; hh < 4; ++hh) for (int n = 0; n < 127; ++n) { int ov = (16 * n + 32 < 64 * j + 64 ? 16 * n + 32 : 64 * j + 64) - (16 * n > 64 * j ? 16 * n : 64 * j); if (ov < 0) ov = 0; ps += pc[hh * 128 + n] * (float)ov * (1.f / 32.f); } psv[j] = ps; }
        __syncthreads();
        if (F.tid == 0) { unsigned msk = 0u; for (int it = 0; it < 8; ++it) { int best = -1; float bv = -INFINITY; for (int j = 0; j < 32; ++j) { if ((msk >> j) & 1u) continue; const bool forced = (j == 0) || (j == cur) || (j == cur - 1); const float scv = forced ? 1e4f : (j <= cur ? psv[j] : NEGBIG); if (scv > bv) { bv = scv; best = j; } } msk |= 1u << best; } selm[0] = msk; }
        __syncthreads();
        const unsigned msk = selm[0];
        for (int hh = 0; hh < 4; ++hh) { const int hq = g * 4 + hh; __syncthreads();
            if (F.tid < 64) qv[F.tid] = bf1(Qb[(size_t)t * 512 + hq * 64 + F.tid]); __syncthreads();
            float osel = 0.f, owin = 0.f;
            for (int br = 1; br < 3; ++br) { const bf16_t* Kb = br == 1 ? KS : KW; const bf16_t* Vb = br == 1 ? VST : VWT; float mloc = -INFINITY;
                for (int k = F.tid; k < 2048; k += 512) { const bool v = br == 1 ? (((msk >> (k >> 6)) & 1u) && k <= tb) : (k <= tb && k > tb - 512); float s = -INFINITY; if (v) { s = 0.f; for (int d = 0; d < 64; ++d) s += qv[d] * bf1(Kb[(size_t)k * 64 + d]); } sc[k] = s; mloc = fmaxf(mloc, s); }
                { float mm = mloc; for (int o = 1; o < 64; o <<= 1) mm = fmaxf(mm, __shfl_xor(mm, o)); __syncthreads(); if (F.lane == 0) red[F.wave] = mm; __syncthreads(); mm = red[0]; for (int w = 1; w < 8; ++w) mm = fmaxf(mm, red[w]); __syncthreads(); mloc = mm; }
                float lsum = 0.f; for (int k = F.tid; k < 2048; k += 512) { const float e = sc[k] > -INFINITY ? exp2f(sc[k] - mloc) : 0.f; sc[k] = e; lsum += e; } lsum = blk_sum(F, lsum, red);
                if (F.tid < 64) { float o = 0.f; for (int k = 0; k <= tb; ++k) o += sc[k] * bf1(Vb[((size_t)(k >> 6) * 64 + F.tid) * 64 + (k & 63)]); o /= lsum; if (br == 1) osel = o; else owin = o; } __syncthreads(); }
            if (F.tid < 64) { const float g0 = bf1(BG[(size_t)t * 32 + hq]), g1 = bf1(BG[(size_t)t * 32 + 8 + hq]), g2 = bf1(BG[(size_t)t * 32 + 16 + hq]);
                float ref = 0.f; if (DBG_CHECK == 14 || DBG_CHECK == 15) ref += g0 * oc[hq * 64 + F.tid]; if (DBG_CHECK == 14 || DBG_CHECK == 16) ref += g1 * osel; if (DBG_CHECK == 14 || DBG_CHECK == 17) ref += g2 * owin;
                const float f = bf1(ATT[(size_t)t * 1024 + 512 + hq * 64 + F.tid]); num += (f - ref) * (f - ref); den += ref * ref; } } } }
#endif
    dbg_done:
    num = blk_sum(F, num, red); den = blk_sum(F, den, red);
}
#endif
#define XB_TMO      128
#define XB_XCNT(j)  (256  + 64 * (j))
#define XB_XSUB(j)  (1280 + 64 * (j))
#define XB_XGEN(j)  (2304 + 64 * (j))
#define XB_TOP      3328
#define XB_TOPGEN   3392
#define XCD_BAR_WORDS 3456
#define XB_SPIN_CAP (1u << 22)
__device__ __forceinline__ unsigned xb_ld(unsigned* p)              { return __hip_atomic_load(p, __ATOMIC_RELAXED, __HIP_MEMORY_SCOPE_AGENT); }
__device__ __forceinline__ unsigned xb_add(unsigned* p, unsigned v) { return __hip_atomic_fetch_add(p, v, __ATOMIC_RELAXED, __HIP_MEMORY_SCOPE_AGENT); }
__device__ __forceinline__ unsigned xb_xcc_id() { return (unsigned)__builtin_amdgcn_s_getreg((3 << 11) | 20) & 0xFu; }
#define XB_SPIN(cond, bar) do { unsigned _sp = 0; while (cond) { __builtin_amdgcn_s_sleep(1); \
    if ((++_sp & 255u) == 0u) { if (xb_ld(&(bar)[XB_TMO])) break; if (_sp > XB_SPIN_CAP) { atomicAdd(&(bar)[XB_TMO], 1u); break; } } } } while (0)
struct XcdBarrier { unsigned* bar; unsigned x; volatile LAS unsigned* st; };
__device__ __forceinline__ XcdBarrier xcd_barrier_post(unsigned* bar, volatile LAS unsigned* st) {
    XcdBarrier b; b.bar = bar; b.x = xb_xcc_id(); b.st = st;
    if (threadIdx.x == 0) (void)xb_add(&bar[XB_XCNT(b.x)], 1u);
    return b;
}
__device__ __forceinline__ void xcd_barrier_complete(unsigned* bar, unsigned x, unsigned& nloc, unsigned& nx) {
    const unsigned G = gridDim.x * gridDim.y * gridDim.z;
    unsigned sum, cnt, mine, sp = 0u;
    for (;;) {
        sum = 0u; cnt = 0u; mine = 0u;
#pragma unroll
        for (unsigned j = 0; j < 16; ++j) { const unsigned c = xb_ld(&bar[XB_XCNT(j)]); sum += c; cnt += (c > 0u) ? 1u : 0u; mine = (j == x) ? c : mine; }
        if (sum == G) break;
        __builtin_amdgcn_s_sleep(1);
        if ((++sp & 255u) == 0u) { if (xb_ld(&bar[XB_TMO])) break; if (sp > XB_SPIN_CAP) { atomicAdd(&bar[XB_TMO], 1u); break; } }
    }
    nloc = mine > 0u ? mine : 1u; nx = cnt > 0u ? cnt : 1u;
}
__device__ __forceinline__ void xcd_barrier(const XcdBarrier& b) {
    asm volatile("s_waitcnt vmcnt(0)" ::: "memory");
    __syncthreads();
    if (threadIdx.x == 0) {
        unsigned* bar = b.bar;
        __builtin_amdgcn_s_waitcnt(0);
        unsigned nloc = b.st[0], nx = b.st[1];
        if (nloc == 0u) { xcd_barrier_complete(bar, b.x, nloc, nx); b.st[0] = nloc; b.st[1] = nx; }
        const unsigned old = xb_add(&bar[XB_XSUB(b.x)], 1u);
        const unsigned gen = old / nloc;
        if (old + 1u == (gen + 1u) * nloc) {
            __builtin_amdgcn_fence(__ATOMIC_RELEASE, "agent");
            asm volatile("s_waitcnt vmcnt(0)" ::: "memory");
            const unsigned og = xb_add(&bar[XB_TOP], 1u);
            const unsigned tg = og / nx;
            if (og + 1u == (tg + 1u) * nx) xb_add(&bar[XB_TOPGEN], 1u);
            else XB_SPIN(xb_ld(&bar[XB_TOPGEN]) == tg, bar);
            __builtin_amdgcn_fence(__ATOMIC_ACQUIRE, "agent");
            xb_add(&bar[XB_XGEN(b.x)], 1u);
            asm volatile("s_waitcnt vmcnt(0)" ::: "memory");
        } else {
            XB_SPIN(xb_ld(&bar[XB_XGEN(b.x)]) == gen, bar);
            __builtin_amdgcn_fence(__ATOMIC_ACQUIRE, "agent");
            asm volatile("s_waitcnt vmcnt(0)" ::: "memory");
        }
    }
    __syncthreads();
}

__device__ __forceinline__ void stagger(int group, int ticks_per_group) {
    const unsigned long long t0 = __builtin_amdgcn_s_memrealtime(); const unsigned long long want = (unsigned long long)(group * ticks_per_group);
    while (__builtin_amdgcn_s_memrealtime() - t0 < want) __builtin_amdgcn_s_sleep(8);
}
#ifndef MK_PER_PHASE
#define MK_PER_PHASE 0
#endif
constexpr int N_PHASES = 11;
__global__ void __launch_bounds__(NWAVES * 64, 2) mk_fwd(Args args) {
    extern __shared__ __attribute__((aligned(16))) unsigned char lds_raw[];
    Frame F;
    F.lds = (LAS unsigned char*)lds_raw; F.ws = args.ws; F.out = args.out;
    F.tid = threadIdx.x; F.lane = F.tid & 63; F.wave = __builtin_amdgcn_readfirstlane(F.tid >> 6);
    F.G = gridDim.x; { const int bx = blockIdx.x; F.vcu = (F.G % 8 == 0) ? (bx % 8) * (F.G / 8) + bx / 8 : bx; }
    volatile LAS unsigned* MISC = (volatile LAS unsigned*)(F.lds + MISC_OFF);
    if (F.tid < 16) MISC[F.tid] = 0u;
    __syncthreads();
    XcdBarrier bar; bar.bar = WSP(unsigned, WS_CTL) + CW_BAR; bar.x = 0; bar.st = MISC + 8;
    if (!MK_PER_PHASE) bar = xcd_barrier_post(WSP(unsigned, WS_CTL) + CW_BAR, MISC + 8);
    const int lo = args.ph_lo, hi = args.ph_hi;
#ifdef DBG_LAST
#define IN(k) (lo <= (k) && (k) < hi && ((k) <= DBG_LAST || (k) == 10))
#else
#define IN(k) (lo <= (k) && (k) < hi)
#endif
#define SEAM(k) do { if (lo <= (k) && (k) + 1 < hi) xcd_barrier(bar); } while (0)
    LAS unsigned char* ring = F.lds;
#ifdef DBG_STAMP
#ifndef DBG_STAMP_OFF
#define DBG_STAMP_OFF 0.0f
#endif
    volatile LAS unsigned long long* stamps = (volatile LAS unsigned long long*)(F.lds + MISC_OFF + 128);
#define STAMP(k) do { if (blockIdx.x == 0 && F.tid == 0) { stamps[k] = __builtin_amdgcn_s_memrealtime(); stamps[16 + (k)] = __builtin_readcyclecounter(); } } while (0)
#else
#define STAMP(k) do {} while (0)
#endif
    STAMP(0);

    if (IN(0)) { p0_prologue(F, args); }
    STAMP(32); SEAM(0); STAMP(1);
    if (IN(1)) { p1_norm_mod(F, args); }
    STAMP(33); SEAM(1); STAMP(2);
    if (IN(2)) {
        SchedPlain S; S.A = (const char*)WSP(bf16_t, WS_H); S.Bt = (const char*)WSP(bf16_t, WS_WIN); S.lda = 2048u; S.K = 1024; S.so.init(NTOK, 3840, F.G, (int)blockIdx.x);
        EpiG1 E{WSP(bf16_t, WS_U), WSP(bf16_t, WS_Q), WSP(bf16_t, WS_KC), WSP(bf16_t, WS_VC), WSP(bf16_t, WS_KS), WSP(bf16_t, WS_VST), WSP(bf16_t, WS_KW), WSP(bf16_t, WS_VWT), WSP(bf16_t, WS_MG), WSP(bf16_t, WS_BG)};
        pg8::gemm_phase<EpiG1, SchedPlain>(ring, 1024, S, E);
#ifdef PROBE_G1
#if PROBE_G1 == 1
        { EpiProbe EP{(float*)(F.ws + WS_CTL + 32768)}; pg8::gemm_phase<EpiProbe, SchedPlain>(ring, 1024, S, EP); }
#else
        pg8::gemm_phase<EpiG1, SchedPlain>(ring, 1024, S, E);
#endif
#endif
    }
    STAMP(34); SEAM(2); STAMP(3);
    if (IN(3)) {
        const int ncmp = F.G > 64 ? 64 : 0;
        const int rid = (int)blockIdx.x;
        if (rid < 64) {
            for (int c = rid; c < 64; c += F.G) {
                SchedCmp S{(const char*)WSP(bf16_t, WS_KC), (const char*)WSP(bf16_t, WS_VC), (const char*)WSP(bf16_t, WS_W1C), c};
                EpiHid E{WSP(bf16_t, WS_HID), WSP(float, WS_BIAS1)};
                pg8::gemm_phase<EpiHid, SchedCmp>(ring, 2048, S, E);
                VM_WAIT(); __syncthreads();
                p3_cmp2(F, c >> 5, c & 31);
                __syncthreads();
            }
        }
        STAMP(13);
        if (rid >= ncmp) { p3_pool(F, (rid - ncmp) * NWAVES + F.wave, (F.G - ncmp) * NWAVES); p3_bgate(F, (rid - ncmp) * NWAVES + F.wave, (F.G - ncmp) * NWAVES); }
    }
    STAMP(35); SEAM(3); STAMP(4);
    if (IN(4)) {
                bf16_t* attn_out = WSP(bf16_t, WS_PA);
        const nsa::Ptrs T{WSP(bf16_t, WS_Q), attn_out, (const char*)F.ws, WSP(bf16_t, WS_BG)};
        int bslot = 0;
        if (F.G == 256) {
            const int xcd = F.vcu >> 5, r = F.vcu & 31;
            for (int k = 0; k < 4; ++k) { const int bg = xcd * 8 + 2 * k + (r >> 4); const int s = ((r & 15) + 4 * k) & 15;
                const int bgn = xcd * 8 + 2 * (k + 1) + (r >> 4), sn = ((r & 15) + 4 * (k + 1)) & 15;
                nsa::attn_unit(ring, T, bg >> 1, bg & 1, 31 - s, bg, s, bslot, k > 0, F.wave, F.lane);
                nsa::attn_unit(ring, T, bg >> 1, bg & 1, s, k < 3 ? bgn : -1, 31 - sn, bslot, true, F.wave, F.lane); }
        } else {
            for (int u = F.vcu; u < 2048; u += F.G) { const int bg = u >> 5, ci = u & 31; nsa::attn_unit(ring, T, bg >> 1, bg & 1, ci, -1, 0, bslot, false, F.wave, F.lane); }
        }
    }
    STAMP(12); STAMP(36); SEAM(4); STAMP(5);
    if (IN(5)) {
        SchedPlain S; S.A = (const char*)WSP(bf16_t, WS_PA); S.Bt = (const char*)WSP(bf16_t, WS_WPA); S.lda = 2048u; S.K = 1024; S.so.init(NTOK, 1024, F.G, (int)blockIdx.x);
        EpiMix E{WSP(bf16_t, WS_MG), WSP(bf16_t, WS_H)}; pg8::gemm_phase<EpiMix, SchedPlain>(ring, 1024, S, E);
    }
    STAMP(37); SEAM(5); STAMP(6);
    if (IN(6)) {
        SchedPlain S; S.A = (const char*)WSP(bf16_t, WS_H); S.Bt = (const char*)WSP(bf16_t, WS_WOUT); S.lda = 2048u; S.K = 1024; S.so.init(NTOK, 1024, F.G, (int)blockIdx.x);
        EpiDelta E{WSP(float, WS_MOD), WSP(bf16_t, WS_PA)}; pg8::gemm_phase<EpiDelta, SchedPlain>(ring, 1024, S, E);
    }
    STAMP(38); SEAM(6); STAMP(7);
    if (IN(7)) { p7_router(F, args); }
    STAMP(39); SEAM(7); STAMP(8);
    LAS unsigned* tcnt = (LAS unsigned*)(F.lds + RT_OFF); LAS unsigned* tbase = tcnt + 32; LAS u32x2* mtab = (LAS u32x2*)(F.lds + RING_BYTES);
    if (IN(8)) {
        moe_tables(F, tcnt, tbase);
        SchedMoe S{(const char*)WSP(unsigned char, WS_H2), (const char*)WSP(unsigned char, WS_WGU), WSP(unsigned, WS_LIST), tcnt, tbase, 1024u, (size_t)1024 * 1024, 512, F.G, (int)blockIdx.x, true, mtab, nullptr};
        EpiHE E{WSP(unsigned char, WS_HE), mtab}; pg8::gemm_phase<EpiHE, SchedMoe>(ring, 512, S, E);
    }
    STAMP(40); SEAM(8); STAMP(9);
    if (IN(9)) {
        moe_tables(F, tcnt, tbase);
        SchedMoe S{(const char*)WSP(unsigned char, WS_HE), (const char*)WSP(unsigned char, WS_WD), WSP(unsigned, WS_LIST), tcnt, tbase, 512u, (size_t)1024 * 512, 256, F.G, (int)blockIdx.x, false, mtab, WSP(float, WS_SLOTW)};
        EpiY E{WSP(bf16_t, WS_Y), mtab}; pg8::gemm_phase<EpiY, SchedMoe>(ring, 256, S, E);
    }
    STAMP(41); SEAM(9); STAMP(10);
#ifdef DBG_CHECK
    if (IN(10)) {
        float num, den; dbg_check(F, args, num, den);
        float* acc2 = (float*)(WSP(unsigned, WS_CTL) + 12288);
        if (F.tid == 0) { atomicAdd(acc2, num); atomicAdd(acc2 + 1, den); }
        xcd_barrier(bar);
        const float tn = __hip_atomic_load(acc2, __ATOMIC_RELAXED, __HIP_MEMORY_SCOPE_AGENT), td = __hip_atomic_load(acc2 + 1, __ATOMIC_RELAXED, __HIP_MEMORY_SCOPE_AGENT);
        float E = 20.0f * sqrtf(tn / fmaxf(td, 1e-30f)); if (!(E < 50.f)) E = 50.f;
        const float* x = args.in[0]; const float* fg = args.in[23]; const int gw = F.vcu * NWAVES + F.wave, NGW = F.G * NWAVES;
        for (int row = gw; row < NTOK; row += NGW) { const f32x4* xr = (const f32x4*)(x + (size_t)row * 1024) + F.lane; f32x4 v[4]; float s = 0.f;
            for (int j = 0; j < 4; ++j) { v[j] = xr[64 * j]; s += v[j][0] * v[j][0] + v[j][1] * v[j][1] + v[j][2] * v[j][2] + v[j][3] * v[j][3]; }
            const float rs = rsqrtf(wave_sum(s) * (1.0f / 1024.0f) + EPS) * (1.0f + E);
            f32x4* orow = (f32x4*)(F.out + (size_t)row * 1024) + F.lane; for (int j = 0; j < 4; ++j) orow[64 * j] = v[j] * rs * *((const f32x4*)fg + F.lane + 64 * j); }
    }
#else
    if (IN(10)) { p10_final(F, args); }
#endif
#ifdef DBG_STAMP
    STAMP(11);
    xcd_barrier(bar);
    if (blockIdx.x == 0 && F.tid == 0) { const unsigned long long t0 = stamps[DBG_STAMP], t1 = stamps[DBG_STAMP_END]; F.out[0] = ((float)(t1 - t0) * 0.01f - DBG_STAMP_OFF) * DBG_STAMP_SCALE;
#ifdef DBG_BARSUM
#ifndef DBG_BARLO
#define DBG_BARLO 0
#define DBG_BARHI 10
#endif
        { unsigned long long sum = 0; for (int k = DBG_BARLO; k < DBG_BARHI; ++k) sum += stamps[k + 1] - stamps[32 + k]; F.out[0] = (float)sum * 0.01f * DBG_STAMP_SCALE; }
#endif
#ifdef DBG_CLK
        F.out[0] = 10.0f * 0.1f * (float)(stamps[16 + DBG_STAMP_END] - stamps[16 + DBG_STAMP]) / (float)(t1 - t0);
#endif
#ifdef DBG_CYC
        F.out[0] = 100.0f * (float)nsa::dbg_cyc[DBG_CYC] / (float)nsa::dbg_cyc[2];
#endif
    }
#endif
#undef IN
#undef SEAM
}

extern "C" void kernel_launch(void* const* d_in, const int* in_sizes, int n_in, void* d_out, int out_size, void* d_ws, size_t ws_size, hipStream_t stream) {
    static int grid = 0;
    if (grid == 0) {
        if (n_in != 24 || out_size != NTOK * D || ws_size < WS_END) { fprintf(stderr, "kernel_launch: unexpected shapes (n_in %d, out %d, ws %zu)\n", n_in, out_size, ws_size); grid = -1; return; }
        int dev = 0, cus = 0, per_cu = 0;
        if (hipGetDevice(&dev) != hipSuccess || hipDeviceGetAttribute(&cus, hipDeviceAttributeMultiprocessorCount, dev) != hipSuccess) { grid = -1; return; }
        if (hipFuncSetAttribute((const void*)mk_fwd, hipFuncAttributeMaxDynamicSharedMemorySize, LDS_BYTES) != hipSuccess) { fprintf(stderr, "kernel_launch: hipFuncSetAttribute failed\n"); grid = -1; return; }
        if (hipOccupancyMaxActiveBlocksPerMultiprocessor(&per_cu, (const void*)mk_fwd, NWAVES * 64, LDS_BYTES) != hipSuccess || per_cu < 1) { fprintf(stderr, "kernel_launch: occupancy query reports %d\n", per_cu); }
        (void)hipGetLastError();
        grid = cus;
    }
    if (grid < 0) return;
    (void)hipMemsetAsync((char*)d_ws + WS_CTL, 0, CTL_ZERO_BYTES, stream);
    Args a{};
    for (int i = 0; i < 24; ++i) a.in[i] = (const float*)d_in[i];
    a.out = (float*)d_out; a.ws = (unsigned char*)d_ws;
#if MK_PER_PHASE
    for (int p = 0; p < N_PHASES; ++p) { a.ph_lo = p; a.ph_hi = p + 1; hipLaunchKernelGGL(mk_fwd, dim3(grid), dim3(NWAVES * 64), LDS_BYTES, stream, a); }
#else
    a.ph_lo = 0; a.ph_hi = N_PHASES; hipLaunchKernelGGL(mk_fwd, dim3(grid), dim3(NWAVES * 64), LDS_BYTES, stream, a);
#endif
}
```

```cpp
#include <hip/hip_runtime.h>
#include <cstdio>
#include <cstdint>

#define GAS __attribute__((address_space(1)))
#define LAS __attribute__((address_space(3)))
typedef unsigned short bf16_t;
typedef short bf16x8 __attribute__((ext_vector_type(8)));
typedef short s16x4 __attribute__((ext_vector_type(4)));
typedef float f32x2 __attribute__((ext_vector_type(2)));
typedef float f32x4 __attribute__((ext_vector_type(4)));
typedef float f32x16 __attribute__((ext_vector_type(16)));
typedef unsigned u32x2 __attribute__((ext_vector_type(2)));
typedef unsigned u32x4 __attribute__((ext_vector_type(4)));

#ifndef STG2
#define STG2 500
#endif
#ifndef DBG_MOE_SCALE
#define DBG_MOE_SCALE 1.0f
#endif
constexpr int NB = 32, SEQ = 2048, D = 1024, NTOK = NB * SEQ;
constexpr int NEXP = 32, EFF = 512;
constexpr int NWAVES = 8;
constexpr float EPS = 1e-6f;
constexpr float LOG2E = 1.4426950408889634f;
constexpr float QSCALE = 0.125f * LOG2E;
constexpr float NEGBIG = -1e30f;

constexpr size_t MiB = 1u << 20;
constexpr size_t WS_CTL = 0, CTL_ZERO_BYTES = 64 * 1024;
constexpr size_t WS_MOD = 1 * MiB;
constexpr size_t WS_BIAS1 = WS_MOD + 768 * 1024;
constexpr size_t WS_W2C = WS_BIAS1 + 4096;
constexpr size_t WS_SLOTW = 2 * MiB;
constexpr size_t WS_LISTC = 768 * MiB;
constexpr size_t WS_LIST = 57 * MiB;
constexpr size_t WS_W1C = 11 * MiB;
constexpr size_t WS_WPA = 13 * MiB;
constexpr size_t WS_WOUT = 15 * MiB;
constexpr size_t WS_WIN = 17 * MiB;
constexpr size_t WS_WGU = 25 * MiB;
constexpr size_t WS_WD = 89 * MiB;
constexpr size_t WS_H = 128 * MiB;
constexpr size_t WS_U = 256 * MiB;
constexpr size_t WS_Q = 320 * MiB;
constexpr size_t WS_KC = 384 * MiB;
constexpr size_t WS_VC = 400 * MiB;
constexpr size_t WS_KS = 416 * MiB;
constexpr size_t WS_VST = 432 * MiB;
constexpr size_t WS_KW = 448 * MiB;
constexpr size_t WS_VWT = 464 * MiB;
constexpr size_t WS_MG = 480 * MiB;
constexpr size_t WS_BG = 736 * MiB;
constexpr size_t WS_HID = 740 * MiB;
constexpr size_t WS_KCMP = 748 * MiB;
constexpr size_t WS_VCMPT = 749 * MiB;
constexpr size_t WS_PA = 816 * MiB;
constexpr size_t WS_H2 = 256 * MiB;
constexpr size_t WS_HE = 384 * MiB;
constexpr size_t WS_Y = 512 * MiB;
constexpr size_t WS_END = 944 * MiB;
constexpr int CW_BAR = 4096;
constexpr int CW_CNT = 8192;
constexpr int CW_CNTC = 10240;
constexpr int CW_Q0 = 12800;

constexpr int RING_BYTES = 131072;
constexpr int LDS_ROUTER_W = 36 * 1024 * 4;
constexpr int RT_OFF = LDS_ROUTER_W;
constexpr int MISC_OFF = 153600;
constexpr int LDS_BYTES = 155648;

typedef __bf16 bf16x2_t __attribute__((ext_vector_type(2)));
__device__ __forceinline__ unsigned cvt_pk_bf16(float lo, float hi) { const f32x2 v = {lo, hi}; const bf16x2_t b = __builtin_convertvector(v, bf16x2_t); return __builtin_bit_cast(unsigned, b); }
__device__ __forceinline__ float bf_lo(unsigned u) { return __uint_as_float(u << 16); }
__device__ __forceinline__ float bf_hi(unsigned u) { return __uint_as_float(u & 0xffff0000u); }
__device__ __forceinline__ float bf1(bf16_t b) { return __uint_as_float((unsigned)b << 16); }
__device__ __forceinline__ float fast_exp2(float x) { return __builtin_amdgcn_exp2f(x); }
__device__ __forceinline__ float fast_rcp(float x) { return __builtin_amdgcn_rcpf(x); }
__device__ __forceinline__ float sigmoidf_(float x) { return fast_rcp(1.0f + fast_exp2(-x * LOG2E)); }
__device__ __forceinline__ float gelu_tanh(float x) { const float u = 0.7978845608028654f * (x + 0.044715f * x * x * x); return x * fast_rcp(1.0f + fast_exp2(-2.0f * LOG2E * u)); }
__device__ __forceinline__ float wave_sum(float v) {
#pragma unroll
    for (int o = 1; o < 64; o <<= 1) v += __shfl_xor(v, o);
    return v;
}
#define LDS_WAIT() asm volatile("s_waitcnt lgkmcnt(0)" ::: "memory")
#define VM_WAIT() asm volatile("s_waitcnt vmcnt(0)" ::: "memory")
namespace pg8 {
#ifdef DBG_GP_K
__device__ unsigned long long dbg_gp[8];
#define GP_T() __builtin_readcyclecounter()
#endif
typedef int i32x4 __attribute__((ext_vector_type(4)));
typedef int i32x8 __attribute__((ext_vector_type(8)));
constexpr int BM = 256, BK = 64, HALF = 128, HTB = HALF * BK * 2, STAGE_BYTES = 8 * HTB;
__host__ __device__ __forceinline__ int lds_byte(int r, int c) { const int st = (r >> 4) * 2 + (c >> 5), rr = r & 15, cc = c & 31, ob = rr * 64 + cc * 2; return st * 1024 + (ob ^ (((ob >> 9) & 1) << 5)); }
__host__ __device__ __forceinline__ void stage_rc(int b, int& R, int& C) { const int st = b / 1024, sb = b % 1024, swz = sb ^ (((sb >> 9) & 1) << 5); R = (st >> 1) * 16 + swz / 64; C = (st & 1) * 32 + (swz % 64) / 2; }
__host__ __device__ __forceinline__ int perm32(int rho) { const int n = rho >> 4, i = rho & 15; return 8 * (i >> 2) + 4 * n + (i & 3); }

struct Unit { const char* A; const char* B; const char* B2; int pm, pn, e, nrows; };

#ifndef PG8_WGM
#define PG8_WGM 8
#endif
struct StaticOrder {
    static constexpr int WGM = PG8_WGM;
    int nM, nN, nwg, G, c;
    __device__ void init(int M, int N, int G_, int c_) { nM = M / BM; nN = N / BM; nwg = nM * nN; G = G_; c = c_; }
    __device__ bool next(int i, int& pm, int& pn) const {
        const long L = (long)i * G + c; if (L >= nwg) return false;
        int wgid = (int)L; { const int q = nwg / 8, r = nwg % 8, xcd = wgid % 8, off = wgid / 8; wgid = (xcd < r ? xcd * (q + 1) : r * (q + 1) + (xcd - r) * q) + off; }
        const int nig = WGM * nN, gid = wgid / nig, fm = gid * WGM, gsz = (nM - fm) < WGM ? (nM - fm) : WGM;
        pm = fm + ((wgid % nig) % gsz); pn = (wgid % nig) / gsz; return true;
    }
};

template <class Epi, class Sched>
__device__ __forceinline__ void gemm_phase(LAS unsigned char* lds, const int K, const Sched& S, const Epi& E) {
    const int tid = threadIdx.x, wid = __builtin_amdgcn_readfirstlane(tid >> 6), lane = tid & 63, wr = wid >> 2, wc = wid & 3, fr = lane & 15, fq = lane >> 4;
    const int nt = K / BK;
    const int LDB = Sched::LDB > 0 ? Sched::LDB : K;
    int Rr[2], Cc[2];
    unsigned voffB[2];
#pragma unroll
    for (int i = 0; i < 2; ++i) { int R, C; stage_rc(tid * 16 + i * 8192, R, C); Rr[i] = R; Cc[i] = C; const int Rb = Epi::PERM ? ((R & ~31) + perm32(R & 31)) : R; voffB[i] = (unsigned)(Rb * LDB + C) * 2u; }
    const size_t kstep = (size_t)(BK * 2);
    const size_t hstepB = (size_t)HALF * LDB * 2;
    const unsigned ldsw = (unsigned)wid * 1024u;
    const int aoff = lds_byte(wr * 64 + fr, fq * 8), boff = lds_byte(wc * 32 + fr, fq * 8);
#define PG8_SA(b, h) (((b) * 2 + (h)) * HTB)
#define PG8_SB(b, h) ((4 + (b) * 2 + (h)) * HTB)
#define PG8_STAGE2(bufoff, gbase, v0, v1) do { \
        __builtin_amdgcn_global_load_lds((const unsigned*)((const char*)(gbase) + (v0)), (LAS unsigned*)(lds + (bufoff) + ldsw), 16, 0, 0); \
        __builtin_amdgcn_global_load_lds((const unsigned*)((const char*)(gbase) + (v1)), (LAS unsigned*)(lds + (bufoff) + ldsw + 8192), 16, 0, 0); } while (0)
#define PG8_STAGEB(bufoff, gbase) PG8_STAGE2(bufoff, gbase, voffB[0], voffB[1])
#define PG8_LDA(dst, b, h) do { _Pragma("unroll") for (int m = 0; m < 4; ++m) { if constexpr (Epi::FP8) { \
            dst##8[m] = __builtin_shufflevector(*(const LAS i32x4*)(lds + PG8_SA(b, h) + aoff + m * 2048), *(const LAS i32x4*)(lds + PG8_SA(b, h) + aoff + m * 2048 + 1024), 0, 1, 2, 3, 4, 5, 6, 7); \
        } else { _Pragma("unroll") for (int k = 0; k < 2; ++k) dst[m][k] = *(const LAS bf16x8*)(lds + PG8_SA(b, h) + aoff + m * 2048 + k * 1024); } } } while (0)
#define PG8_LDB(dst, b, h) do { _Pragma("unroll") for (int n = 0; n < 2; ++n) { if constexpr (Epi::FP8) { \
            dst##8[n] = __builtin_shufflevector(*(const LAS i32x4*)(lds + PG8_SB(b, h) + boff + n * 2048), *(const LAS i32x4*)(lds + PG8_SB(b, h) + boff + n * 2048 + 1024), 0, 1, 2, 3, 4, 5, 6, 7); \
        } else { _Pragma("unroll") for (int k = 0; k < 2; ++k) dst[n][k] = *(const LAS bf16x8*)(lds + PG8_SB(b, h) + boff + n * 2048 + k * 1024); } } } while (0)
#define PG8_MMA(ai, bj, At, Bt) do { __builtin_amdgcn_s_setprio(1); _Pragma("unroll") for (int m = 0; m < 4; ++m) _Pragma("unroll") for (int n = 0; n < 2; ++n) { \
        if constexpr (Epi::FP8) {   \
              \
            asm volatile("v_mfma_scale_f32_16x16x128_f8f6f4 %0, %1, %2, %0, %3, %4 op_sel_hi:[0,0,0]" : "+v"(acc[ai][bj][m][n]) : "v"(Bt##8[n]), "v"(At##8[m]), "v"(sclw), "v"(scla)); \
        } else { _Pragma("unroll") for (int k = 0; k < 2; ++k) acc[ai][bj][m][n] = __builtin_amdgcn_mfma_f32_16x16x32_bf16(Bt[n][k], At[m][k], acc[ai][bj][m][n], 0, 0, 0); } } \
        __builtin_amdgcn_s_setprio(0); } while (0)
#define PG8_WAIT_V(n) asm volatile("s_waitcnt vmcnt(" #n ")" ::: "memory")
#define PG8_WAIT_L(n) asm volatile("s_waitcnt lgkmcnt(" #n ")" ::: "memory")
#define PG8_BAR __builtin_amdgcn_s_barrier()
#define PG8_SCHED __builtin_amdgcn_sched_barrier(0)
    Unit cur, nxt, nn; int ui = 0; u32x2 pfv = {0u, 0u}; bool has_nn = false;
    if (!S.next(0, cur)) return;
    f32x4 acc[2][2][4][2];
#pragma unroll
    for (int a = 0; a < 2; ++a)
#pragma unroll
        for (int b = 0; b < 2; ++b)
#pragma unroll
            for (int m = 0; m < 4; ++m)
#pragma unroll
                for (int n = 0; n < 2; ++n) acc[a][b][m][n] = (f32x4){0.f, 0.f, 0.f, 0.f};
    const int sclw = Epi::SCALE_W, scla = Epi::SCALE_A;
    bf16x8 At[4][2], B0[2][2], B1[2][2];
    i32x8 At8[4], B08[2], B18[2];
    unsigned c00, c01, c10, c11, n00, n01, n10, n11;
    c00 = S.aoff(cur, Rr[0]) + (unsigned)Cc[0] * 2u; c01 = S.aoff(cur, Rr[1]) + (unsigned)Cc[1] * 2u;
    c10 = S.aoff(cur, Rr[0] + HALF) + (unsigned)Cc[0] * 2u; c11 = S.aoff(cur, Rr[1] + HALF) + (unsigned)Cc[1] * 2u;
    const char* cA = cur.A; const char* cB = cur.B; const char* cB2 = nullptr; if constexpr (Sched::HAS_B2) cB2 = cur.B2;
    S.prefetch(cur, 0);
    if (S.next(1, nxt)) S.prefetch(nxt, 1);
    PG8_STAGEB(PG8_SB(0, 0), cB); PG8_STAGEB(PG8_SB(0, 1), cB + hstepB); PG8_STAGE2(PG8_SA(0, 0), cA, c00, c01); PG8_STAGE2(PG8_SA(0, 1), cA, c10, c11);
    if (wr == 1) PG8_BAR;
    PG8_WAIT_V(2); PG8_BAR;
    PG8_STAGEB(PG8_SB(1, 0), cB + kstep); PG8_STAGE2(PG8_SA(1, 0), cA + kstep, c00, c01); PG8_STAGEB(PG8_SB(1, 1), cB + hstepB + kstep);
    PG8_WAIT_V(6); PG8_BAR;
#ifdef DBG_GP_K
    const bool dbg_on = (DBG_GP_K > 0 ? (Epi::FP8 && K == DBG_GP_K && Sched::HAS_B2 == (DBG_GP_B2)) : (sizeof(Epi) == -(DBG_GP_K) && Epi::HAS_MID == (bool)(DBG_GP_B2))) && blockIdx.x == 0 && threadIdx.x == 0; unsigned long long dbg_t0 = GP_T(), dbg_loop = 0, dbg_epi = 0, dbg_n = 0, dbg_first = 0;
#endif
    for (;;) {
#ifdef DBG_GP_K
        const unsigned long long dbg_a = GP_T();
#endif
        const bool has_next = S.next(ui + 1, nxt);
        const char* nA = has_next ? nxt.A : cA; const char* nB = has_next ? nxt.B : cB; const char* nB2 = nullptr; if constexpr (Sched::HAS_B2) nB2 = has_next ? nxt.B2 : cB2;
        n00 = c00; n01 = c01; n10 = c10; n11 = c11;
        asm volatile(".p2align 6");
#pragma unroll 1
        for (int t = 0; t < nt; t += 2) {
            if constexpr (Epi::HAS_MID) { if (t == nt / 2) E.mid(acc, cur, wr, wc, fr, fq); }
            const bool last = (t == nt - 2);
            const char* a1 = cA + (size_t)(t + 1) * kstep;
            const char* a2 = last ? nA : cA + (size_t)(t + 2) * kstep; const char* b2 = last ? nB : cB + (size_t)(t + 2) * kstep;
            if constexpr (Sched::HAS_B2) { if (!last && t + 2 >= nt / 2) b2 = cB2 + (size_t)(t + 2 - nt / 2) * kstep; }
            const char* a3 = a2 + kstep; const char* b3 = b2 + kstep;
            PG8_LDB(B0, 0, 0); PG8_LDB(B1, 0, 1); PG8_SCHED; PG8_LDA(At, 0, 0); PG8_STAGE2(PG8_SA(1, 1), a1, c10, c11);
            PG8_WAIT_V(8); PG8_WAIT_L(0); PG8_BAR; PG8_MMA(0, 0, At, B0); PG8_MMA(0, 1, At, B1); PG8_BAR; PG8_SCHED;
            if (last && has_next) {
                n00 = S.aoff2(nxt, ui + 1, Rr[0]) + (unsigned)Cc[0] * 2u; n01 = S.aoff2(nxt, ui + 1, Rr[1]) + (unsigned)Cc[1] * 2u;
                n10 = S.aoff2(nxt, ui + 1, Rr[0] + HALF) + (unsigned)Cc[0] * 2u; n11 = S.aoff2(nxt, ui + 1, Rr[1] + HALF) + (unsigned)Cc[1] * 2u; }
            const unsigned x00 = n00, x01 = n01, x10 = n10, x11 = n11;
            PG8_LDA(At, 0, 1); PG8_STAGEB(PG8_SB(0, 0), b2); PG8_STAGEB(PG8_SB(0, 1), b2 + hstepB); PG8_STAGE2(PG8_SA(0, 0), a2, x00, x01);
            PG8_WAIT_V(8); PG8_WAIT_L(0); PG8_BAR; PG8_MMA(1, 0, At, B0); PG8_MMA(1, 1, At, B1); PG8_BAR; PG8_SCHED;
            PG8_LDB(B0, 1, 0); PG8_LDB(B1, 1, 1); PG8_SCHED; PG8_LDA(At, 1, 0); PG8_STAGE2(PG8_SA(0, 1), a2, x10, x11);
            PG8_WAIT_V(8); PG8_WAIT_L(0); PG8_BAR; PG8_MMA(0, 0, At, B0); PG8_MMA(0, 1, At, B1); PG8_BAR; PG8_SCHED;
            PG8_LDA(At, 1, 1); PG8_STAGEB(PG8_SB(1, 0), b3); PG8_STAGEB(PG8_SB(1, 1), b3 + hstepB); PG8_STAGE2(PG8_SA(1, 0), a3, x00, x01);
            PG8_WAIT_V(8); PG8_WAIT_L(0); PG8_BAR; PG8_MMA(1, 0, At, B0); PG8_MMA(1, 1, At, B1); PG8_BAR; PG8_SCHED;
        }
#ifdef DBG_GP_K
        const unsigned long long dbg_b = GP_T();
#endif
        if (wr == 0) PG8_BAR;
        has_nn = has_next && S.next(ui + 2, nn);
        if (has_nn) pfv = S.pf_load(nn);
        E(acc, cur, wr, wc, fr, fq, ui);
#ifdef DBG_GP_K
        { const unsigned long long dbg_c = GP_T(); dbg_loop += dbg_b - dbg_a; dbg_epi += dbg_c - dbg_b; dbg_n += 1; if (ui == 0) dbg_first = dbg_b - dbg_t0; }
#endif
        if (!has_next) break;
#pragma unroll
        for (int a = 0; a < 2; ++a)
#pragma unroll
            for (int b = 0; b < 2; ++b)
#pragma unroll
                for (int m = 0; m < 4; ++m)
#pragma unroll
                    for (int n = 0; n < 2; ++n) acc[a][b][m][n] = (f32x4){0.f, 0.f, 0.f, 0.f};
        cur = nxt; cA = nA; cB = nB; if constexpr (Sched::HAS_B2) cB2 = nB2; c00 = n00; c01 = n01; c10 = n10; c11 = n11; ++ui;
        if (wr == 1) PG8_BAR;
        if (has_nn) S.pf_store(ui + 1, pfv);
    }
    PG8_WAIT_V(0);
    PG8_BAR;
#ifdef DBG_GP_K
    if (dbg_on) { dbg_gp[0] += dbg_loop; dbg_gp[1] += dbg_epi; dbg_gp[2] += GP_T() - dbg_t0; dbg_gp[3] += dbg_n; dbg_gp[4] += dbg_first; }
#endif
#undef PG8_SA
#undef PG8_SB
#undef PG8_STAGE2
#undef PG8_STAGEB
#undef PG8_LDA
#undef PG8_LDB
#undef PG8_MMA
#undef PG8_WAIT_V
#undef PG8_WAIT_L
#undef PG8_BAR
#undef PG8_SCHED
}
}
using pg8::Unit;
#if defined(EPI_SC1)
typedef int i32x4 __attribute__((ext_vector_type(4)));
__device__ __forceinline__ void epi_st16_sc1(const void* base, unsigned byte_off, u32x4 v) {
    const __amdgpu_buffer_rsrc_t r = __builtin_amdgcn_make_buffer_rsrc((void*)base, 0, 0x7fffffff, 0x00020000);
    __builtin_amdgcn_raw_buffer_store_b128(v, r, (int)byte_off, 0, 16); }
#define EPI_ST16(base_, off_, val_) epi_st16_sc1((base_), (unsigned)((off_) * 2), (val_))
#elif defined(EPI_NT)
#define EPI_ST16(base_, off_, val_) __builtin_nontemporal_store((val_), (u32x4*)((base_) + (off_)))
#else
#define EPI_ST16(base_, off_, val_) (*(u32x4*)((base_) + (off_)) = (val_))
#endif
typedef f32x4 AccT[2][2][4][2];

__device__ __forceinline__ u32x4 pack8(const f32x4 a, const f32x4 b) { u32x4 w; w.x = cvt_pk_bf16(a[0], a[1]); w.y = cvt_pk_bf16(a[2], a[3]); w.z = cvt_pk_bf16(b[0], b[1]); w.w = cvt_pk_bf16(b[2], b[3]); return w; }
__device__ __forceinline__ void unpack8(const u32x4 w, f32x4& a, f32x4& b) { a = (f32x4){bf_lo(w.x), bf_hi(w.x), bf_lo(w.y), bf_hi(w.y)}; b = (f32x4){bf_lo(w.z), bf_hi(w.z), bf_lo(w.w), bf_hi(w.w)}; }

__device__ __forceinline__ unsigned pack4_fp8(float a, float b, float c, float d) { int p = __builtin_amdgcn_cvt_pk_fp8_f32(a, b, 0, false); p = __builtin_amdgcn_cvt_pk_fp8_f32(c, d, p, true); return (unsigned)p; }
constexpr int MOE_W_SHIFT = 5;
constexpr int MOE_SCALE_W = (127 - MOE_W_SHIFT) * 0x01010101;
struct SchedPlain {
    const char* A; const char* Bt; unsigned lda; int K; pg8::StaticOrder so;
    __device__ __forceinline__ bool next(int i, Unit& u) const { int pm, pn; if (!so.next(i, pm, pn)) return false; u.pm = pm; u.pn = pn; u.e = 0; u.nrows = 256;
        u.A = A + (size_t)pm * 256 * lda; u.B = Bt + (size_t)pn * 256 * K * 2; return true; }
    static constexpr int LDB = 0; static constexpr bool HAS_B2 = false;
    __device__ __forceinline__ unsigned aoff(const Unit&, int R) const { return (unsigned)R * lda; }
    __device__ __forceinline__ unsigned aoff2(const Unit& u, int, int R) const { return aoff(u, R); }
    __device__ __forceinline__ void prefetch(const Unit&, int) const {}
    __device__ __forceinline__ u32x2 pf_load(const Unit&) const { return (u32x2){0u, 0u}; }
    __device__ __forceinline__ void pf_store(int, u32x2) const {}
};

struct EpiG1 {
    static constexpr bool PERM = true, HAS_MID = false, FP8 = false; static constexpr int SCALE_W = 0x7f7f7f7f, SCALE_A = 0x7f7f7f7f;
    bf16_t *U, *Q, *KC, *VC, *KS, *VST, *KW, *VWT, *MG, *BG;
    __device__ __forceinline__ void operator()(const AccT& acc, const Unit& u, int wr, int wc, int fr, int fq, int ui = 0) const {
        const int pn = u.pn < 8 ? u.pn + 7 : (u.pn < 12 ? u.pn - 8 : 18 - u.pn);
        const int row0 = u.pm * 256 + wr * 64 + fr; const int cc = wc * 32 + 8 * fq;
        if (pn == 4) {
            const bool odd = (fq & 1) != 0; const int g = cc >> 6, d = (cc & 63) - (odd ? 8 : 0);
#pragma unroll
            for (int ai = 0; ai < 2; ++ai)
#pragma unroll
                for (int c = 0; c < 2; ++c)
#pragma unroll
                    for (int bj = 0; bj < 2; ++bj) {
                        const f32x4 e0 = acc[ai][bj][2 * c][0], e1 = acc[ai][bj][2 * c][1], o0 = acc[ai][bj][2 * c + 1][0], o1 = acc[ai][bj][2 * c + 1][1];
                        const unsigned ex = pack4_fp8(e0[0], e0[1], e0[2], e0[3]), ey = pack4_fp8(e1[0], e1[1], e1[2], e1[3]), ox = pack4_fp8(o0[0], o0[1], o0[2], o0[3]), oy = pack4_fp8(o1[0], o1[1], o1[2], o1[3]);
                        const auto sx = __builtin_amdgcn_permlane16_swap(ex, ox, false, false); const auto sy = __builtin_amdgcn_permlane16_swap(ey, oy, false, false);
                        u32x4 o; o.x = sx[0]; o.y = sy[0]; o.z = sx[1]; o.w = sy[1];
                        const int row = row0 + ai * 128 + (2 * c + (odd ? 1 : 0)) * 16; const int b = row >> 11, sq = row & 2047;
                        *(u32x4*)((unsigned char*)(bj == 0 ? KC : VC) + ((size_t)(b * 2 + g) * 2048 + sq) * 64 + d) = o; }
            return;
        }
#pragma unroll
        for (int ai = 0; ai < 2; ++ai)
#pragma unroll
            for (int m = 0; m < 4; ++m) {
                const int row = row0 + ai * 128 + m * 16;
#pragma unroll
                for (int bj = 0; bj < 2; ++bj) {
                    f32x4 v0 = acc[ai][bj][m][0], v1 = acc[ai][bj][m][1];
                    const int col = 128 * bj + cc;
                    if (pn < 2) { EPI_ST16(U, (size_t)row * 512 + pn * 256 + col, pack8(v0, v1)); }
                    else if (pn < 4) { EPI_ST16(Q, (size_t)row * 512 + (pn - 2) * 256 + col, pack8(v0, v1)); }
                    else if (pn < 7) {
                        const int g = cc >> 6, d = cc & 63, b = row >> 11, s = row & 2047;
                        const size_t kidx = ((size_t)(b * 2 + g) * 2048 + s) * 64 + d;
                        if (pn == 4) { u32x2 w8; w8.x = pack4_fp8(v0[0], v0[1], v0[2], v0[3]); w8.y = pack4_fp8(v1[0], v1[1], v1[2], v1[3]); *(u32x2*)((unsigned char*)(bj == 0 ? KC : VC) + kidx) = w8; }
                        else if (bj == 0) { bf16_t* Kb = pn == 5 ? KS : KW; EPI_ST16(Kb, kidx, pack8(v0, v1)); }
                        else {
                            const u32x4 w = pack8(v0, v1); const int odd = fr & 1;
                            bf16_t* Vt = (pn == 5 ? VST : VWT) + (((size_t)(b * 2 + g) * 32 + (s >> 6)) * 64 + d + odd) * 64 + ((s & 63) & ~1);
#pragma unroll
                            for (int q = 0; q < 4; ++q) { const unsigned mine = q == 0 ? w.x : (q == 1 ? w.y : (q == 2 ? w.z : w.w));
                                const unsigned nb = (unsigned)__builtin_amdgcn_update_dpp(0, (int)mine, 0xB1, 0xF, 0xF, true);
                                const unsigned o = odd ? ((nb >> 16) | (mine & 0xffff0000u)) : ((mine & 0xffffu) | (nb << 16));
                                *(unsigned*)(Vt + (size_t)(2 * q) * 64) = o; } }
                    }
                    else if (pn < 15) {
                        if (bj == 0) { f32x4 a0 = v0, a1 = v1, b0 = acc[ai][1][m][0], b1 = acc[ai][1][m][1];
#pragma unroll
                            for (int i = 0; i < 4; ++i) {
                                const float t0 = fminf(1.0f + fast_exp2(b0[i]), 1e20f), t1 = fminf(1.0f + fast_exp2(b1[i]), 1e20f);
                                a0[i] = t0 * fast_rcp(1.0f + fast_exp2(a0[i])); a1[i] = t1 * fast_rcp(1.0f + fast_exp2(a1[i])); b0[i] = fast_rcp(t0); b1[i] = fast_rcp(t1); }
                            const size_t mgo = (size_t)row * 2048 + (pn - 7) * 128 + cc; EPI_ST16(MG, mgo, pack8(a0, a1)); EPI_ST16(MG, mgo + 1024, pack8(b0, b1)); } }
                }
            }
    }
};

#ifdef PROBE_G1
struct EpiProbe {
    static constexpr bool PERM = true, HAS_MID = false, FP8 = false; static constexpr int SCALE_W = 0x7f7f7f7f, SCALE_A = 0x7f7f7f7f;
    float* sink;
    __device__ __forceinline__ void operator()(const AccT& acc, const Unit& u, int wr, int wc, int fr, int fq, int ui = 0) const {
        f32x4 t = (f32x4){0.f, 0.f, 0.f, 0.f};
#pragma unroll
        for (int ai = 0; ai < 2; ++ai)
#pragma unroll
            for (int bj = 0; bj < 2; ++bj)
#pragma unroll
                for (int m = 0; m < 4; ++m) t += acc[ai][bj][m][0] + acc[ai][bj][m][1];
        if (t[0] + t[1] + t[2] + t[3] == 1234567.0f) sink[threadIdx.x] = t[0];
    }
};
template <int MODE> struct EpiProbeS {
    static constexpr bool PERM = true, HAS_MID = false, FP8 = false; static constexpr int SCALE_W = 0x7f7f7f7f, SCALE_A = 0x7f7f7f7f;
    bf16_t* D;
    __device__ __forceinline__ void operator()(const AccT& acc, const Unit& u, int wr, int wc, int fr, int fq, int ui = 0) const {
        const int lane = threadIdx.x & 63, wid = threadIdx.x >> 6;
        const int fr2 = MODE == 5 ? (lane >> 2) : fr, fq2 = MODE == 5 ? (lane & 3) : fq;
        const int row0 = u.pm * 256 + wr * 64 + fr2; const int cc = wc * 32 + 8 * fq2;
        const int src = (16 * (lane & 3) + (lane >> 2)) * 4;
        int sidx = 0;
#pragma unroll
        for (int ai = 0; ai < 2; ++ai)
#pragma unroll
            for (int m = 0; m < 4; ++m) {
                const int row = row0 + ai * 128 + m * 16;
#pragma unroll
                for (int bj = 0; bj < 2; ++bj) {
                    u32x4 w = pack8(acc[ai][bj][m][0], acc[ai][bj][m][1]);
                    const int col = 128 * bj + cc;
                    if constexpr (MODE == 5) { w.x = (unsigned)__builtin_amdgcn_ds_bpermute(src, (int)w.x); w.y = (unsigned)__builtin_amdgcn_ds_bpermute(src, (int)w.y); w.z = (unsigned)__builtin_amdgcn_ds_bpermute(src, (int)w.z); w.w = (unsigned)__builtin_amdgcn_ds_bpermute(src, (int)w.w); }
                    if constexpr (MODE == 4) { *(u32x4*)(D + (size_t)((u.pm * 15 + u.pn) & 1023) * 65536 + ((wid * 16 + sidx) * 64 + lane) * 8) = w; }
                    else { *(u32x4*)(D + (size_t)row * 512 + (u.pn & 1) * 256 + col) = w; }
                    ++sidx;
                }
            }
    }
};
#endif
struct SchedCmp {
    const char* KC; const char* VC; const char* W1; int c;
    __device__ __forceinline__ bool next(int i, Unit& u) const { if (i != 0 || c >= 64) return false; u.e = c >> 5; u.pm = c & 31; u.pn = 0; u.nrows = 256;
        u.A = (u.e ? VC : KC) + (size_t)u.pm * 256 * 1024; u.B = W1 + (size_t)u.e * 256 * 2048; return true; }
    static constexpr int LDB = 0; static constexpr bool HAS_B2 = false;
    __device__ __forceinline__ unsigned aoff(const Unit&, int R) const { return (unsigned)R * 1024u; }
    __device__ __forceinline__ unsigned aoff2(const Unit& u, int, int R) const { return aoff(u, R); }
    __device__ __forceinline__ void prefetch(const Unit&, int) const {}
    __device__ __forceinline__ u32x2 pf_load(const Unit&) const { return (u32x2){0u, 0u}; }
    __device__ __forceinline__ void pf_store(int, u32x2) const {}
};
struct EpiHid {
    static constexpr bool PERM = true, HAS_MID = false, FP8 = true; static constexpr int SCALE_W = MOE_SCALE_W, SCALE_A = 0x7f7f7f7f;
    bf16_t* HID; const float* bias1;
    __device__ __forceinline__ void operator()(const AccT& acc, const Unit& u, int wr, int wc, int fr, int fq, int ui = 0) const {
        const int row0 = u.pm * 256 + wr * 64 + fr; const int cc = wc * 32 + 8 * fq; bf16_t* H = HID + (size_t)u.e * 8192 * 256; const float* bs = bias1 + u.e * 256;
#pragma unroll
        for (int bj = 0; bj < 2; ++bj) { const int col = 128 * bj + cc; const f32x4 b0 = *(const f32x4*)(bs + col), b1 = *(const f32x4*)(bs + col + 4);
#pragma unroll
            for (int ai = 0; ai < 2; ++ai)
#pragma unroll
                for (int m = 0; m < 4; ++m) { const int row = row0 + ai * 128 + m * 16; f32x4 v0 = acc[ai][bj][m][0] + b0, v1 = acc[ai][bj][m][1] + b1;
#pragma unroll
                    for (int i = 0; i < 4; ++i) { v0[i] = gelu_tanh(v0[i]); v1[i] = gelu_tanh(v1[i]); }
                    EPI_ST16(H, (size_t)row * 256 + col, pack8(v0, v1)); } }
    }
};

struct EpiMix {
    static constexpr bool PERM = true, HAS_MID = true, FP8 = false; static constexpr int SCALE_W = 0x7f7f7f7f, SCALE_A = 0x7f7f7f7f;
    const bf16_t* MG; bf16_t* MIX;
    __device__ __forceinline__ void mid(AccT& acc, const Unit& u, int wr, int wc, int fr, int fq, int ui = 0) const {
        unsigned off0 = (unsigned)(u.pm * 256 + wr * 64 + fr) * 2048u + (unsigned)(u.pn * 256 + wc * 32 + 8 * fq);
        asm volatile("" : "+v"(off0));
        u32x4 g[2][4][2];
#pragma unroll
        for (int ai = 0; ai < 2; ++ai)
#pragma unroll
            for (int m = 0; m < 4; ++m)
#pragma unroll
                for (int bj = 0; bj < 2; ++bj) g[ai][m][bj] = *(const u32x4*)(MG + off0 + (unsigned)((ai * 128 + m * 16) * 2048 + 128 * bj));
        __builtin_amdgcn_sched_barrier(0);
#pragma unroll
        for (int ai = 0; ai < 2; ++ai) {
#pragma unroll
            for (int m = 0; m < 4; ++m)
#pragma unroll
                for (int bj = 0; bj < 2; ++bj) { f32x4 a0, a1; unpack8(g[ai][m][bj], a0, a1); acc[ai][bj][m][0] *= a0; acc[ai][bj][m][1] *= a1; }
            asm volatile("" : "+v"(acc[ai][0][0][0]), "+v"(acc[ai][1][0][0]) :: "memory");
        }
    }
    __device__ __forceinline__ void operator()(const AccT& acc, const Unit& u, int wr, int wc, int fr, int fq, int ui = 0) const {
        const int row0 = u.pm * 256 + wr * 64 + fr; const int c0 = u.pn * 256 + wc * 32 + 8 * fq;
        u32x4 g[2][4][2];
#pragma unroll
        for (int ai = 0; ai < 2; ++ai)
#pragma unroll
            for (int m = 0; m < 4; ++m)
#pragma unroll
                for (int bj = 0; bj < 2; ++bj) g[ai][m][bj] = *(const u32x4*)(MG + (size_t)(row0 + ai * 128 + m * 16) * 2048 + 1024 + c0 + 128 * bj);
        __builtin_amdgcn_sched_barrier(0);
#pragma unroll
        for (int ai = 0; ai < 2; ++ai)
#pragma unroll
            for (int m = 0; m < 4; ++m)
#pragma unroll
                for (int bj = 0; bj < 2; ++bj) { f32x4 g0, g1; unpack8(g[ai][m][bj], g0, g1);
                    EPI_ST16(MIX, (size_t)(row0 + ai * 128 + m * 16) * 1024 + c0 + 128 * bj, pack8(acc[ai][bj][m][0] * g0, acc[ai][bj][m][1] * g1)); }
    }
};
struct EpiDelta {
    static constexpr bool PERM = true, HAS_MID = false, FP8 = false; static constexpr int SCALE_W = 0x7f7f7f7f, SCALE_A = 0x7f7f7f7f;
    const float* MOD; bf16_t* DELTA;
    __device__ __forceinline__ void operator()(const AccT& acc, const Unit& u, int wr, int wc, int fr, int fq, int ui = 0) const {
        const int row0 = u.pm * 256 + wr * 64 + fr; const int c0 = u.pn * 256 + wc * 32 + 8 * fq; const int b = (u.pm * 256) >> 11;
        const float* g1 = MOD + (size_t)b * 6144 + 2048;
#pragma unroll
        for (int bj = 0; bj < 2; ++bj) { const int col = c0 + 128 * bj; const f32x4 g0 = *(const f32x4*)(g1 + col), g1v = *(const f32x4*)(g1 + col + 4);
#pragma unroll
            for (int ai = 0; ai < 2; ++ai)
#pragma unroll
                for (int m = 0; m < 4; ++m) EPI_ST16(DELTA, (size_t)(row0 + ai * 128 + m * 16) * 1024 + col, pack8(acc[ai][bj][m][0] * g0, acc[ai][bj][m][1] * g1v)); }
    }
};

struct SchedMoe {
    static constexpr int LDB = 0; static constexpr bool HAS_B2 = false;
    const char* A; const char* W; const u32x2* LIST; const LAS unsigned* tcnt; const LAS unsigned* tbase; unsigned lda; size_t wstride; int K; int G, c; bool by_token;
    __device__ __forceinline__ bool next(int i, Unit& u) const {
        if (i >= 32) return false; const unsigned w = (unsigned)__builtin_amdgcn_readfirstlane((int)tbase[40 + i]); if (w == 0xffffffffu) return false;
        const int e = (int)(w >> 16), tile = (int)((w >> 2) & 0x3fffu), pn = (int)(w & 3u); const int cnt = __builtin_amdgcn_readfirstlane((int)tcnt[e]);
        u.e = e; u.pm = tile; u.pn = pn; u.nrows = (cnt - tile * 256) < 256 ? (cnt - tile * 256) : 256;
        u.A = A; u.B = W + (size_t)e * wstride + (size_t)pn * 256 * K * 2;
        return true; }
    __device__ __forceinline__ u32x2 entry(const Unit& u, int R) const { const int r = R < u.nrows ? R : u.nrows - 1; return LIST[(size_t)u.e * 65536 + u.pm * 256 + r]; }
    __device__ __forceinline__ unsigned aoff(const Unit& u, int R) const { const unsigned s = entry(u, R).x; return (by_token ? (s >> 1) : s) * lda; }
    LAS u32x2* tab;
    __device__ __forceinline__ unsigned aoff2(const Unit&, int ui, int R) const { const unsigned s = tab[(ui % 3) * 256 + R].x;
        return (by_token ? (s >> 1) : s) * lda; }
    __device__ __forceinline__ u32x2 pf_load(const Unit& u) const { const int tid = threadIdx.x; u32x2 e = {0u, 0u}; if (tid < 256) e = entry(u, tid); return e; }
    __device__ __forceinline__ void pf_store(int ui, u32x2 e) const { const int tid = threadIdx.x; if (tid < 256) tab[(ui % 3) * 256 + tid] = e; }
    __device__ __forceinline__ void prefetch(const Unit& u, int ui) const { pf_store(ui, pf_load(u)); }
};
constexpr float HE_SCALE = 8.0f;
struct EpiHE {
    static constexpr bool PERM = true, HAS_MID = false, FP8 = true; static constexpr int SCALE_W = MOE_SCALE_W, SCALE_A = 0x7f7f7f7f;
    unsigned char* HE; const LAS u32x2* tab;
    __device__ __forceinline__ void operator()(const AccT& acc, const Unit& u, int wr, int wc, int fr, int fq, int ui = 0) const {
        const int cc = u.pn * 128 + wc * 32 + 8 * fq; const bool odd = (fq & 1) != 0;
#pragma unroll
        for (int ai = 0; ai < 2; ++ai)
#pragma unroll
            for (int c = 0; c < 2; ++c) { u32x2 w[2]; unsigned sl[2];
#pragma unroll
                for (int q = 0; q < 2; ++q) { const int m = 2 * c + q; const int R = ai * 128 + wr * 64 + m * 16 + fr;
                    const u32x2 te = tab[(ui % 3) * 256 + R]; sl[q] = te.x; const float wsc = __uint_as_float(te.y) * HE_SCALE; f32x4 g0 = acc[ai][0][m][0], g1 = acc[ai][0][m][1]; const f32x4 u0 = acc[ai][1][m][0] * wsc, u1 = acc[ai][1][m][1] * wsc;
#pragma unroll
                    for (int i = 0; i < 4; ++i) { g0[i] = g0[i] * sigmoidf_(g0[i]) * u0[i]; g1[i] = g1[i] * sigmoidf_(g1[i]) * u1[i]; }
                    w[q].x = pack4_fp8(g0[0], g0[1], g0[2], g0[3]); w[q].y = pack4_fp8(g1[0], g1[1], g1[2], g1[3]); }
                const auto sx = __builtin_amdgcn_permlane16_swap(w[0].x, w[1].x, false, false); const auto sy = __builtin_amdgcn_permlane16_swap(w[0].y, w[1].y, false, false);
                u32x4 o; o.x = sx[0]; o.y = sy[0]; o.z = sx[1]; o.w = sy[1];
                const int Rst = ai * 128 + wr * 64 + (2 * c + (odd ? 1 : 0)) * 16 + fr; const unsigned sst = odd ? sl[1] : sl[0];
                if (Rst < u.nrows) *(u32x4*)(HE + (size_t)sst * 512 + cc - (odd ? 8 : 0)) = o; }
    }
};
struct SchedPair {
    static constexpr int LDB = 256; static constexpr bool HAS_B2 = true;
    const char* A; const char* W; const unsigned* LISTC; const LAS unsigned* tcntC; const LAS unsigned* ulistC; LAS u32x2* tab;
    __device__ __forceinline__ bool next(int i, Unit& u) const {
        if (i >= 32) return false; const unsigned w = (unsigned)__builtin_amdgcn_readfirstlane((int)ulistC[i]); if (w == 0xffffffffu) return false;
        const int c = (int)(w >> 16), tile = (int)((w >> 2) & 0x3fffu), pn = (int)(w & 3u); const int cnt = __builtin_amdgcn_readfirstlane((int)tcntC[c]);
        u.e = c; u.pm = tile; u.pn = pn; u.nrows = (cnt - tile * 256) < 256 ? (cnt - tile * 256) : 256;
        const int g = c / 28; int q = c - g * 28, a = 0; while (q >= 7 - a) { q -= 7 - a; ++a; } const int b = a + 1 + q;
        u.A = A; u.B = W + (size_t)(g * 8 + a) * (1024 * 512) + (size_t)pn * 256 * 512; u.B2 = W + (size_t)(g * 8 + b) * (1024 * 512) + (size_t)pn * 256 * 512; return true; }
    __device__ __forceinline__ unsigned token(const Unit& u, int R) const { const int r = R < u.nrows ? R : u.nrows - 1; return LISTC[(size_t)u.e * 65536 + u.pm * 256 + r]; }
    __device__ __forceinline__ unsigned aoff(const Unit& u, int R) const { return token(u, R) * 1024u; }
    __device__ __forceinline__ unsigned aoff2(const Unit&, int ui, int R) const { return tab[(ui % 3) * 256 + R].x * 1024u; }
    __device__ __forceinline__ u32x2 pf_load(const Unit& u) const { const int tid = threadIdx.x; u32x2 e = {0u, 0u}; if (tid < 256) e.x = token(u, tid); return e; }
    __device__ __forceinline__ void pf_store(int ui, u32x2 e) const { const int tid = threadIdx.x; if (tid < 256) tab[(ui % 3) * 256 + tid] = e; }
    __device__ __forceinline__ void prefetch(const Unit& u, int ui) const { pf_store(ui, pf_load(u)); }
};
struct EpiYC {
    static constexpr bool PERM = true, HAS_MID = false, FP8 = true; static constexpr int SCALE_W = MOE_SCALE_W, SCALE_A = (127 - 3) * 0x01010101;
    bf16_t* Y; const LAS u32x2* tab;
    __device__ __forceinline__ void operator()(const AccT& acc, const Unit& u, int wr, int wc, int fr, int fq, int ui = 0) const {
        const int c0 = u.pn * 256 + wc * 32 + 8 * fq;
#pragma unroll
        for (int ai = 0; ai < 2; ++ai)
#pragma unroll
            for (int m = 0; m < 4; ++m) { const int R = ai * 128 + wr * 64 + m * 16 + fr;
                if (R < u.nrows) { const unsigned tok = tab[(ui % 3) * 256 + R].x;
#pragma unroll
                    for (int bj = 0; bj < 2; ++bj) EPI_ST16(Y, (size_t)tok * 1024 + c0 + 128 * bj, pack8(acc[ai][bj][m][0], acc[ai][bj][m][1])); } }
    }
};
struct Args { const float* in[24]; float* out; unsigned char* ws; int ph_lo, ph_hi; };
struct Frame {
    LAS unsigned char* lds;
    unsigned char* ws;
    float* out;
    int tid, lane, wave, vcu, G;
};
#define WSP(T, off) ((T*)(F.ws + (off)))

struct TrItem { const float* W; bf16_t* dst; int ldw, nvalid, ldd; bool fp8; float sc; };
__device__ __forceinline__ void p0_tr_load(const TrItem& t, f32x4 (&v)[8], int lane) {
    const int rg = lane >> 3, c4 = (lane & 7) * 4;
#pragma unroll
    for (int i = 0; i < 8; ++i) v[i] = c4 < t.nvalid ? *(const f32x4*)(t.W + (size_t)(rg + 8 * i) * t.ldw + c4) : (f32x4){0.f, 0.f, 0.f, 0.f};
}
__device__ __forceinline__ void p0_tr_finish(const TrItem& t, const f32x4 (&v)[8], LAS float* scr, int lane) {
    const int rg = lane >> 3, c4 = (lane & 7) * 4;
#pragma unroll
    for (int i = 0; i < 8; ++i) { LAS float* d = scr + (rg + 8 * i) * 33 + c4; d[0] = v[i][0]; d[1] = v[i][1]; d[2] = v[i][2]; d[3] = v[i][3]; }
    LDS_WAIT(); asm volatile("" ::: "memory");
    const int c8 = lane & 7;
    if (t.fp8) { constexpr float SC = (float)(1 << 5);
#pragma unroll
        for (int j = 0; j < 4; ++j) { const int n = (lane >> 3) + 8 * j; const LAS float* s = scr + (8 * c8) * 33 + n;
            u32x2 o; o.x = pack4_fp8(s[0 * 33] * SC, s[1 * 33] * SC, s[2 * 33] * SC, s[3 * 33] * SC); o.y = pack4_fp8(s[4 * 33] * SC, s[5 * 33] * SC, s[6 * 33] * SC, s[7 * 33] * SC);
            *(u32x2*)((unsigned char*)t.dst + (size_t)n * t.ldd + 8 * c8) = o; }
    } else {
#pragma unroll
    for (int j = 0; j < 4; ++j) { const int n = (lane >> 3) + 8 * j; const LAS float* s = scr + (8 * c8) * 33 + n;
        const float c = t.sc; u32x4 o; o.x = cvt_pk_bf16(s[0 * 33] * c, s[1 * 33] * c); o.y = cvt_pk_bf16(s[2 * 33] * c, s[3 * 33] * c); o.z = cvt_pk_bf16(s[4 * 33] * c, s[5 * 33] * c); o.w = cvt_pk_bf16(s[6 * 33] * c, s[7 * 33] * c);
        *(u32x4*)(t.dst + (size_t)n * t.ldd + 8 * c8) = o; }
    }
    LDS_WAIT(); asm volatile("" ::: "memory");
}
#ifdef DBG_STAMP
#ifndef DBG_STAMP_BLK
#define DBG_STAMP_BLK 0
#endif
#define P0STAMP(k) do { if (blockIdx.x == DBG_STAMP_BLK && F.tid == 0) ((volatile LAS unsigned long long*)(F.lds + MISC_OFF + 128))[k] = __builtin_amdgcn_s_memrealtime(); } while (0)
#else
#define P0STAMP(k) do {} while (0)
#endif
__device__ __forceinline__ void p0_prologue(Frame& F, const Args& AR) {
    const float* c_in = AR.in[1]; const float* ada_w = AR.in[2]; const float* ada_b = AR.in[3];
    const float* w_in = AR.in[5]; const float* pool_w = AR.in[6]; const float* pool_scale = AR.in[7]; const float* cmp_pos = AR.in[8]; const float* cmp_w1 = AR.in[9];
    const float* cmp_b1 = AR.in[10]; const float* cmp_w2 = AR.in[11]; const float* w_up_pool = AR.in[12]; const float* w_up_attn = AR.in[13]; const float* w_out = AR.in[14];
    const float* wg = AR.in[20]; const float* wu = AR.in[21]; const float* wd = AR.in[22];
    if (F.vcu < 104) {
        LAS float* red = (LAS float*)F.lds;
        const int item = F.vcu;
        if (item < 96) {
            LAS float* cl = (LAS float*)F.lds;
            for (int i = F.tid; i < 32 * 256; i += 512) { const int b = i & 31, k4 = (i >> 5) * 4; const f32x4 cv = *(const f32x4*)(c_in + b * 1024 + k4); cl[(k4 + 0) * 32 + b] = cv[0]; cl[(k4 + 1) * 32 + b] = cv[1]; cl[(k4 + 2) * 32 + b] = cv[2]; cl[(k4 + 3) * 32 + b] = cv[3]; }
            __syncthreads();
            P0STAMP(15);
            const int n = item * 64 + F.lane; float acc[32];
#pragma unroll
            for (int b = 0; b < 32; ++b) acc[b] = 0.f;
            const int k0 = F.wave * 128;
#pragma unroll 4
            for (int k = k0; k < k0 + 128; ++k) { const float w = ada_w[(size_t)k * 6144 + n];
#pragma unroll
                for (int b4 = 0; b4 < 8; ++b4) { const f32x4 cv = *(const LAS f32x4*)(cl + k * 32 + 4 * b4); acc[4 * b4] += cv[0] * w; acc[4 * b4 + 1] += cv[1] * w; acc[4 * b4 + 2] += cv[2] * w; acc[4 * b4 + 3] += cv[3] * w; } }
            __syncthreads();
            P0STAMP(60);
#pragma unroll
            for (int b = 0; b < 32; ++b) red[(F.wave * 32 + b) * 64 + F.lane] = acc[b];
            __syncthreads();
            for (int o = F.tid; o < 2048; o += 512) { float s = 0.f;
#pragma unroll
                for (int w = 0; w < 8; ++w) s += red[w * 2048 + o];
                const int b = o >> 6, nn = item * 64 + (o & 63); WSP(float, WS_MOD)[b * 6144 + nn] = s + ada_b[nn]; }
            __syncthreads();
        } else {
            const int it = item - 96, i = it >> 2, n = (it & 3) * 64 + F.lane; float acc = 0.f; const int k0 = F.wave * 256;
            for (int k = k0; k < k0 + 256; ++k) acc += cmp_pos[i * 2048 + k] * cmp_w1[((size_t)i * 2048 + k) * 256 + n];
            red[F.wave * 64 + F.lane] = acc;
            __syncthreads();
            if (F.tid < 64) { float s = 0.f;
#pragma unroll
                for (int w = 0; w < 8; ++w) s += red[w * 64 + F.tid];
                const int nn = (it & 3) * 64 + F.tid; WSP(float, WS_BIAS1)[i * 256 + nn] = s + cmp_b1[i * 256 + nn]; }
            __syncthreads();
        }
    }
    P0STAMP(14);
    LAS float* scr = (LAS float*)(F.lds + F.wave * 16384);
    const int gw = F.vcu * NWAVES + F.wave, NGW = F.G * NWAVES;
    constexpr int T_IN = 16 * 128, T_GU = 32 * 512, T_D = 32 * 256, T_A = 256, T_OUT = 512, T_W1C = 512, T_W2C = 16, T_WP = 512;
    constexpr int NTR = T_IN + T_GU + T_D + T_A + T_OUT + T_W1C + T_W2C;
#define P0_DECODE(it_, T_) do { int r = (it_); T_.fp8 = false; T_.sc = 1.0f; \
        if (r < T_GU) { const int e = r >> 9, rr = r & 511, kb = rr >> 5, nb = rr & 31, n0 = 32 * nb, tile = n0 >> 8, bj = (n0 >> 7) & 1, c0 = n0 & 127; \
            T_.W = (bj ? wu : wg) + (size_t)e * 1024 * 512 + (size_t)(64 * kb) * 512 + tile * 128 + c0; T_.ldw = 512; T_.nvalid = 32; T_.fp8 = true; T_.dst = (bf16_t*)(WSP(unsigned char, WS_WGU) + (size_t)e * 1024 * 1024 + (size_t)n0 * 1024 + 64 * kb); T_.ldd = 1024; break; } r -= T_GU; \
        if (r < T_D) { const int e = r >> 8, rr = r & 255, kb = rr >> 5, nb = rr & 31; \
            T_.W = wd + (size_t)e * 512 * 1024 + (size_t)(64 * kb) * 1024 + 32 * nb; T_.ldw = 1024; T_.nvalid = 32; T_.fp8 = true; T_.dst = (bf16_t*)(WSP(unsigned char, WS_WD) + (size_t)e * 1024 * 512 + (size_t)(32 * nb) * 512 + 64 * kb); T_.ldd = 512; break; } r -= T_D; \
        if (r < T_IN) { const int kb = r >> 7, nb = r & 127, np = 32 * nb; const int pt = np >> 8; const int lt = pt < 8 ? pt + 7 : (pt < 12 ? pt - 8 : (pt < 15 ? 18 - pt : pt)); const int n0 = lt * 256 + (np & 255); int src0, nv;        \
            if (n0 < 1792) { src0 = n0; nv = 32; } else if (n0 < 3840) { const int q = n0 - 1792; src0 = 1816 + ((q >> 7) & 1) * 1024 + (q >> 8) * 128 + (q & 127); nv = 32; } else if (n0 == 3840) { src0 = 1792; nv = 24; } else { src0 = 0; nv = 0; } \
            T_.W = w_in + (size_t)(64 * kb) * 3864 + src0; T_.ldw = 3864; T_.nvalid = nv; if (n0 >= 1792 && n0 < 3840) T_.sc = -LOG2E; else if (n0 >= 512 && n0 < 1024) T_.sc = QSCALE;        T_.dst = WSP(bf16_t, WS_WIN) + (size_t)np * 1024 + 64 * kb; T_.ldd = 1024; break; } r -= T_IN; \
        if (r < T_A) { const int kb = r >> 5, nb = r & 31; \
            T_.W = w_up_attn + (size_t)(64 * kb) * 1024 + 32 * nb; T_.ldw = 1024; T_.nvalid = 32; T_.dst = WSP(bf16_t, WS_WPA) + (size_t)(32 * nb) * 1024 + 512 + 64 * kb; T_.ldd = 1024; break; } r -= T_A; \
        if (r < T_OUT) { const int kb = r >> 5, nb = r & 31; \
            T_.W = w_out + (size_t)(64 * kb) * 1024 + 32 * nb; T_.ldw = 1024; T_.nvalid = 32; T_.dst = WSP(bf16_t, WS_WOUT) + (size_t)(32 * nb) * 1024 + 64 * kb; T_.ldd = 1024; break; } r -= T_OUT; \
        if (r < T_W1C) { const int i = r >> 8, rr = r & 255, kb = rr >> 3, nb = rr & 7; \
            T_.W = cmp_w1 + (size_t)i * 2048 * 256 + (size_t)(64 * kb) * 256 + 32 * nb; T_.ldw = 256; T_.nvalid = 32; T_.fp8 = true; T_.dst = (bf16_t*)(WSP(unsigned char, WS_W1C) + (size_t)i * 256 * 2048 + (size_t)(32 * nb) * 2048 + 64 * kb); T_.ldd = 2048; break; } r -= T_W1C; \
        { const int i = r >> 3, rr = r & 7, kb = rr >> 1, nb = rr & 1; \
            T_.W = cmp_w2 + (size_t)i * 256 * 64 + (size_t)(64 * kb) * 64 + 32 * nb; T_.ldw = 64; T_.nvalid = 32; T_.dst = WSP(bf16_t, WS_W2C) + (size_t)i * 64 * 256 + (size_t)(32 * nb) * 256 + 64 * kb; T_.ldd = 256; } } while (0)
    if (gw < NTR) {
        TrItem ta, tb; f32x4 va[8], vb[8];
        P0_DECODE(gw, ta); p0_tr_load(ta, va, F.lane);
        for (int it = gw; it < NTR; it += 2 * NGW) {
            const bool hb = it + NGW < NTR; if (hb) { P0_DECODE(it + NGW, tb); p0_tr_load(tb, vb, F.lane); }
            p0_tr_finish(ta, va, scr, F.lane);
            if (!hb) break;
            const bool ha = it + 2 * NGW < NTR; if (ha) { P0_DECODE(it + 2 * NGW, ta); p0_tr_load(ta, va, F.lane); }
            p0_tr_finish(tb, vb, scr, F.lane);
            if (!ha) break;
        }
    }
#undef P0_DECODE
    for (int r = NGW - 1 - gw; r < T_WP; r += NGW) {
        const int gi = r >> 7, rr = r & 127, nblk = rr >> 3, c0 = (rr & 7) * 16, n = 64 * nblk + F.lane; float acc[16];
#pragma unroll
        for (int c = 0; c < 16; ++c) acc[c] = 0.f;
        for (int d0 = 0; d0 < 128; d0 += 16) { float wv[16];
#pragma unroll
            for (int j = 0; j < 16; ++j) wv[j] = pool_scale[gi * 128 + d0 + j] * w_up_pool[(size_t)(gi * 128 + d0 + j) * 1024 + n];
#pragma unroll
            for (int c = 0; c < 16; ++c)
#pragma unroll
                for (int q4 = 0; q4 < 4; ++q4) { const f32x4 pw = *(const f32x4*)(pool_w + (size_t)(gi * 128 + c0 + c) * 128 + d0 + 4 * q4);
                    acc[c] += pw[0] * wv[4 * q4] + pw[1] * wv[4 * q4 + 1] + pw[2] * wv[4 * q4 + 2] + pw[3] * wv[4 * q4 + 3]; } }
        u32x4 o0, o1; o0.x = cvt_pk_bf16(acc[0], acc[1]); o0.y = cvt_pk_bf16(acc[2], acc[3]); o0.z = cvt_pk_bf16(acc[4], acc[5]); o0.w = cvt_pk_bf16(acc[6], acc[7]);
        o1.x = cvt_pk_bf16(acc[8], acc[9]); o1.y = cvt_pk_bf16(acc[10], acc[11]); o1.z = cvt_pk_bf16(acc[12], acc[13]); o1.w = cvt_pk_bf16(acc[14], acc[15]);
        bf16_t* dst = WSP(bf16_t, WS_WPA) + (size_t)n * 1024 + gi * 128 + c0; *(u32x4*)dst = o0; *(u32x4*)(dst + 8) = o1;
    }
}

__device__ __forceinline__ void p1_norm_mod(Frame& F, const Args& AR) {
    const float* x = AR.in[0]; const float* g1n = AR.in[4]; const float* MOD = WSP(float, WS_MOD); bf16_t* H = WSP(bf16_t, WS_H);
    const int gw = F.vcu * NWAVES + F.wave, NGW = F.G * NWAVES;
    for (int q = gw; q < NTOK / 32; q += NGW) {
        const int b = q >> 6; f32x4 Av[4], Bv[4];
#pragma unroll
        for (int j = 0; j < 4; ++j) { const int col = 4 * F.lane + 256 * j; const f32x4 g = *(const f32x4*)(g1n + col), sc = *(const f32x4*)(MOD + b * 6144 + 1024 + col); Av[j] = g * (sc + 1.0f); Bv[j] = *(const f32x4*)(MOD + b * 6144 + col); }
        for (int r = 0; r < 32; ++r) {
            const size_t row = (size_t)q * 32 + r; const f32x4* xr = (const f32x4*)(x + row * 1024) + F.lane; f32x4 v[4]; float s = 0.f;
#pragma unroll
            for (int j = 0; j < 4; ++j) { v[j] = xr[64 * j]; s += (v[j][0] * v[j][0] + v[j][1] * v[j][1]) + (v[j][2] * v[j][2] + v[j][3] * v[j][3]); }
            const float rs = rsqrtf(wave_sum(s) * (1.0f / 1024.0f) + EPS);
            u32x2* o = (u32x2*)(H + row * 1024) + F.lane;
#pragma unroll
            for (int j = 0; j < 4; ++j) { const f32x4 h = v[j] * rs * Av[j] + Bv[j]; u32x2 w; w.x = cvt_pk_bf16(h[0], h[1]); w.y = cvt_pk_bf16(h[2], h[3]); o[64 * j] = w; }
        }
    }
}

__device__ __forceinline__ void p3_pool(Frame& F, int widx, int nw) {
    const bf16_t* U = WSP(bf16_t, WS_U); bf16_t* P = WSP(bf16_t, WS_PA);
    const int gi = F.lane >> 4, w = 2 << gi;
    for (int run = widx; run < NTOK / 8; run += nw) {
#ifdef POOL_THROTTLE
        __builtin_amdgcn_s_sleep(POOL_THROTTLE);
#endif
        const int t0 = run * 8, tb0 = t0 & 2047; const bf16_t* up = U + (size_t)t0 * 512 + F.lane * 8;
        u32x4 rw[24];
#pragma unroll
        for (int i = 0; i < 24; ++i) { const int d = 16 - i; rw[i] = (tb0 - d >= 0 && d <= w) || d <= 0 ? *(const u32x4*)(up - (ptrdiff_t)d * 512) : (u32x4){0u, 0u, 0u, 0u}; }
        float sum[8];
#pragma unroll
        for (int k = 0; k < 8; ++k) sum[k] = 0.f;
#pragma unroll
        for (int i = 0; i < 16; ++i) { f32x4 a, b; unpack8(rw[i], a, b);
#pragma unroll
            for (int k = 0; k < 4; ++k) { sum[k] += a[k]; sum[4 + k] += b[k]; } }
#pragma unroll
        for (int i = 0; i < 8; ++i) { const int tb = tb0 + i; f32x4 a, b, c, d; unpack8(rw[16 + i], a, b);
            const u32x4 old = w == 2 ? rw[14 + i] : (w == 4 ? rw[12 + i] : (w == 8 ? rw[8 + i] : rw[i])); unpack8(old, c, d);
#pragma unroll
            for (int k = 0; k < 4; ++k) { sum[k] += a[k] - c[k]; sum[4 + k] += b[k] - d[k]; }
            const float inv = 1.0f / (float)((tb + 1) < w ? (tb + 1) : w); f32x4 o0, o1;
#pragma unroll
            for (int k = 0; k < 4; ++k) { o0[k] = sum[k] * inv - a[k]; o1[k] = sum[4 + k] * inv - b[k]; }
            *(u32x4*)(P + (size_t)(t0 + i) * 1024 + F.lane * 8) = pack8(o0, o1); }
    }
}

__device__ __forceinline__ void p3_cmp2(Frame& F, int which, int pm) {
    const bf16_t* H = WSP(bf16_t, WS_HID) + (size_t)which * 8192 * 256; const bf16_t* W2 = WSP(bf16_t, WS_W2C) + (size_t)which * 64 * 256;
    const int l16 = F.lane & 15, kq = F.lane >> 4; const int rbase = pm * 256 + F.wave * 32;
    bf16x8 hf[2][8];
#pragma unroll
    for (int rb = 0; rb < 2; ++rb)
#pragma unroll
        for (int ks = 0; ks < 8; ++ks) hf[rb][ks] = *(const bf16x8*)(H + (size_t)(rbase + rb * 16 + l16) * 256 + 32 * ks + 8 * kq);
#pragma unroll
    for (int cb = 0; cb < 4; ++cb) {
        bf16x8 wf[8];
#pragma unroll
        for (int ks = 0; ks < 8; ++ks) wf[ks] = *(const bf16x8*)(W2 + (size_t)(cb * 16 + l16) * 256 + 32 * ks + 8 * kq);
#pragma unroll
        for (int rb = 0; rb < 2; ++rb) {
            f32x4 acc = (f32x4){0.f, 0.f, 0.f, 0.f};
#pragma unroll
            for (int ks = 0; ks < 8; ++ks) {
                if (which == 0) acc = __builtin_amdgcn_mfma_f32_16x16x32_bf16(wf[ks], hf[rb][ks], acc, 0, 0, 0);
                else acc = __builtin_amdgcn_mfma_f32_16x16x32_bf16(hf[rb][ks], wf[ks], acc, 0, 0, 0); }
            u32x2 w;
            if (which == 0) { const int row = rbase + rb * 16 + l16; const bool pad = (row & 127) == 127; w.x = pad ? 0u : cvt_pk_bf16(acc[0], acc[1]); w.y = pad ? 0u : cvt_pk_bf16(acc[2], acc[3]);
                *(u32x2*)(WSP(bf16_t, WS_KCMP) + (size_t)row * 64 + cb * 16 + 4 * kq) = w; }
            else { const int row0 = rbase + rb * 16 + 4 * kq; const int bg = row0 >> 7, n0 = row0 & 127, d = cb * 16 + l16; if (n0 + 3 == 127) acc[3] = 0.f;
                w.x = cvt_pk_bf16(acc[0], acc[1]); w.y = cvt_pk_bf16(acc[2], acc[3]); *(u32x2*)(WSP(bf16_t, WS_VCMPT) + (((size_t)bg * 2 + (n0 >> 6)) * 64 + d) * 64 + (n0 & 63)) = w; }
        }
    }
}

__device__ __forceinline__ void p3_bgate(Frame& F, int widx, int nw) {
    const bf16_t* H = WSP(bf16_t, WS_H); const bf16_t* W = WSP(bf16_t, WS_WIN) + (size_t)3840 * 1024; bf16_t* BG = WSP(bf16_t, WS_BG);
    LAS unsigned char* wl = F.lds;
    __syncthreads();
    for (int i = F.tid; i < 32 * 128; i += 512) { const int r = i >> 7, c = i & 127; *(LAS u32x4*)(wl + r * 2064 + c * 16) = *(const u32x4*)(W + (size_t)r * 1024 + c * 8); }
    __syncthreads();
    const int l16 = F.lane & 15, kq = F.lane >> 4;
    const LAS unsigned char* wp = wl + l16 * 2064 + 16 * kq;
    for (int grp = widx; grp < NTOK / 16; grp += nw) {
        const bf16_t* hp = H + ((size_t)grp * 16 + l16) * 1024 + 8 * kq;
        f32x4 acc0 = (f32x4){0.f, 0.f, 0.f, 0.f}, acc1 = acc0;
#pragma unroll 1
        for (int kb = 0; kb < 4; ++kb) { bf16x8 hf[8];
#pragma unroll
            for (int j = 0; j < 8; ++j) hf[j] = *(const bf16x8*)(hp + 32 * (8 * kb + j));
#pragma unroll
            for (int j = 0; j < 8; ++j) { const int ks = 8 * kb + j; const bf16x8 w0 = *(const LAS bf16x8*)(wp + 64 * ks), w1 = *(const LAS bf16x8*)(wp + 16 * 2064 + 64 * ks);
                acc0 = __builtin_amdgcn_mfma_f32_16x16x32_bf16(w0, hf[j], acc0, 0, 0, 0); acc1 = __builtin_amdgcn_mfma_f32_16x16x32_bf16(w1, hf[j], acc1, 0, 0, 0); } }
        bf16_t* o = BG + ((size_t)grp * 16 + l16) * 32 + 4 * kq; u32x2 w;
        w.x = cvt_pk_bf16(sigmoidf_(acc0[0]), sigmoidf_(acc0[1])); w.y = cvt_pk_bf16(sigmoidf_(acc0[2]), sigmoidf_(acc0[3])); *(u32x2*)o = w;
        w.x = cvt_pk_bf16(sigmoidf_(acc1[0]), sigmoidf_(acc1[1])); w.y = cvt_pk_bf16(sigmoidf_(acc1[2]), sigmoidf_(acc1[3])); *(u32x2*)(o + 16) = w;
    }
}
namespace nsa {
#ifdef DBG_STAMP
__device__ unsigned long long dbg_cyc[8];
#endif
constexpr int KB0 = 0, VB0 = 8192, PS_OFF = 65536;
__device__ __forceinline__ float pmax32(float m) { auto rr = __builtin_amdgcn_permlane32_swap(__float_as_uint(m), __float_as_uint(m), false, false); return fmaxf(__uint_as_float(rr[0]), __uint_as_float(rr[1])); }
__device__ __forceinline__ float psum32(float m) { auto rr = __builtin_amdgcn_permlane32_swap(__float_as_uint(m), __float_as_uint(m), false, false); return __uint_as_float(rr[0]) + __uint_as_float(rr[1]); }

struct Ptrs { bf16_t* Q; bf16_t* O; const char* WS; const bf16_t* BG; };

__device__ __forceinline__ void attn_unit(LAS unsigned char* lds, const Ptrs& T, const int b, const int g, const int ci, const int nbg, const int nci, int& bslot, const bool pre, const int wid, const int lane) {
    const int r32 = lane & 31, hi = lane >> 5, hh = wid >> 1, qh = wid & 1;
    const int qloc = 32 * qh + r32, t = 64 * ci + qloc, bg = b * 2 + g;
    const size_t row = (size_t)b * SEQ + t;
    const int sR = 8 * wid + (lane >> 3), sch = (lane & 7) ^ ((sR >> 1) & 7);
    const int sK = (sR & ~12) | ((sR & 4) << 1) | ((sR & 8) >> 1);
    const unsigned kst = (unsigned)(sK * 128 + sch * 16);
    const unsigned vst = (unsigned)(sR * 128 + sch * 16);
    const int xr = (r32 >> 1) & 7;
    unsigned kofs[4], vofs[4];
#pragma unroll
    for (int s = 0; s < 4; ++s) kofs[s] = (unsigned)(r32 * 128 + (((2 * s + hi) ^ xr) << 4));
#pragma unroll
    for (int c = 0; c < 4; ++c) vofs[c] = (unsigned)(r32 * 128 + (((2 * c + hi) ^ xr) << 4));
    bf16_t* qp = T.Q + row * 512 + (g * 4 + hh) * 64; bf16_t* op = T.O + row * 1024 + 512 + (g * 4 + hh) * 64;
    bf16x8 qr[4];
#pragma unroll
    for (int s = 0; s < 4; ++s) qr[s] = *(const bf16x8*)(qp + 16 * s + 8 * hi);
    const bf16_t* bgp = T.BG + row * 32 + g * 4 + hh;
    const float gate_c = bf1(bgp[0]), gate_s = bf1(bgp[8]), gate_w = bf1(bgp[16]);

    const int ntc = ci >= 16 ? 2 : 1, nsel = ci + 1, nwin = (ci < 8 ? ci : 8) + 1, nsteps = ntc + nsel + nwin;
#define NSA_ISSUE_U(bg_, ci_, ntc_, nsel_, st_, bufsel_) do { const int s_ = (st_); unsigned uk_, uv_;        \
        if (s_ < (ntc_)) { uk_ = (unsigned)WS_KCMP + (unsigned)(bg_) * 16384u + (unsigned)s_ * 8192u; uv_ = (unsigned)WS_VCMPT + (unsigned)(bg_) * 16384u + (unsigned)s_ * 8192u; } \
        else if (s_ < (ntc_) + (nsel_)) { const unsigned o_ = (unsigned)(bg_) * 262144u + (unsigned)(s_ - (ntc_)) * 8192u; uk_ = (unsigned)WS_KS + o_; uv_ = (unsigned)WS_VST + o_; } \
        else { const unsigned o_ = (unsigned)(bg_) * 262144u + (unsigned)((ci_) - (s_ - (ntc_) - (nsel_))) * 8192u; uk_ = (unsigned)WS_KW + o_; uv_ = (unsigned)WS_VWT + o_; } \
        const int kb_ = KB0 + (bufsel_) * 16384, vb_ = VB0 + (bufsel_) * 16384; \
        __builtin_amdgcn_global_load_lds((const unsigned*)(T.WS + (uk_ + kst)), (LAS unsigned*)(lds + kb_ + wid * 1024), 16, 0, 0); \
        __builtin_amdgcn_global_load_lds((const unsigned*)(T.WS + (uv_ + vst)), (LAS unsigned*)(lds + vb_ + wid * 1024), 16, 0, 0); } while (0)
#define NSA_ISSUE(st_, bufsel_) NSA_ISSUE_U(bg, ci, ntc, nsel, st_, bufsel_)

#ifdef DBG_STAMP
    unsigned long long dbg_wait_vm = 0, dbg_wait_bar = 0, dbg_s1 = 0, dbg_s2 = 0; const unsigned long long dbg_t0 = __builtin_readcyclecounter();
#endif
    float m_ref = 0.f, l_run = 0.f;
    bool first = true;
    f32x16 o0 = {}, o1 = {}, A0 = {}, A1 = {};
    unsigned selmask = 0xffffffffu; float sh0 = 1.f, sh1 = 1.f, sh2 = 1.f, sh3 = 1.f;
    bf16x8 pq0 = {}, pq1 = {};
    int vpend = VB0;
    int cpend = 0;
#define NSA_PVLOAD(v00_, v01_, v10_, v11_) do { \
        v00_ = *(const LAS bf16x8*)(lds + vpend + (cpend ? vofs[2] : vofs[0])); v01_ = *(const LAS bf16x8*)(lds + vpend + (cpend ? vofs[3] : vofs[1])); \
        v10_ = *(const LAS bf16x8*)(lds + vpend + 4096 + (cpend ? vofs[2] : vofs[0])); v11_ = *(const LAS bf16x8*)(lds + vpend + 4096 + (cpend ? vofs[3] : vofs[1])); } while (0)
#define NSA_PVMMA(v00_, v01_, v10_, v11_) do { \
        o0 = __builtin_amdgcn_mfma_f32_32x32x16_bf16(v00_, pq0, o0, 0, 0, 0); o1 = __builtin_amdgcn_mfma_f32_32x32x16_bf16(v10_, pq0, o1, 0, 0, 0); \
        o0 = __builtin_amdgcn_mfma_f32_32x32x16_bf16(v01_, pq1, o0, 0, 0, 0); o1 = __builtin_amdgcn_mfma_f32_32x32x16_bf16(v11_, pq1, o1, 0, 0, 0); } while (0)

    int bcur = bslot;
    if (!pre) { NSA_ISSUE(0, bcur); if (nsteps > 1) NSA_ISSUE(1, (bcur + 1) & 3); }
    asm volatile(".p2align 6");
    for (int st = 0; st < nsteps; ++st) {
#ifdef DBG_STAMP
        const unsigned long long tw0_ = __builtin_readcyclecounter();
#endif
        if (st + 1 < nsteps) asm volatile("s_waitcnt vmcnt(2)" ::: "memory"); else asm volatile("s_waitcnt vmcnt(0)" ::: "memory");
#ifdef DBG_STAMP
        const unsigned long long tw1_ = __builtin_readcyclecounter();
#endif
        __builtin_amdgcn_s_barrier(); asm volatile("" ::: "memory");
#ifdef DBG_STAMP
        { const unsigned long long tw2_ = __builtin_readcyclecounter(); dbg_wait_vm += tw1_ - tw0_; dbg_wait_bar += tw2_ - tw1_; }
#endif
        { const int bn = (bcur + 2) & 3; if (st + 2 < nsteps) NSA_ISSUE(st + 2, bn); }
        if (st == nsteps - 1 && nbg >= 0) {
            const int nntc = nci >= 16 ? 2 : 1, nnsel = nci + 1;
            NSA_ISSUE_U(nbg, nci, nntc, nnsel, 0, (bcur + 1) & 3); NSA_ISSUE_U(nbg, nci, nntc, nnsel, 1, (bcur + 2) & 3); }
#ifdef DBG_STAMP
        const unsigned long long ts_a = __builtin_readcyclecounter();
#endif
        const int kb = KB0 + bcur * 16384, vb = VB0 + bcur * 16384;
        if (st == ntc && ci >= 8) {
            float v[16];
#pragma unroll
            for (int jj = 0; jj < 16; ++jj) v[jj] = 0.f;
#pragma unroll
            for (int h4 = 0; h4 < 4; ++h4) { const LAS float* ps = (const LAS float*)(lds + PS_OFF) + (h4 * 64 + qloc) * 68 + 16 * hi; const f32x4 S = *(const LAS f32x4*)((const LAS float*)(lds + PS_OFF + 69632) + (h4 * 64 + qloc) * 4);
                const float s0 = hi ? S[2] : S[0], s1 = hi ? S[3] : S[1], sm = hi ? S[1] : S[0];
#pragma unroll
                for (int j4 = 0; j4 < 4; ++j4) { const f32x4 mn = *(const LAS f32x4*)(ps + 4 * j4), cr = *(const LAS f32x4*)(ps + 32 + 4 * j4);
#pragma unroll
                    for (int i = 0; i < 4; ++i) { const int jj = 4 * j4 + i; v[jj] += mn[i] * (jj < 8 ? s0 : s1) + cr[i] * (jj == 0 ? sm : (jj - 1 < 8 ? s0 : s1)); } } }
            selmask = 1u | (1u << ci) | (1u << (ci - 1));
            const int lim = ci - 2 - 16 * hi;
#pragma unroll 1
            for (int it = 0; it < 5; ++it) { float bv = -1.f; int best = 0; const unsigned smh = selmask >> (16 * hi);
#pragma unroll
                for (int jj = 0; jj < 16; ++jj) { const bool cand = (jj <= lim) && !((smh >> jj) & 1u) && (v[jj] > bv); bv = cand ? v[jj] : bv; best = cand ? 16 * hi + jj : best; }
                const auto xb = __builtin_amdgcn_permlane32_swap(__float_as_uint(bv), __float_as_uint(bv), false, false); const auto xi = __builtin_amdgcn_permlane32_swap((unsigned)best, (unsigned)best, false, false);
                const float blo = __uint_as_float(xb[0]), bhi = __uint_as_float(xb[1]);
                best = (blo >= bhi) ? (int)xi[0] : (int)xi[1];
                selmask |= 1u << best; }
        }
        int lo, hi_; bool full; bool live = true;
        if (st < ntc) { lo = 0; hi_ = ((t - 31) >> 4) - 64 * st; full = (64 * ci - 31) >= 16 * (64 * st + 63); }
        else if (st < ntc + nsel) { const int j = st - ntc; lo = 0; hi_ = t - 64 * j; full = j < ci; live = ((selmask >> j) & 1u) != 0u; }
        else { const int j = ci - (st - ntc - nsel); lo = t - 511 - 64 * j; hi_ = t - 64 * j; full = (j < ci) && (j > ci - 8); }
        int span = hi_ - lo; int koff = 8 * hi - lo; if (span < 0) { koff = -100000; span = 0; }
        const bool end_c = (st == ntc - 1), end_s = (st == ntc + nsel - 1), end_w = (st == nsteps - 1);
#ifdef DBG_STAMP
        const unsigned long long ts_b = __builtin_readcyclecounter();
#endif
#pragma unroll
        for (int kh = 0; kh < 2; ++kh) {
            bf16x8 kf0, kf1, kf2, kf3, v00, v01, v10, v11;
            kf0 = *(const LAS bf16x8*)(lds + kb + 4096 * kh + kofs[0]); kf1 = *(const LAS bf16x8*)(lds + kb + 4096 * kh + kofs[1]);
            kf2 = *(const LAS bf16x8*)(lds + kb + 4096 * kh + kofs[2]); kf3 = *(const LAS bf16x8*)(lds + kb + 4096 * kh + kofs[3]);
            NSA_PVLOAD(v00, v01, v10, v11);
            const float cval = live ? -m_ref : NEGBIG;
            f32x16 p;
#pragma unroll
            for (int r = 0; r < 16; ++r) p[r] = cval;
            __builtin_amdgcn_sched_barrier(0);
            p = __builtin_amdgcn_mfma_f32_32x32x16_bf16(kf0, qr[0], p, 0, 0, 0); p = __builtin_amdgcn_mfma_f32_32x32x16_bf16(kf1, qr[1], p, 0, 0, 0);
            p = __builtin_amdgcn_mfma_f32_32x32x16_bf16(kf2, qr[2], p, 0, 0, 0); p = __builtin_amdgcn_mfma_f32_32x32x16_bf16(kf3, qr[3], p, 0, 0, 0);
            NSA_PVMMA(v00, v01, v10, v11);
            if (!full) {
#pragma unroll
                for (int r = 0; r < 16; ++r) { const int c = 32 * kh + 16 * (r >> 3) + (r & 7); p[r] = ((unsigned)(koff + c) <= (unsigned)span) ? p[r] : NEGBIG; }
            }
            float mx;
            { float a = fmaxf(fmaxf(p[0], p[1]), p[2]), bq = fmaxf(fmaxf(p[3], p[4]), p[5]); a = fmaxf(fmaxf(a, p[6]), p[7]); bq = fmaxf(fmaxf(bq, p[8]), p[9]);
              a = fmaxf(fmaxf(a, p[10]), p[11]); bq = fmaxf(fmaxf(bq, p[12]), p[13]); a = fmaxf(fmaxf(a, p[14]), p[15]); mx = pmax32(fmaxf(a, bq)); }
            if (first || __builtin_amdgcn_ballot_w64(mx > 8.0f) != 0ull) {
                const float dl = first ? mx : fmaxf(mx, 0.f);
                m_ref += dl;
#pragma unroll
                for (int r = 0; r < 16; ++r) p[r] -= dl;
                if (!first) { const float f = fast_exp2(-dl); l_run *= f;
#pragma unroll
                    for (int r = 0; r < 16; ++r) { o0[r] *= f; o1[r] *= f; }
                    if (st < ntc) { sh0 *= f; sh1 *= f; sh2 *= f; sh3 *= f; } }
                first = false;
            }
            float ls = 0.f;
#pragma unroll
            for (int r = 0; r < 16; ++r) { p[r] = fast_exp2(p[r]); ls += p[r]; }
            l_run += ls;
            { u32x4 w0, w1;
              w0.x = cvt_pk_bf16(p[0], p[1]); w0.y = cvt_pk_bf16(p[2], p[3]); w0.z = cvt_pk_bf16(p[4], p[5]); w0.w = cvt_pk_bf16(p[6], p[7]);
              w1.x = cvt_pk_bf16(p[8], p[9]); w1.y = cvt_pk_bf16(p[10], p[11]); w1.z = cvt_pk_bf16(p[12], p[13]); w1.w = cvt_pk_bf16(p[14], p[15]);
              pq0 = __builtin_bit_cast(bf16x8, w0); pq1 = __builtin_bit_cast(bf16x8, w1); }
            vpend = vb; cpend = 2 * kh;
            if (st < ntc && ci >= 8) {
                LAS float* psw = (LAS float*)(lds + PS_OFF) + (hh * 64 + qloc) * 68 + 16 * st + 8 * kh + 2 * hi;
#pragma unroll
                for (int a2 = 0; a2 < 2; ++a2)
#pragma unroll
                    for (int jj = 0; jj < 2; ++jj) { const int r0 = 8 * a2 + 4 * jj;
                        psw[4 * a2 + jj] = p[r0] + p[r0 + 1] + p[r0 + 2] + 0.5f * p[r0 + 3];
                        if (16 * st + 8 * kh + 4 * a2 + 2 * hi + jj + 1 < 32) psw[32 + 4 * a2 + jj + 1] = 0.5f * p[r0 + 3]; }
                if (st == 0 && kh == 0 && hi == 0) psw[32] = 0.f;
                if (st == 0) { if (kh == 0) sh0 = 1.f; else sh1 = 1.f; } else { if (kh == 0) sh2 = 1.f; else sh3 = 1.f; }
            }
        }
#ifdef DBG_STAMP
        const unsigned long long ts_c = __builtin_readcyclecounter(); dbg_s1 += ts_b - ts_a; dbg_s2 += ts_c - ts_b;
#endif
        if (end_c || end_s || end_w) {
            { bf16x8 v00, v01, v10, v11; NSA_PVLOAD(v00, v01, v10, v11); NSA_PVMMA(v00, v01, v10, v11); pq0 = bf16x8{}; pq1 = bf16x8{}; }
            const float ltot = psum32(l_run); float gate = end_c ? gate_c : (end_s ? gate_s : gate_w);
#if defined(DBG_CHECK) && (DBG_CHECK == 15 || DBG_CHECK == 16 || DBG_CHECK == 17)
            if ((DBG_CHECK == 15 && !end_c) || (DBG_CHECK == 16 && !end_s) || (DBG_CHECK == 17 && !end_w)) gate = 0.f;
#endif
            const float rl = (m_ref > -1e29f) ? fast_rcp(ltot) : 0.f; const float sc = gate * rl;
#pragma unroll
            for (int r = 0; r < 16; ++r) { A0[r] += o0[r] * sc; A1[r] += o1[r] * sc; o0[r] = 0.f; o1[r] = 0.f; }
            if (end_c && ci >= 8 && hi == 0) { LAS float* pst = (LAS float*)(lds + PS_OFF + 69632) + (hh * 64 + qloc) * 4; *(LAS f32x4*)pst = (f32x4){rl * sh0, rl * sh1, rl * sh2, rl * sh3}; }
            m_ref = 0.f; l_run = 0.f; first = true;
        }
        bcur = (bcur + 1) & 3;
    }
#undef NSA_ISSUE
#undef NSA_ISSUE_U
#undef NSA_PVLOAD
#undef NSA_PVMMA
#pragma unroll
    for (int dh = 0; dh < 2; ++dh)
#pragma unroll
        for (int c = 0; c < 2; ++c) { const f32x16& A = dh ? A1 : A0; const int a0 = 2 * c, a1 = 2 * c + 1;
            const unsigned e0 = cvt_pk_bf16(A[4 * a0], A[4 * a0 + 1]), e1 = cvt_pk_bf16(A[4 * a0 + 2], A[4 * a0 + 3]), o0 = cvt_pk_bf16(A[4 * a1], A[4 * a1 + 1]), o1 = cvt_pk_bf16(A[4 * a1 + 2], A[4 * a1 + 3]);
            const auto s0 = __builtin_amdgcn_permlane32_swap(e0, o0, false, false); const auto s1 = __builtin_amdgcn_permlane32_swap(e1, o1, false, false);
            u32x4 w; w.x = s0[0]; w.y = s1[0]; w.z = s0[1]; w.w = s1[1];
            *(u32x4*)(op + 32 * dh + 16 * c + 8 * hi) = w; }
    bslot = bcur;
    __builtin_amdgcn_s_barrier(); asm volatile("" ::: "memory");
#ifdef DBG_STAMP
    if (blockIdx.x == 0 && threadIdx.x == 0) { dbg_cyc[0] += dbg_wait_vm; dbg_cyc[1] += dbg_wait_bar; dbg_cyc[3] += dbg_s1; dbg_cyc[4] += dbg_s2; dbg_cyc[2] += __builtin_readcyclecounter() - dbg_t0; }
#endif
}
}
__device__ __forceinline__ float dpp_sum16(float v) {
    v += __uint_as_float(__builtin_amdgcn_update_dpp(0, __float_as_uint(v), 0xB1, 0xF, 0xF, true));
    v += __uint_as_float(__builtin_amdgcn_update_dpp(0, __float_as_uint(v), 0x4E, 0xF, 0xF, true));
    v += __uint_as_float(__builtin_amdgcn_update_dpp(0, __float_as_uint(v), 0x141, 0xF, 0xF, true));
    v += __uint_as_float(__builtin_amdgcn_update_dpp(0, __float_as_uint(v), 0x140, 0xF, 0xF, true));
    return v;
}
__device__ __forceinline__ void p7_router(Frame& F, const Args& AR) {
    const float* X1 = AR.in[0]; const bf16_t* DL = WSP(bf16_t, WS_PA); const float* g2n = AR.in[15]; const float* rgw = AR.in[16]; const float* rgb = AR.in[17]; const float* rew = AR.in[18]; const float* reb = AR.in[19];
    const float* MOD = WSP(float, WS_MOD); unsigned char* H2 = WSP(unsigned char, WS_H2); u32x2* LIST = WSP(u32x2, WS_LIST); unsigned* LISTC = WSP(unsigned, WS_LISTC);
    unsigned* gcnt = WSP(unsigned, WS_CTL) + CW_CNT; unsigned* gcntC = WSP(unsigned, WS_CTL) + CW_CNTC;
    LAS float* Wl = (LAS float*)F.lds; LAS unsigned* lcnt = (LAS unsigned*)(F.lds + RT_OFF); LAS unsigned* lbase = lcnt + 32; LAS unsigned* lcntC = lcnt + 64; LAS unsigned* lbaseC = lcntC + 112;
    LAS unsigned short* tinfo = (LAS unsigned short*)(lbaseC + 112); LAS unsigned short* tinfoC = tinfo + 512; LAS float* twt = (LAS float*)(tinfoC + 256);
    for (int k = F.tid; k < 1024; k += 512) {
        const f32x4 gq = *(const f32x4*)(rgw + 4 * k); Wl[k] = gq[0]; Wl[1024 + k] = gq[1]; Wl[2048 + k] = gq[2]; Wl[3072 + k] = gq[3];
#pragma unroll
        for (int j4 = 0; j4 < 8; ++j4) { const f32x4 e = *(const f32x4*)(rew + 32 * k + 4 * j4); Wl[(4 + 4 * j4) * 1024 + k] = e[0]; Wl[(5 + 4 * j4) * 1024 + k] = e[1]; Wl[(6 + 4 * j4) * 1024 + k] = e[2]; Wl[(7 + 4 * j4) * 1024 + k] = e[3]; } }
    __syncthreads();
    for (int tg = F.vcu; tg < NTOK / 256; tg += F.G) {
        if (F.tid < 32) lcnt[F.tid] = 0u; else if (F.tid >= 64 && F.tid < 176) lcntC[F.tid - 64] = 0u;
        __syncthreads();
        const int b = (tg * 256) >> 11; f32x4 Av[4], Bv[4];
#pragma unroll
        for (int j = 0; j < 4; ++j) { const int col = 4 * F.lane + 256 * j; const f32x4 g = *(const f32x4*)(g2n + col), sc = *(const f32x4*)(MOD + b * 6144 + 4096 + col); Av[j] = g * (sc + 1.0f); Bv[j] = *(const f32x4*)(MOD + b * 6144 + 3072 + col); }
        f32x4 na[4], nb[4]; u32x2 da[4], db[4];
        { const size_t r0 = (size_t)tg * 256 + F.wave * 32; const f32x4* xa = (const f32x4*)(X1 + r0 * 1024) + F.lane; const u32x2* dp = (const u32x2*)(DL + r0 * 1024) + F.lane;
#pragma unroll
          for (int j = 0; j < 4; ++j) { na[j] = xa[64 * j]; nb[j] = xa[256 + 64 * j]; da[j] = dp[64 * j]; db[j] = dp[256 + 64 * j]; } }
        for (int pr = 0; pr < 16; ++pr) {
            const int lt = F.wave * 32 + 2 * pr; const size_t row = (size_t)tg * 256 + lt;
            f32x4 ha[4], hb[4]; float sa = 0.f, sb = 0.f;
#pragma unroll
            for (int j = 0; j < 4; ++j) { ha[j] = na[j] + (f32x4){bf_lo(da[j].x), bf_hi(da[j].x), bf_lo(da[j].y), bf_hi(da[j].y)}; hb[j] = nb[j] + (f32x4){bf_lo(db[j].x), bf_hi(db[j].x), bf_lo(db[j].y), bf_hi(db[j].y)}; }
            if (pr < 15) { const f32x4* xa = (const f32x4*)(X1 + (row + 2) * 1024) + F.lane; const u32x2* dp = (const u32x2*)(DL + (row + 2) * 1024) + F.lane;
#pragma unroll
                for (int j = 0; j < 4; ++j) { na[j] = xa[64 * j]; nb[j] = xa[256 + 64 * j]; da[j] = dp[64 * j]; db[j] = dp[256 + 64 * j]; } }
            { f32x4 qa = ha[0] * ha[0], qb = hb[0] * hb[0];
#pragma unroll
              for (int j = 1; j < 4; ++j) { qa = __builtin_elementwise_fma(ha[j], ha[j], qa); qb = __builtin_elementwise_fma(hb[j], hb[j], qb); }
              sa = (qa[0] + qa[1]) + (qa[2] + qa[3]); sb = (qb[0] + qb[1]) + (qb[2] + qb[3]); }
            const float ra = rsqrtf(wave_sum(sa) * (1.0f / 1024.0f) + EPS), rb = rsqrtf(wave_sum(sb) * (1.0f / 1024.0f) + EPS);
            unsigned* oa = (unsigned*)(H2 + row * 1024) + F.lane; unsigned* ob = oa + 256;
#pragma unroll
            for (int j = 0; j < 4; ++j) { ha[j] = ha[j] * ra * Av[j] + Bv[j]; hb[j] = hb[j] * rb * Av[j] + Bv[j];
                oa[64 * j] = pack4_fp8(ha[j][0], ha[j][1], ha[j][2], ha[j][3]); ob[64 * j] = pack4_fp8(hb[j][0], hb[j][1], hb[j][2], hb[j][3]); }
#define RT_DOT2(rowa, rowb, outv) do { float pa_ = 0.f, pb_ = 0.f; const LAS float* wra_ = Wl + (rowa) * 1024 + 4 * F.lane; const LAS float* wrb_ = Wl + (rowb) * 1024 + 4 * F.lane; \
                f32x4 qa_ = (f32x4){0.f, 0.f, 0.f, 0.f}, qb_ = (f32x4){0.f, 0.f, 0.f, 0.f};        \
                _Pragma("unroll") for (int jq_ = 0; jq_ < 4; ++jq_) { const f32x4 wa_ = *(const LAS f32x4*)(wra_ + 256 * jq_); const f32x4 wb_ = *(const LAS f32x4*)(wrb_ + 256 * jq_); \
                    qa_ = __builtin_elementwise_fma(ha[jq_], wa_, qa_); qb_ = __builtin_elementwise_fma(hb[jq_], wb_, qb_); } \
                pa_ = (qa_[0] + qa_[1]) + (qa_[2] + qa_[3]); pb_ = (qb_[0] + qb_[1]) + (qb_[2] + qb_[3]); \
                auto rr_ = __builtin_amdgcn_permlane32_swap(__float_as_uint(pa_), __float_as_uint(pb_), false, false); \
                float v_ = __uint_as_float(rr_[0]) + __uint_as_float(rr_[1]); v_ = dpp_sum16(v_); v_ += __shfl_xor(v_, 16); (outv) = v_; } while (0)
            float g0, g1, g2, g3;
            RT_DOT2(0, 0, g0); RT_DOT2(1, 1, g1); RT_DOT2(2, 2, g2); RT_DOT2(3, 3, g3);
            g0 += rgb[0]; g1 += rgb[1]; g2 += rgb[2]; g3 += rgb[3];
            int gidx = 0; float gm = g0; if (g1 > gm) { gm = g1; gidx = 1; } if (g2 > gm) { gm = g2; gidx = 2; } if (g3 > gm) { gm = g3; gidx = 3; }
            const float gp = fast_rcp(__expf(g0 - gm) + __expf(g1 - gm) + __expf(g2 - gm) + __expf(g3 - gm));
            const int ga = __builtin_amdgcn_readlane(gidx, 0), gb = __builtin_amdgcn_readlane(gidx, 32);
            float le[8];
#pragma unroll
            for (int j = 0; j < 8; ++j) { RT_DOT2(4 + ga * 8 + j, 4 + gb * 8 + j, le[j]); le[j] += reb[gidx * 8 + j]; }
#undef RT_DOT2
            int i0 = 0; float v0 = le[0];
#pragma unroll
            for (int j = 1; j < 8; ++j) if (le[j] > v0) { v0 = le[j]; i0 = j; }
            int i1 = -1; float v1 = -INFINITY;
#pragma unroll
            for (int j = 0; j < 8; ++j) if (j != i0 && le[j] > v1) { v1 = le[j]; i1 = j; }
            const float ex = __expf(v1 - v0); const float rx = gp * fast_rcp(1.0f + ex); const float w0 = rx, w1 = rx * ex;
            if ((F.lane & 31) == 0) {
                const int tl = lt + (F.lane >> 5); const int ia = i0 < i1 ? i0 : i1, ib = i0 < i1 ? i1 : i0; const float wa = i0 < i1 ? w0 : w1, wb = i0 < i1 ? w1 : w0; const int e0 = gidx * 8 + ia, e1 = gidx * 8 + ib;
                const int cls = gidx * 28 + ((ia * (15 - ia)) >> 1) + (ib - ia - 1);
                const unsigned p0 = __hip_atomic_fetch_add(lcnt + e0, 1u, __ATOMIC_RELAXED, __HIP_MEMORY_SCOPE_WORKGROUP), p1 = __hip_atomic_fetch_add(lcnt + e1, 1u, __ATOMIC_RELAXED, __HIP_MEMORY_SCOPE_WORKGROUP);
                const unsigned pc = __hip_atomic_fetch_add(lcntC + cls, 1u, __ATOMIC_RELAXED, __HIP_MEMORY_SCOPE_WORKGROUP);
                tinfo[2 * tl] = (unsigned short)(((unsigned)e0 << 10) | p0); tinfo[2 * tl + 1] = (unsigned short)(((unsigned)e1 << 10) | p1); tinfoC[tl] = (unsigned short)(((unsigned)cls << 8) | pc);
                twt[2 * tl] = wa; twt[2 * tl + 1] = wb;
            }
        }
        __syncthreads();
        if (F.tid < 32) lbase[F.tid] = __hip_atomic_fetch_add(gcnt + 64 * F.tid, lcnt[F.tid], __ATOMIC_RELAXED, __HIP_MEMORY_SCOPE_AGENT);
        else if (F.tid >= 64 && F.tid < 176) { const unsigned n = lcntC[F.tid - 64]; lbaseC[F.tid - 64] = n ? __hip_atomic_fetch_add(gcntC + 16 * (F.tid - 64), n, __ATOMIC_RELAXED, __HIP_MEMORY_SCOPE_AGENT) : 0u; }
        __syncthreads();
        { const unsigned inf = tinfo[F.tid]; const unsigned e = inf >> 10, p = inf & 1023u; LIST[(size_t)e * 65536 + lbase[e] + p] = (u32x2){(unsigned)(tg * 256) * 2u + (unsigned)F.tid, __float_as_uint(twt[F.tid])}; }
        if (F.tid < 256) { const unsigned inf = tinfoC[F.tid]; const unsigned c = inf >> 8, p = inf & 255u; LISTC[(size_t)c * 65536 + lbaseC[c] + p] = (unsigned)(tg * 256) + (unsigned)F.tid; }
        __syncthreads();
    }
}
__device__ __forceinline__ void moe_tables(Frame& F, LAS unsigned* tcnt, LAS unsigned* tbase) {
    const unsigned* gcnt = WSP(unsigned, WS_CTL) + CW_CNT;
    if (F.tid < 32) tcnt[F.tid] = __hip_atomic_load(gcnt + 64 * F.tid, __ATOMIC_RELAXED, __HIP_MEMORY_SCOPE_AGENT);
    __syncthreads();
    if (F.wave == 0) {
        const int l = F.lane; const unsigned own = l < 32 ? (tcnt[l] + 255u) >> 8 : 0u; unsigned inc = own;
#pragma unroll
        for (int o = 1; o < 64; o <<= 1) { const unsigned n = (unsigned)__shfl_up((int)inc, o); if (l >= o) inc += n; }
        if (l < 32) tbase[l] = inc - own;
        if (l == 31) tbase[32] = inc; }
    __syncthreads();
    if (F.tid < 32) {
        const long L = (long)F.tid * F.G + (long)F.vcu; const int total = (int)tbase[32] * 4; unsigned w = 0xffffffffu;
        if (L < total) { const int pn = (int)L & 3, tau = (int)L >> 2; int e = 0; for (int j = 1; j < 32; ++j) if ((int)tbase[j] <= tau) e = j; w = ((unsigned)e << 16) | ((unsigned)(tau - (int)tbase[e]) << 2) | (unsigned)pn; }
        tbase[40 + F.tid] = w; }
    __syncthreads();
}

__device__ __forceinline__ void moe_tables_c(Frame& F, LAS unsigned* tcntC, LAS unsigned* tbaseC, LAS unsigned* ulistC) {
    const unsigned* gcntC = WSP(unsigned, WS_CTL) + CW_CNTC;
    if (F.tid < 112) tcntC[F.tid] = __hip_atomic_load(gcntC + 16 * F.tid, __ATOMIC_RELAXED, __HIP_MEMORY_SCOPE_AGENT);
    __syncthreads();
    if (F.wave == 0) {
        const int l = F.lane; const unsigned t0 = l < 56 ? (tcntC[2 * l] + 255u) >> 8 : 0u, t1 = l < 56 ? (tcntC[2 * l + 1] + 255u) >> 8 : 0u; const unsigned own = t0 + t1; unsigned inc = own;
#pragma unroll
        for (int o = 1; o < 64; o <<= 1) { const unsigned n = (unsigned)__shfl_up((int)inc, o); if (l >= o) inc += n; }
        const unsigned exc = inc - own;
        if (l < 56) { tbaseC[2 * l] = exc; tbaseC[2 * l + 1] = exc + t0; }
        if (l == 55) tbaseC[112] = inc; }
    __syncthreads();
    if (F.tid < 32) {
        const long L = (long)F.tid * F.G + (long)F.vcu; const int total = (int)tbaseC[112] * 4; unsigned w = 0xffffffffu;
        if (L < total) { const int pn = (int)L & 3, tau = (int)L >> 2; int c = 0; for (int j = 1; j < 112; ++j) if ((int)tbaseC[j] <= tau) c = j; w = ((unsigned)c << 16) | ((unsigned)(tau - (int)tbaseC[c]) << 2) | (unsigned)pn; }
        ulistC[F.tid] = w; }
    __syncthreads();
}

__device__ __forceinline__ void moe_tables_both(Frame& F, LAS unsigned* tcnt, LAS unsigned* tbase, LAS unsigned* tcntC, LAS unsigned* tbaseC, LAS unsigned* ulistC) {
    const unsigned* gcnt = WSP(unsigned, WS_CTL) + CW_CNT; const unsigned* gcntC = WSP(unsigned, WS_CTL) + CW_CNTC;
    if (F.tid < 32) tcnt[F.tid] = __hip_atomic_load(gcnt + 64 * F.tid, __ATOMIC_RELAXED, __HIP_MEMORY_SCOPE_AGENT);
    else if (F.tid >= 64 && F.tid < 176) tcntC[F.tid - 64] = __hip_atomic_load(gcntC + 16 * (F.tid - 64), __ATOMIC_RELAXED, __HIP_MEMORY_SCOPE_AGENT);
    __syncthreads();
    if (F.wave == 0) {
        const int l = F.lane; const unsigned own = l < 32 ? (tcnt[l] + 255u) >> 8 : 0u; unsigned inc = own;
#pragma unroll
        for (int o = 1; o < 64; o <<= 1) { const unsigned n = (unsigned)__shfl_up((int)inc, o); if (l >= o) inc += n; }
        if (l < 32) tbase[l] = inc - own;
        if (l == 31) tbase[32] = inc;
    } else if (F.wave == 1) {
        const int l = F.lane; const unsigned t0 = l < 56 ? (tcntC[2 * l] + 255u) >> 8 : 0u, t1 = l < 56 ? (tcntC[2 * l + 1] + 255u) >> 8 : 0u; const unsigned own = t0 + t1; unsigned inc = own;
#pragma unroll
        for (int o = 1; o < 64; o <<= 1) { const unsigned n = (unsigned)__shfl_up((int)inc, o); if (l >= o) inc += n; }
        const unsigned exc = inc - own;
        if (l < 56) { tbaseC[2 * l] = exc; tbaseC[2 * l + 1] = exc + t0; }
        if (l == 55) tbaseC[112] = inc; }
    __syncthreads();
    if (F.tid < 32) {
        const long L = (long)F.tid * F.G + (long)F.vcu; const int total = (int)tbase[32] * 4; unsigned w = 0xffffffffu;
        if (L < total) { const int pn = (int)L & 3, tau = (int)L >> 2; int e = 0; for (int j = 1; j < 32; ++j) if ((int)tbase[j] <= tau) e = j; w = ((unsigned)e << 16) | ((unsigned)(tau - (int)tbase[e]) << 2) | (unsigned)pn; }
        tbase[40 + F.tid] = w;
    } else if (F.tid >= 64 && F.tid < 96) { const int i = F.tid - 64;
        const long L = (long)i * F.G + (long)F.vcu; const int total = (int)tbaseC[112] * 4; unsigned w = 0xffffffffu;
        if (L < total) { const int pn = (int)L & 3, tau = (int)L >> 2; int c = 0; for (int j = 1; j < 112; ++j) if ((int)tbaseC[j] <= tau) c = j; w = ((unsigned)c << 16) | ((unsigned)(tau - (int)tbaseC[c]) << 2) | (unsigned)pn; }
        ulistC[i] = w; }
    __syncthreads();
}

__device__ __forceinline__ void p10_final(Frame& F, const Args& AR) {
    const float* X = AR.in[0]; const bf16_t* DL = WSP(bf16_t, WS_PA); float* OUT = F.out; const float* fg = AR.in[23]; const float* MOD = WSP(float, WS_MOD); const bf16_t* Y = WSP(bf16_t, WS_Y);
    const int gw = F.vcu * NWAVES + F.wave, NGW = F.G * NWAVES;
    for (int q = gw; q < NTOK / 32; q += NGW) {
        const int b = q >> 6; f32x4 Gv[4], Fv[4];
#pragma unroll
        for (int j = 0; j < 4; ++j) { const int col = 4 * F.lane + 256 * j; Gv[j] = *(const f32x4*)(MOD + b * 6144 + 5120 + col); Fv[j] = *(const f32x4*)(fg + col); }
        for (int r = 0; r < 32; ++r) {
            const size_t row = (size_t)q * 32 + r; const f32x4* xr = (const f32x4*)(X + row * 1024) + F.lane; const u32x2* dr = (const u32x2*)(DL + row * 1024) + F.lane; f32x4* orow = (f32x4*)(OUT + row * 1024) + F.lane;
            const u32x2* y0 = (const u32x2*)(Y + row * 1024) + F.lane;
            f32x4 v[4]; float s = 0.f;
#pragma unroll
            for (int j = 0; j < 4; ++j) { const u32x2 a = y0[64 * j]; const f32x4 ys = (f32x4){bf_lo(a.x), bf_hi(a.x), bf_lo(a.y), bf_hi(a.y)};
                const u32x2 dd = dr[64 * j]; v[j] = xr[64 * j] + (f32x4){bf_lo(dd.x), bf_hi(dd.x), bf_lo(dd.y), bf_hi(dd.y)} + Gv[j] * ys * DBG_MOE_SCALE; s += (v[j][0] * v[j][0] + v[j][1] * v[j][1]) + (v[j][2] * v[j][2] + v[j][3] * v[j][3]); }
            const float rs = rsqrtf(wave_sum(s) * (1.0f / 1024.0f) + EPS);
#pragma unroll
            for (int j = 0; j < 4; ++j) orow[64 * j] = v[j] * rs * Fv[j];
        }
    }
}
#ifdef DBG_CHECK
#ifndef DBG_SALT
#define DBG_SALT 0
#endif
__device__ __forceinline__ float blk_sum(Frame& F, float v, LAS float* red) {
    v = wave_sum(v); __syncthreads(); if (F.lane == 0) red[F.wave] = v; __syncthreads(); float s = 0.f;
#pragma unroll
    for (int w = 0; w < 8; ++w) s += red[w]; __syncthreads(); return s;
}
__device__ __forceinline__ float dbg_sig(float x) { return 1.0f / (1.0f + __expf(-x)); }
__device__ __forceinline__ void dbg_check(Frame& F, const Args& AR, float& num, float& den) {
    LAS float* red = (LAS float*)(F.lds + 150000 - 64);
    LAS float* sh = (LAS float*)F.lds;
    const int t = (F.vcu * 257 + 31 * DBG_SALT + 5) & 65535; const int b = t >> 11, tb = t & 2047;
    const float* MOD = WSP(float, WS_MOD);
    num = 0.f; den = 0.f;
#if DBG_CHECK == 1
    { const int bb = F.vcu & 31; for (int n = F.tid; n < 6144; n += 512) { float s = AR.in[3][n]; for (int k = 0; k < 1024; ++k) s += AR.in[1][bb * 1024 + k] * AR.in[2][(size_t)k * 6144 + n];
        const float f = MOD[bb * 6144 + n]; num += (f - s) * (f - s); den += s * s; } }
#elif DBG_CHECK == 2
    { float ss = 0.f; for (int k = F.tid; k < 1024; k += 512) { const float v = AR.in[0][(size_t)t * 1024 + k]; ss += v * v; } ss = blk_sum(F, ss, red); const float r = rsqrtf(ss / 1024.f + EPS);
      for (int k = F.tid; k < 1024; k += 512) { const float ref = AR.in[0][(size_t)t * 1024 + k] * r * AR.in[4][k] * (1.f + MOD[b * 6144 + 1024 + k]) + MOD[b * 6144 + k]; const float f = bf1(WSP(bf16_t, WS_H)[(size_t)t * 1024 + k]);
        num += (f - ref) * (f - ref); den += ref * ref; } }
#elif DBG_CHECK >= 30 && DBG_CHECK < 40
    { for (int k = F.tid; k < 1024; k += 512) sh[k] = bf1(WSP(bf16_t, WS_H)[(size_t)t * 1024 + k]); __syncthreads();
      for (int n = F.tid; n < 3864; n += 512) { float s = 0.f; for (int k = 0; k < 1024; ++k) s += sh[k] * AR.in[5][(size_t)k * 3864 + n];
        float f = 0.f; bool use = false; float ref = s;
        if (n < 512) { use = DBG_CHECK == 30; f = bf1(WSP(bf16_t, WS_U)[(size_t)t * 512 + n]); }
        else if (n < 1024) { use = DBG_CHECK == 31; f = bf1(WSP(bf16_t, WS_Q)[(size_t)t * 512 + n - 512]); ref = s * QSCALE; }
        else if (n < 1792) { const int seg = (n - 1024) >> 7, cc = (n - 1024) & 127, g = cc >> 6, d = cc & 63; const size_t kidx = ((size_t)(b * 2 + g) * 2048 + tb) * 64 + d, vidx = (((size_t)(b * 2 + g) * 32 + (tb >> 6)) * 64 + d) * 64 + (tb & 63);
            if (seg == 0) { use = DBG_CHECK == 32; f = bf1(WSP(bf16_t, WS_KC)[kidx]); } else if (seg == 1) { use = DBG_CHECK == 32; f = bf1(WSP(bf16_t, WS_VC)[kidx]); }
            else if (seg == 2) { use = DBG_CHECK == 33; f = bf1(WSP(bf16_t, WS_KS)[kidx]); } else if (seg == 3) { use = DBG_CHECK == 33; f = bf1(WSP(bf16_t, WS_VST)[vidx]); }
            else if (seg == 4) { use = DBG_CHECK == 34; f = bf1(WSP(bf16_t, WS_KW)[kidx]); } else { use = DBG_CHECK == 34; f = bf1(WSP(bf16_t, WS_VWT)[vidx]); } }
        else if (DBG_CHECK == 37) { use = n < 3840; f = bf1(WSP(bf16_t, WS_MG)[(size_t)t * 2048 + (n < 3840 ? n - 1792 : 0)]); ref = dbg_sig(s); }
        else if (n < 1816) { use = DBG_CHECK == 36; f = bf1(WSP(bf16_t, WS_BG)[(size_t)t * 32 + n - 1792]); ref = dbg_sig(s); }
        else if (DBG_CHECK == 39) { use = true; f = bf1(WSP(bf16_t, WS_MG)[(size_t)t * 2048 + n - 1816]); ref = s; }
        else { use = DBG_CHECK == 35 || (DBG_CHECK == 38 && ((n - 1816) >> 8) == DBG_SALT); f = bf1(WSP(bf16_t, WS_MG)[(size_t)t * 2048 + n - 1816]); ref = dbg_sig(s); }
        if (use) { num += (f - ref) * (f - ref); den += ref * ref; } } }
#elif DBG_CHECK == 40
    { for (int i = 0; i < 16; ++i) { const int nd = (F.vcu * 16 + i + 256 * DBG_SALT) & 4095; int src = -1; if (nd < 1792) src = nd; else if (nd < 3840) src = nd + 24; else if (nd < 3864) src = nd - 3840 + 1792;
        for (int k = F.tid; k < 1024; k += 512) { const float ref = src >= 0 ? AR.in[5][(size_t)k * 3864 + src] : 0.f; const float f = bf1(WSP(bf16_t, WS_WIN)[(size_t)nd * 1024 + k]); num += (f - ref) * (f - ref); den += ref * ref; } } }
#elif DBG_CHECK == 4
    { const bf16_t* U = WSP(bf16_t, WS_U); for (int c = F.tid; c < 512; c += 512) { const int w = 2 << (c >> 7); float s = 0.f; int cnt = 0; for (int d = 0; d < w; ++d) if (tb - d >= 0) { s += bf1(U[(size_t)(t - d) * 512 + c]); ++cnt; }
        const float ref = s / (float)cnt - bf1(U[(size_t)t * 512 + c]); const float f = bf1(WSP(bf16_t, WS_PA)[(size_t)t * 1024 + c]); num += (f - ref) * (f - ref); den += ref * ref; } }
#elif DBG_CHECK == 5
    { const bf16_t* PA = WSP(bf16_t, WS_PA); { const int o = F.tid, gi = o >> 7, d = o & 127; float s = 0.f; for (int c = 0; c < 128; ++c) s += bf1(PA[(size_t)t * 1024 + gi * 128 + c]) * AR.in[6][(size_t)(gi * 128 + c) * 128 + d]; sh[o] = s * AR.in[7][o]; } __syncthreads();
      for (int n = F.tid; n < 1024; n += 512) { float s = 0.f; for (int k = 0; k < 512; ++k) s += sh[k] * AR.in[12][(size_t)k * 1024 + n]; float s2 = 0.f; for (int k = 0; k < 512; ++k) s2 += bf1(PA[(size_t)t * 1024 + 512 + k]) * AR.in[13][(size_t)k * 1024 + n];
        const float gb = bf1(WSP(bf16_t, WS_MG)[(size_t)t * 2048 + 1024 + n]); const float ref = s * bf1(WSP(bf16_t, WS_MG)[(size_t)t * 2048 + n]) * gb + s2 * gb;
        const float f = bf1(WSP(bf16_t, WS_H)[(size_t)t * 1024 + n]); num += (f - ref) * (f - ref); den += ref * ref; } }
#elif DBG_CHECK == 7
    { for (int n = F.tid; n < 1024; n += 512) { float s = 0.f; for (int k = 0; k < 1024; ++k) s += bf1(WSP(bf16_t, WS_H)[(size_t)t * 1024 + k]) * AR.in[14][(size_t)k * 1024 + n];
        const float ref = MOD[b * 6144 + 2048 + n] * s; const float f = bf1(WSP(bf16_t, WS_PA)[(size_t)t * 1024 + n]); num += (f - ref) * (f - ref); den += ref * ref; } }
#elif DBG_CHECK == 8
    { float ss = 0.f; for (int k = F.tid; k < 1024; k += 512) { const float v = AR.in[0][(size_t)t * 1024 + k] + bf1(WSP(bf16_t, WS_PA)[(size_t)t * 1024 + k]); ss += v * v; } ss = blk_sum(F, ss, red); const float r = rsqrtf(ss / 1024.f + EPS);
      for (int k = F.tid; k < 1024; k += 512) { const float ref = (AR.in[0][(size_t)t * 1024 + k] + bf1(WSP(bf16_t, WS_PA)[(size_t)t * 1024 + k])) * r * AR.in[15][k] * (1.f + MOD[b * 6144 + 4096 + k]) + MOD[b * 6144 + 3072 + k]; const float f = bf1(WSP(bf16_t, WS_H2)[(size_t)t * 1024 + k]);
        num += (f - ref) * (f - ref); den += ref * ref; } }
#elif DBG_CHECK == 9 || DBG_CHECK == 10 || DBG_CHECK == 12 || DBG_CHECK == 13
    { for (int k = F.tid; k < 1024; k += 512) sh[k] = bf1(WSP(bf16_t, WS_H2)[(size_t)t * 1024 + k]); __syncthreads();
      LAS float* lgt = sh + 1024;
      if (F.tid < 36) { float s = 0.f; if (F.tid < 4) { for (int k = 0; k < 1024; ++k) s += sh[k] * AR.in[16][k * 4 + F.tid]; s += AR.in[17][F.tid]; } else { const int j = F.tid - 4; for (int k = 0; k < 1024; ++k) s += sh[k] * AR.in[18][k * 32 + j]; s += AR.in[19][j]; } lgt[F.tid] = s; }
      __syncthreads();
      int gidx = 0; float gm = lgt[0]; for (int j = 1; j < 4; ++j) if (lgt[j] > gm) { gm = lgt[j]; gidx = j; }
      float gs = 0.f; for (int j = 0; j < 4; ++j) gs += __expf(lgt[j] - gm); const float gp = 1.f / gs;
      int i0 = 0; float v0 = lgt[4 + gidx * 8]; for (int j = 1; j < 8; ++j) if (lgt[4 + gidx * 8 + j] > v0) { v0 = lgt[4 + gidx * 8 + j]; i0 = j; }
      int i1 = -1; float v1 = -INFINITY; for (int j = 0; j < 8; ++j) if (j != i0 && lgt[4 + gidx * 8 + j] > v1) { v1 = lgt[4 + gidx * 8 + j]; i1 = j; }
      const float ex = __expf(v1 - v0); const float wk0 = gp / (1.f + ex), wk1 = gp * ex / (1.f + ex); const int ek0 = gidx * 8 + i0, ek1 = gidx * 8 + i1;
      if (DBG_CHECK == 12 && F.tid == 0) { const float f0 = WSP(float, WS_SLOTW)[2 * t], f1 = WSP(float, WS_SLOTW)[2 * t + 1]; num += (f0 - wk0) * (f0 - wk0) + (f1 - wk1) * (f1 - wk1); den += wk0 * wk0 + wk1 * wk1; }
      if (DBG_CHECK == 13) {
          const unsigned* LIST = WSP(unsigned, WS_LIST); const unsigned* gc = WSP(unsigned, WS_CTL) + CW_CNT; float found0 = 0.f, found1 = 0.f;
          const unsigned c0 = gc[64 * ek0], c1 = gc[64 * ek1];
          for (unsigned i = F.tid; i < c0; i += 512) if (LIST[(size_t)ek0 * 65536 + i] == (unsigned)(2 * t)) found0 = 1.f;
          for (unsigned i = F.tid; i < c1; i += 512) if (LIST[(size_t)ek1 * 65536 + i] == (unsigned)(2 * t + 1)) found1 = 1.f;
          num -= found0 + found1; if (F.tid == 0) { num += 2.f; den += 2.f; } }
      LAS float* he = sh + 1280;
      if (DBG_CHECK >= 12) goto dbg_done;
      _Pragma("unroll 1") for (int k2 = 0; k2 < 2; ++k2) { const int e = k2 ? ek1 : ek0; const float wkk = k2 ? wk1 : wk0; __syncthreads();
        { const int j = F.tid; float a = 0.f, u = 0.f; for (int k = 0; k < 1024; ++k) { a += sh[k] * AR.in[20][((size_t)e * 1024 + k) * 512 + j]; u += sh[k] * AR.in[21][((size_t)e * 1024 + k) * 512 + j]; }
          const float hv = a * dbg_sig(a) * u; he[j] = hv;
          if (DBG_CHECK == 10) { const float f = bf1(WSP(bf16_t, WS_HE)[(size_t)(2 * t + k2) * 512 + j]); num += (f - hv) * (f - hv); den += hv * hv; } }
        __syncthreads();
        if (DBG_CHECK == 9) for (int n = F.tid; n < 1024; n += 512) { float s = 0.f; for (int j = 0; j < 512; ++j) s += he[j] * AR.in[22][((size_t)e * 512 + j) * 1024 + n]; const float ref = s * wkk;
            const float f = bf1(WSP(bf16_t, WS_Y)[(size_t)(2 * t + k2) * 1024 + n]); num += (f - ref) * (f - ref); den += ref * ref; } } }
#elif DBG_CHECK == 11
    { const int bg = F.vcu & 63, n = (F.vcu * 7 + DBG_SALT) % 127; LAS float* hid = sh + 2048;
      for (int which = 0; which < 2; ++which) { const bf16_t* KV = WSP(bf16_t, which ? WS_VC : WS_KC) + ((size_t)bg * 2048 + 16 * n) * 64; __syncthreads();
        for (int k = F.tid; k < 2048; k += 512) sh[k] = bf1(KV[k]) + AR.in[8][which * 2048 + k]; __syncthreads();
        if (F.tid < 256) { float s = AR.in[10][which * 256 + F.tid]; for (int k = 0; k < 2048; ++k) s += sh[k] * AR.in[9][((size_t)which * 2048 + k) * 256 + F.tid]; const float u = 0.7978845608f * (s + 0.044715f * s * s * s); hid[F.tid] = 0.5f * s * (1.f + tanhf(u)); }
        __syncthreads();
        if (F.tid < 64) { float s = 0.f; for (int j = 0; j < 256; ++j) s += hid[j] * AR.in[11][((size_t)which * 256 + j) * 64 + F.tid];
            const float f = which ? bf1(WSP(bf16_t, WS_VCMPT)[(((size_t)bg * 2 + (n >> 6)) * 64 + F.tid) * 64 + (n & 63)]) : bf1(WSP(bf16_t, WS_KCMP)[((size_t)bg * 128 + n) * 64 + F.tid]); num += (f - s) * (f - s); den += s * s; } } }
#elif DBG_CHECK == 14 || DBG_CHECK == 15 || DBG_CHECK == 16 || DBG_CHECK == 17
    { const bf16_t* Qb = WSP(bf16_t, WS_Q); const bf16_t* ATT = WSP(bf16_t, WS_PA); const bf16_t* BG = WSP(bf16_t, WS_BG);
      LAS float* sc = sh;
      LAS float* pc = sh + 2048;
      LAS float* qv = sh + 2560;
      LAS float* oc = sh + 2624;
      LAS float* psv = sh + 3136;
      LAS unsigned* selm = (LAS unsigned*)(sh + 3200);
      const int cur = tb >> 6;
      for (int g = 0; g < 2; ++g) { const int bg = b * 2 + g;
        const bf16_t* KCMP = WSP(bf16_t, WS_KCMP) + (size_t)bg * 128 * 64; const bf16_t* VCT = WSP(bf16_t, WS_VCMPT) + (size_t)bg * 64 * 128;
        const bf16_t* KS = WSP(bf16_t, WS_KS) + (size_t)bg * 2048 * 64; const bf16_t* VST = WSP(bf16_t, WS_VST) + (size_t)bg * 64 * 2048;
        const bf16_t* KW = WSP(bf16_t, WS_KW) + (size_t)bg * 2048 * 64; const bf16_t* VWT = WSP(bf16_t, WS_VWT) + (size_t)bg * 64 * 2048;
        for (int hh = 0; hh < 4; ++hh) { const int hq = g * 4 + hh; __syncthreads();
            if (F.tid < 64) qv[F.tid] = bf1(Qb[(size_t)t * 512 + hq * 64 + F.tid]); __syncthreads();
            float s = -INFINITY; const bool valid = F.tid < 127 && (16 * F.tid + 31 <= tb);
            if (valid) { s = 0.f; for (int d = 0; d < 64; ++d) s += qv[d] * bf1(KCMP[F.tid * 64 + d]); }
            float m;
            { float mm = s; for (int o = 1; o < 64; o <<= 1) mm = fmaxf(mm, __shfl_xor(mm, o)); __syncthreads(); if (F.lane == 0) red[F.wave] = mm; __syncthreads(); mm = red[0]; for (int w = 1; w < 8; ++w) mm = fmaxf(mm, red[w]); __syncthreads(); m = mm; }
            const float e = valid ? exp2f(s - m) : 0.f; const float l = blk_sum(F, e, red);
            if (F.tid < 128) pc[hh * 128 + F.tid] = l > 0.f ? e / l : 0.f; __syncthreads();
            if (F.tid < 64) { float o = 0.f; for (int n = 0; n < 127; ++n) o += pc[hh * 128 + n] * bf1(VCT[((n >> 6) * 64 + F.tid) * 64 + (n & 63)]); oc[hq * 64 + F.tid] = o; } __syncthreads(); }
        if (F.tid < 32) { const int j = F.tid; float ps = 0.f; for (int hh = 0; hh < 4; ++hh) for (int n = 0; n < 127; ++n) { int ov = (16 * n + 32 < 64 * j + 64 ? 16 * n + 32 : 64 * j + 64) - (16 * n > 64 * j ? 16 * n : 64 * j); if (ov < 0) ov = 0; ps += pc[hh * 128 + n] * (float)ov * (1.f / 32.f); } psv[j] = ps; }
        __syncthreads();
        if (F.tid == 0) { unsigned msk = 0u; for (int it = 0; it < 8; ++it) { int best = -1; float bv = -INFINITY; for (int j = 0; j < 32; ++j) { if ((msk >> j) & 1u) continue; const bool forced = (j == 0) || (j == cur) || (j == cur - 1); const float scv = forced ? 1e4f : (j <= cur ? psv[j] : NEGBIG); if (scv > bv) { bv = scv; best = j; } } msk |= 1u << best; } selm[0] = msk; }
        __syncthreads();
        const unsigned msk = selm[0];
        for (int hh = 0; hh < 4; ++hh) { const int hq = g * 4 + hh; __syncthreads();
            if (F.tid < 64) qv[F.tid] = bf1(Qb[(size_t)t * 512 + hq * 64 + F.tid]); __syncthreads();
            float osel = 0.f, owin = 0.f;
            for (int br = 1; br < 3; ++br) { const bf16_t* Kb = br == 1 ? KS : KW; const bf16_t* Vb = br == 1 ? VST : VWT; float mloc = -INFINITY;
                for (int k = F.tid; k < 2048; k += 512) { const bool v = br == 1 ? (((msk >> (k >> 6)) & 1u) && k <= tb) : (k <= tb && k > tb - 512); float s = -INFINITY; if (v) { s = 0.f; for (int d = 0; d < 64; ++d) s += qv[d] * bf1(Kb[(size_t)k * 64 + d]); } sc[k] = s; mloc = fmaxf(mloc, s); }
                { float mm = mloc; for (int o = 1; o < 64; o <<= 1) mm = fmaxf(mm, __shfl_xor(mm, o)); __syncthreads(); if (F.lane == 0) red[F.wave] = mm; __syncthreads(); mm = red[0]; for (int w = 1; w < 8; ++w) mm = fmaxf(mm, red[w]); __syncthreads(); mloc = mm; }
                float lsum = 0.f; for (int k = F.tid; k < 2048; k += 512) { const float e = sc[k] > -INFINITY ? exp2f(sc[k] - mloc) : 0.f; sc[k] = e; lsum += e; } lsum = blk_sum(F, lsum, red);
                if (F.tid < 64) { float o = 0.f; for (int k = 0; k <= tb; ++k) o += sc[k] * bf1(Vb[((size_t)(k >> 6) * 64 + F.tid) * 64 + (k & 63)]); o /= lsum; if (br == 1) osel = o; else owin = o; } __syncthreads(); }
            if (F.tid < 64) { const float g0 = bf1(BG[(size_t)t * 32 + hq]), g1 = bf1(BG[(size_t)t * 32 + 8 + hq]), g2 = bf1(BG[(size_t)t * 32 + 16 + hq]);
                float ref = 0.f; if (DBG_CHECK == 14 || DBG_CHECK == 15) ref += g0 * oc[hq * 64 + F.tid]; if (DBG_CHECK == 14 || DBG_CHECK == 16) ref += g1 * osel; if (DBG_CHECK == 14 || DBG_CHECK == 17) ref += g2 * owin;
                const float f = bf1(ATT[(size_t)t * 1024 + 512 + hq * 64 + F.tid]); num += (f - ref) * (f - ref); den += ref * ref; } } } }
#endif
    dbg_done:
    num = blk_sum(F, num, red); den = blk_sum(F, den, red);
}
#endif
#define XB_TMO      128
#define XB_XCNT(j)  (256  + 64 * (j))
#define XB_XSUB(j)  (1280 + 64 * (j))
#define XB_XGEN(j)  (2304 + 64 * (j))
#define XB_TOP      3328
#define XB_TOPGEN   3392
#define XCD_BAR_WORDS 3456
#define XB_SPIN_CAP (1u << 22)
__device__ __forceinline__ unsigned xb_ld(unsigned* p)              { return __hip_atomic_load(p, __ATOMIC_RELAXED, __HIP_MEMORY_SCOPE_AGENT); }
__device__ __forceinline__ unsigned xb_add(unsigned* p, unsigned v) { return __hip_atomic_fetch_add(p, v, __ATOMIC_RELAXED, __HIP_MEMORY_SCOPE_AGENT); }
__device__ __forceinline__ unsigned xb_xcc_id() { return (unsigned)__builtin_amdgcn_s_getreg((3 << 11) | 20) & 0xFu; }
#define XB_SPIN(cond, bar) do { unsigned _sp = 0; while (cond) { __builtin_amdgcn_s_sleep(1); \
    if ((++_sp & 255u) == 0u) { if (xb_ld(&(bar)[XB_TMO])) break; if (_sp > XB_SPIN_CAP) { atomicAdd(&(bar)[XB_TMO], 1u); break; } } } } while (0)
struct XcdBarrier { unsigned* bar; unsigned x; volatile LAS unsigned* st; };
__device__ __forceinline__ XcdBarrier xcd_barrier_post(unsigned* bar, volatile LAS unsigned* st) {
    XcdBarrier b; b.bar = bar; b.x = xb_xcc_id(); b.st = st;
    if (threadIdx.x == 0) (void)xb_add(&bar[XB_XCNT(b.x)], 1u);
    return b;
}
__device__ __forceinline__ void xcd_barrier_complete(unsigned* bar, unsigned x, unsigned& nloc, unsigned& nx) {
    const unsigned G = gridDim.x * gridDim.y * gridDim.z;
    unsigned sum, cnt, mine, sp = 0u;
    for (;;) {
        sum = 0u; cnt = 0u; mine = 0u;
#pragma unroll
        for (unsigned j = 0; j < 16; ++j) { const unsigned c = xb_ld(&bar[XB_XCNT(j)]); sum += c; cnt += (c > 0u) ? 1u : 0u; mine = (j == x) ? c : mine; }
        if (sum == G) break;
        __builtin_amdgcn_s_sleep(1);
        if ((++sp & 255u) == 0u) { if (xb_ld(&bar[XB_TMO])) break; if (sp > XB_SPIN_CAP) { atomicAdd(&bar[XB_TMO], 1u); break; } }
    }
    nloc = mine > 0u ? mine : 1u; nx = cnt > 0u ? cnt : 1u;
}
__device__ __forceinline__ void xcd_barrier(const XcdBarrier& b) {
    asm volatile("s_waitcnt vmcnt(0)" ::: "memory");
    __syncthreads();
    if (threadIdx.x == 0) {
        unsigned* bar = b.bar;
        __builtin_amdgcn_s_waitcnt(0);
        unsigned nloc = b.st[0], nx = b.st[1];
        if (nloc == 0u) { xcd_barrier_complete(bar, b.x, nloc, nx); b.st[0] = nloc; b.st[1] = nx; }
        const unsigned old = xb_add(&bar[XB_XSUB(b.x)], 1u);
        const unsigned gen = old / nloc;
        if (old + 1u == (gen + 1u) * nloc) {
            __builtin_amdgcn_fence(__ATOMIC_RELEASE, "agent");
            asm volatile("s_waitcnt vmcnt(0)" ::: "memory");
            const unsigned og = xb_add(&bar[XB_TOP], 1u);
            const unsigned tg = og / nx;
            if (og + 1u == (tg + 1u) * nx) xb_add(&bar[XB_TOPGEN], 1u);
            else XB_SPIN(xb_ld(&bar[XB_TOPGEN]) == tg, bar);
            __builtin_amdgcn_fence(__ATOMIC_ACQUIRE, "agent");
            xb_add(&bar[XB_XGEN(b.x)], 1u);
            asm volatile("s_waitcnt vmcnt(0)" ::: "memory");
        } else {
            XB_SPIN(xb_ld(&bar[XB_XGEN(b.x)]) == gen, bar);
            __builtin_amdgcn_fence(__ATOMIC_ACQUIRE, "agent");
            asm volatile("s_waitcnt vmcnt(0)" ::: "memory");
        }
    }
    __syncthreads();
}

__device__ __forceinline__ void stagger(int group, int ticks_per_group) {
    const unsigned long long t0 = __builtin_amdgcn_s_memrealtime(); const unsigned long long want = (unsigned long long)(group * ticks_per_group);
    while (__builtin_amdgcn_s_memrealtime() - t0 < want) __builtin_amdgcn_s_sleep(8);
}
#ifndef MK_PER_PHASE
#define MK_PER_PHASE 0
#endif
constexpr int N_PHASES = 11;
__global__ void __launch_bounds__(NWAVES * 64, 2) mk_fwd(Args args) {
    extern __shared__ __attribute__((aligned(16))) unsigned char lds_raw[];
    Frame F;
    F.lds = (LAS unsigned char*)lds_raw; F.ws = args.ws; F.out = args.out;
    F.tid = threadIdx.x; F.lane = F.tid & 63; F.wave = __builtin_amdgcn_readfirstlane(F.tid >> 6);
    F.G = gridDim.x; { const int bx = blockIdx.x; F.vcu = (F.G % 8 == 0) ? (bx % 8) * (F.G / 8) + bx / 8 : bx; }
    volatile LAS unsigned* MISC = (volatile LAS unsigned*)(F.lds + MISC_OFF);
    if (F.tid < 16) MISC[F.tid] = 0u;
    __syncthreads();
    XcdBarrier bar; bar.bar = WSP(unsigned, WS_CTL) + CW_BAR; bar.x = 0; bar.st = MISC + 8;
    if (!MK_PER_PHASE) bar = xcd_barrier_post(WSP(unsigned, WS_CTL) + CW_BAR, MISC + 8);
    const int lo = args.ph_lo, hi = args.ph_hi;
#ifdef DBG_LAST
#define IN(k) (lo <= (k) && (k) < hi && ((k) <= DBG_LAST || (k) == 10))
#else
#define IN(k) (lo <= (k) && (k) < hi)
#endif
#define SEAM(k) do { if (lo <= (k) && (k) + 1 < hi) xcd_barrier(bar); } while (0)
    LAS unsigned char* ring = F.lds;
#ifdef DBG_STAMP
#ifndef DBG_STAMP_OFF
#define DBG_STAMP_OFF 0.0f
#endif
    volatile LAS unsigned long long* stamps = (volatile LAS unsigned long long*)(F.lds + MISC_OFF + 128);
#ifndef DBG_STAMP_BLK
#define DBG_STAMP_BLK 0
#endif
#define STAMP(k) do { if (blockIdx.x == DBG_STAMP_BLK && F.tid == 0) { stamps[k] = __builtin_amdgcn_s_memrealtime(); stamps[16 + (k)] = __builtin_readcyclecounter(); } } while (0)
#else
#define STAMP(k) do {} while (0)
#endif
    STAMP(0);

    if (IN(0)) { p0_prologue(F, args); }
    STAMP(32); SEAM(0); STAMP(1);
    if (IN(1)) { p1_norm_mod(F, args); }
    STAMP(33); SEAM(1); STAMP(2);
    if (IN(2)) {
        SchedPlain S; S.A = (const char*)WSP(bf16_t, WS_H); S.Bt = (const char*)WSP(bf16_t, WS_WIN); S.lda = 2048u; S.K = 1024; S.so.init(NTOK, 3840, F.G, (int)blockIdx.x);
        EpiG1 E{WSP(bf16_t, WS_U), WSP(bf16_t, WS_Q), WSP(bf16_t, WS_KC), WSP(bf16_t, WS_VC), WSP(bf16_t, WS_KS), WSP(bf16_t, WS_VST), WSP(bf16_t, WS_KW), WSP(bf16_t, WS_VWT), WSP(bf16_t, WS_MG), WSP(bf16_t, WS_BG)};
        pg8::gemm_phase<EpiG1, SchedPlain>(ring, 1024, S, E);
#ifdef PROBE_G1
#if PROBE_G1 == 1
        { EpiProbe EP{(float*)(F.ws + WS_CTL + 32768)}; pg8::gemm_phase<EpiProbe, SchedPlain>(ring, 1024, S, EP); }
#elif PROBE_G1 >= 3
        { EpiProbeS<PROBE_G1> EP{WSP(bf16_t, WS_PA)}; pg8::gemm_phase<EpiProbeS<PROBE_G1>, SchedPlain>(ring, 1024, S, EP); }
#else
        pg8::gemm_phase<EpiG1, SchedPlain>(ring, 1024, S, E);
#endif
#endif
    }
    STAMP(34); SEAM(2); STAMP(3);
    if (IN(3)) {
        const int ncmp = F.G > 64 ? 64 : 0;
        const int rid = (int)blockIdx.x;
        if (rid < 64) {
            for (int c = rid; c < 64; c += F.G) {
                SchedCmp S{(const char*)WSP(bf16_t, WS_KC), (const char*)WSP(bf16_t, WS_VC), (const char*)WSP(bf16_t, WS_W1C), c};
                EpiHid E{WSP(bf16_t, WS_HID), WSP(float, WS_BIAS1)};
                pg8::gemm_phase<EpiHid, SchedCmp>(ring, 1024, S, E);
                VM_WAIT(); __syncthreads();
                p3_cmp2(F, c >> 5, c & 31);
                __syncthreads();
            }
        }
        STAMP(13);
        if (rid >= ncmp) { p3_pool(F, (rid - ncmp) * NWAVES + F.wave, (F.G - ncmp) * NWAVES); p3_bgate(F, (rid - ncmp) * NWAVES + F.wave, (F.G - ncmp) * NWAVES); }
    }
    STAMP(35); SEAM(3); STAMP(4);
    if (IN(4)) {
                bf16_t* attn_out = WSP(bf16_t, WS_PA);
        const nsa::Ptrs T{WSP(bf16_t, WS_Q), attn_out, (const char*)F.ws, WSP(bf16_t, WS_BG)};
        int bslot = 0;
        if (F.G == 256) {
            const int xcd = F.vcu >> 5, r = F.vcu & 31;
            for (int k = 0; k < 4; ++k) { const int bg = xcd * 8 + 2 * k + (r >> 4); const int s = ((r & 15) + 4 * k) & 15;
                const int bgn = xcd * 8 + 2 * (k + 1) + (r >> 4), sn = ((r & 15) + 4 * (k + 1)) & 15;
                nsa::attn_unit(ring, T, bg >> 1, bg & 1, 31 - s, bg, s, bslot, k > 0, F.wave, F.lane);
                nsa::attn_unit(ring, T, bg >> 1, bg & 1, s, k < 3 ? bgn : -1, 31 - sn, bslot, true, F.wave, F.lane); }
        } else {
            for (int u = F.vcu; u < 2048; u += F.G) { const int bg = u >> 5, ci = u & 31; nsa::attn_unit(ring, T, bg >> 1, bg & 1, ci, -1, 0, bslot, false, F.wave, F.lane); }
        }
    }
    STAMP(12); STAMP(36); SEAM(4); STAMP(5);
    if (IN(5)) {
        SchedPlain S; S.A = (const char*)WSP(bf16_t, WS_PA); S.Bt = (const char*)WSP(bf16_t, WS_WPA); S.lda = 2048u; S.K = 1024; S.so.init(NTOK, 1024, F.G, (int)blockIdx.x);
        EpiMix E{WSP(bf16_t, WS_MG), WSP(bf16_t, WS_H)}; pg8::gemm_phase<EpiMix, SchedPlain>(ring, 1024, S, E);
    }
    STAMP(37); SEAM(5); STAMP(6);
    if (IN(6)) {
        SchedPlain S; S.A = (const char*)WSP(bf16_t, WS_H); S.Bt = (const char*)WSP(bf16_t, WS_WOUT); S.lda = 2048u; S.K = 1024; S.so.init(NTOK, 1024, F.G, (int)blockIdx.x);
        EpiDelta E{WSP(float, WS_MOD), WSP(bf16_t, WS_PA)}; pg8::gemm_phase<EpiDelta, SchedPlain>(ring, 1024, S, E);
    }
    STAMP(38); SEAM(6); STAMP(7);
    if (IN(7)) { p7_router(F, args); }
    STAMP(39); SEAM(7); STAMP(8);
    LAS unsigned* tcnt = (LAS unsigned*)(F.lds + RT_OFF); LAS unsigned* tbase = tcnt + 32; LAS u32x2* mtab = (LAS u32x2*)(F.lds + RING_BYTES);
    if (IN(8)) {
        { LAS unsigned* tcntC = tcnt + 128; LAS unsigned* tbaseC = tcntC + 112; LAS unsigned* ulistC = tbaseC + 120;
          if (hi > 9) moe_tables_both(F, tcnt, tbase, tcntC, tbaseC, ulistC); else moe_tables(F, tcnt, tbase); }
        SchedMoe S{(const char*)WSP(unsigned char, WS_H2), (const char*)WSP(unsigned char, WS_WGU), WSP(u32x2, WS_LIST), tcnt, tbase, 1024u, (size_t)1024 * 1024, 512, F.G, (int)blockIdx.x, true, mtab};
        EpiHE E{WSP(unsigned char, WS_HE), mtab}; pg8::gemm_phase<EpiHE, SchedMoe>(ring, 512, S, E);
    }
    STAMP(40); SEAM(8); STAMP(9);
    if (IN(9)) {
        LAS unsigned* tcntC = tcnt + 128; LAS unsigned* tbaseC = tcntC + 112; LAS unsigned* ulistC = tbaseC + 120;
        if (lo == 9) moe_tables_c(F, tcntC, tbaseC, ulistC);
        SchedPair S{(const char*)WSP(unsigned char, WS_HE), (const char*)WSP(unsigned char, WS_WD), WSP(unsigned, WS_LISTC), tcntC, ulistC, mtab};
        EpiYC E{WSP(bf16_t, WS_Y), mtab}; pg8::gemm_phase<EpiYC, SchedPair>(ring, 512, S, E);
    }
    STAMP(41); SEAM(9); STAMP(10);
#ifdef DBG_CHECK
    if (IN(10)) {
        float num, den; dbg_check(F, args, num, den);
        float* acc2 = (float*)(WSP(unsigned, WS_CTL) + 12288);
        if (F.tid == 0) { atomicAdd(acc2, num); atomicAdd(acc2 + 1, den); }
        xcd_barrier(bar);
        const float tn = __hip_atomic_load(acc2, __ATOMIC_RELAXED, __HIP_MEMORY_SCOPE_AGENT), td = __hip_atomic_load(acc2 + 1, __ATOMIC_RELAXED, __HIP_MEMORY_SCOPE_AGENT);
        float E = 20.0f * sqrtf(tn / fmaxf(td, 1e-30f)); if (!(E < 50.f)) E = 50.f;
        const float* x = args.in[0]; const float* fg = args.in[23]; const int gw = F.vcu * NWAVES + F.wave, NGW = F.G * NWAVES;
        for (int row = gw; row < NTOK; row += NGW) { const f32x4* xr = (const f32x4*)(x + (size_t)row * 1024) + F.lane; f32x4 v[4]; float s = 0.f;
            for (int j = 0; j < 4; ++j) { v[j] = xr[64 * j]; s += v[j][0] * v[j][0] + v[j][1] * v[j][1] + v[j][2] * v[j][2] + v[j][3] * v[j][3]; }
            const float rs = rsqrtf(wave_sum(s) * (1.0f / 1024.0f) + EPS) * (1.0f + E);
            f32x4* orow = (f32x4*)(F.out + (size_t)row * 1024) + F.lane; for (int j = 0; j < 4; ++j) orow[64 * j] = v[j] * rs * *((const f32x4*)fg + F.lane + 64 * j); }
    }
#else
    if (IN(10)) { p10_final(F, args); }
#endif
#ifdef DBG_STAMP
    STAMP(11);
    xcd_barrier(bar);
    if (blockIdx.x == DBG_STAMP_BLK && F.tid == 0) { const unsigned long long t0 = stamps[DBG_STAMP], t1 = stamps[DBG_STAMP_END]; F.out[0] = ((float)(t1 - t0) * 0.01f - DBG_STAMP_OFF) * DBG_STAMP_SCALE;
#ifdef DBG_STAMP_Q
        F.out[0] = floorf(F.out[0] / DBG_STAMP_Q + 0.5f) * DBG_STAMP_Q;
#endif
#ifdef DBG_BARSUM
#ifndef DBG_BARLO
#define DBG_BARLO 0
#define DBG_BARHI 10
#endif
        { unsigned long long sum = 0; for (int k = DBG_BARLO; k < DBG_BARHI; ++k) sum += stamps[k + 1] - stamps[32 + k]; F.out[0] = (float)sum * 0.01f * DBG_STAMP_SCALE; }
#endif
#ifdef DBG_CLK
        F.out[0] = 10.0f * 0.1f * (float)(stamps[16 + DBG_STAMP_END] - stamps[16 + DBG_STAMP]) / (float)(t1 - t0);
#endif
#ifdef DBG_GP_K
        F.out[0] = DBG_GP_SEL == 3 ? (float)pg8::dbg_gp[3] * (float)DBG_GP_SCALE / (float)(pg8::dbg_gp[3] > 0 ? 1 : 1) : (DBG_GP_SEL == 5 ? (float)pg8::dbg_gp[2] * (float)DBG_GP_SCALE : 100.0f * (float)pg8::dbg_gp[DBG_GP_SEL] / (float)pg8::dbg_gp[2]);
#endif
#ifdef DBG_CYC
        F.out[0] = 100.0f * (float)nsa::dbg_cyc[DBG_CYC] / (float)nsa::dbg_cyc[2];
#endif
    }
#endif
#undef IN
#undef SEAM
}

extern "C" void kernel_launch(void* const* d_in, const int* in_sizes, int n_in, void* d_out, int out_size, void* d_ws, size_t ws_size, hipStream_t stream) {
    static int grid = 0;
    if (grid == 0) {
        if (n_in != 24 || out_size != NTOK * D || ws_size < WS_END) { fprintf(stderr, "kernel_launch: unexpected shapes (n_in %d, out %d, ws %zu)\n", n_in, out_size, ws_size); grid = -1; return; }
        int dev = 0, cus = 0, per_cu = 0;
        if (hipGetDevice(&dev) != hipSuccess || hipDeviceGetAttribute(&cus, hipDeviceAttributeMultiprocessorCount, dev) != hipSuccess) { grid = -1; return; }
        if (hipFuncSetAttribute((const void*)mk_fwd, hipFuncAttributeMaxDynamicSharedMemorySize, LDS_BYTES) != hipSuccess) { fprintf(stderr, "kernel_launch: hipFuncSetAttribute failed\n"); grid = -1; return; }
        if (hipOccupancyMaxActiveBlocksPerMultiprocessor(&per_cu, (const void*)mk_fwd, NWAVES * 64, LDS_BYTES) != hipSuccess || per_cu < 1) { fprintf(stderr, "kernel_launch: occupancy query reports %d\n", per_cu); }
        (void)hipGetLastError();
        grid = cus;
    }
    if (grid < 0) return;
    (void)hipMemsetD32Async((hipDeviceptr_t)((char*)d_ws + WS_CTL), 0, CTL_ZERO_BYTES / 4, stream);
    Args a{};
    for (int i = 0; i < 24; ++i) a.in[i] = (const float*)d_in[i];
    a.out = (float*)d_out; a.ws = (unsigned char*)d_ws;
#if MK_PER_PHASE
    for (int p = 0; p < N_PHASES; ++p) { a.ph_lo = p; a.ph_hi = p + 1; hipLaunchKernelGGL(mk_fwd, dim3(grid), dim3(NWAVES * 64), LDS_BYTES, stream, a); }
#else
    a.ph_lo = 0; a.ph_hi = N_PHASES; hipLaunchKernelGGL(mk_fwd, dim3(grid), dim3(NWAVES * 64), LDS_BYTES, stream, a);
#endif
}
```
